# Optimizing an MI355X kernel written in HIP

```python
import jax, jax.numpy as jnp
from jax import lax
import numpy as np

D_MODEL = 2048
BATCH = 4
SEQ = 2048
DEPTH = 2
DEC_BATCH = 32
DEC_SEQ = 1
PAST_LEN = 16384
PAGE_SIZE = 128

MIX_WIDTH = D_MODEL
ATTN_WIDTH = MIX_WIDTH // 2
GM_WIDTH = MIX_WIDTH - ATTN_WIDTH
HEAD_DIM = 64
N_HEADS = ATTN_WIDTH // HEAD_DIM
N_KV_HEADS = N_HEADS // 4
GQA_GROUP = N_HEADS // N_KV_HEADS
WINDOW = 128
ROPE_THETA = 10000.0
CHUNK = 128
GM_HEADS = 8
GM_HD = GM_WIDTH // GM_HEADS
D_FF = 11 * D_MODEL // 4
CONV_W = 3
KV_WIDTH = N_KV_HEADS * HEAD_DIM
IN_COLS = ATTN_WIDTH + 2 * KV_WIDTH + 2 * GM_WIDTH
EPS = 1e-6
NEG = -1e30

kernel_name = "hymba_swa_sink_chunk_gmlp_convffn_adaln_step"


def rms_norm(x, g):
    xf = x.astype(jnp.float32)
    y = xf * lax.rsqrt(jnp.mean(xf * xf, axis=-1, keepdims=True) + EPS)
    return (y * g.astype(jnp.float32)).astype(x.dtype)


def rope(x, pos):
    half = HEAD_DIM // 2
    inv = ROPE_THETA ** (-jnp.arange(half, dtype=jnp.float32) / half)
    ang = pos.astype(jnp.float32)[:, None] * inv[None, :]
    cos = jnp.cos(ang)[None, :, None, :]
    sin = jnp.sin(ang)[None, :, None, :]
    xf = x.astype(jnp.float32)
    x1, x2 = xf[..., :half], xf[..., half:]
    return jnp.concatenate([x1 * cos - x2 * sin, x2 * cos + x1 * sin], axis=-1).astype(x.dtype)


def sink_attention(q, k, v, mask, sinks):
    B, N, Tq = q.shape[:3]
    s = jnp.einsum('bnqkgd,bnjkd->bnkgqj', q.astype(jnp.float32), k.astype(jnp.float32)) * (HEAD_DIM ** -0.5)
    s = jnp.where(mask[None, :, None, None], s, NEG)
    sk = sinks.astype(jnp.float32).reshape(N_KV_HEADS, GQA_GROUP)[None, None, :, :, None]
    m = jnp.maximum(s.max(axis=-1), sk)
    p = jnp.exp(s - m[..., None])
    p = p / (p.sum(axis=-1) + jnp.exp(sk - m))[..., None]
    o = jnp.einsum('bnkgqj,bnjkd->bnqkgd', p, v.astype(jnp.float32))
    return o.reshape(B, N * Tq, N_HEADS * HEAD_DIM)


def swa_prompt(q, k, v, sinks):
    B, S = q.shape[:2]
    nb = S // WINDOW
    qb = q.reshape(B, nb, WINDOW, N_KV_HEADS, GQA_GROUP, HEAD_DIM)
    kb = k.reshape(B, nb, WINDOW, N_KV_HEADS, HEAD_DIM)
    vb = v.reshape(B, nb, WINDOW, N_KV_HEADS, HEAD_DIM)
    pad = jnp.zeros_like(kb[:, :1])
    kk = jnp.concatenate([jnp.concatenate([pad, kb[:, :-1]], axis=1), kb], axis=2)
    vv = jnp.concatenate([jnp.concatenate([pad, vb[:, :-1]], axis=1), vb], axis=2)
    n = jnp.arange(nb)[:, None, None]
    qpos = n * WINDOW + jnp.arange(WINDOW)[None, :, None]
    kpos = (n - 1) * WINDOW + jnp.arange(2 * WINDOW)[None, None, :]
    mask = (kpos <= qpos) & (kpos >= qpos - WINDOW) & (kpos >= 0)
    return sink_attention(qb, kk, vv, mask, sinks)


def swa_sample(q, k_new, v_new, k_cache, v_cache, sinks):
    T = q.shape[1]
    W = k_cache.shape[1]
    kk = jnp.concatenate([k_cache.astype(k_new.dtype), k_new], axis=1)
    vv = jnp.concatenate([v_cache.astype(v_new.dtype), v_new], axis=1)
    qpos = PAST_LEN + jnp.arange(T)[:, None]
    kpos = PAST_LEN - W + jnp.arange(W + T)[None, :]
    mask = (kpos <= qpos) & (kpos >= qpos - WINDOW) & (kpos >= 0)
    o = sink_attention(q[:, None], kk[:, None], vv[:, None], mask[None], sinks)
    return o, kk[:, -W:], vv[:, -W:]


def chunk_spatial_gate(u, v, ws, bs):
    B, T, _ = v.shape
    nc = -(-T // CHUNK)
    vp = jnp.pad(v, ((0, 0), (0, nc * CHUNK - T), (0, 0))).reshape(B, nc, CHUNK, GM_HEADS, GM_HD)
    causal = jnp.tril(jnp.ones((CHUNK, CHUNK), dtype=bool))
    wm = jnp.where(causal[None], ws, jnp.zeros_like(ws))
    s = jnp.einsum('hij,bcjhd->bcihd', wm, vp) + jnp.swapaxes(bs, 0, 1)[None, None, :, :, None]
    s = s.reshape(B, nc * CHUNK, GM_WIDTH)[:, :T]
    return u * s


def conv_ffn(h, prev, w_gate, w_up, conv_w, conv_b, w_down):
    a = h @ w_gate
    T = a.shape[1]
    ap = jnp.concatenate([prev.astype(a.dtype), a], axis=1)
    conv = conv_b
    for t in range(CONV_W):
        conv = conv + conv_w[t] * ap[:, t:t + T]
    y = (jax.nn.silu(conv) * (h @ w_up)) @ w_down
    return y, ap[:, -(CONV_W - 1):]


def block(x, c, pos, kv_cache, conv_prev, w_ada, b_ada, g1, g2, w_in, gm_gain, gm_ws, gm_bs,
          sinks, w_out, w_gate, w_up, conv_w, conv_b, w_down):
    B, T, _ = x.shape
    mod = jax.nn.silu(c) @ w_ada + b_ada
    sh1, sc1, gt1, sh2, sc2, gt2 = [m[:, None, :] for m in jnp.split(mod, 6, axis=-1)]
    h = rms_norm(x, g1) * (1 + sc1) + sh1
    z = h @ w_in
    q, k, v, gu, gv = jnp.split(z, [ATTN_WIDTH, ATTN_WIDTH + KV_WIDTH, ATTN_WIDTH + 2 * KV_WIDTH,
                                    ATTN_WIDTH + 2 * KV_WIDTH + GM_WIDTH], axis=-1)
    q = rope(q.reshape(B, T, N_HEADS, HEAD_DIM), pos).reshape(B, T, N_KV_HEADS, GQA_GROUP, HEAD_DIM)
    k = rope(k.reshape(B, T, N_KV_HEADS, HEAD_DIM), pos)
    v = v.reshape(B, T, N_KV_HEADS, HEAD_DIM)
    if kv_cache is None:
        attn = swa_prompt(q, k, v, sinks)
        k_state, v_state = k[:, -WINDOW:], v[:, -WINDOW:]
    else:
        attn, k_state, v_state = swa_sample(q, k, v, kv_cache[0], kv_cache[1], sinks)
    u = jax.nn.gelu(gu)
    gvn = rms_norm(jax.nn.gelu(gv), gm_gain)
    gm = chunk_spatial_gate(u, gvn, gm_ws, gm_bs)
    gm_state = gvn[:, ((T - 1) // CHUNK) * CHUNK:]
    mix = jnp.concatenate([attn.astype(x.dtype), gm], axis=-1) @ w_out
    x = x + gt1 * mix
    h2 = rms_norm(x, g2) * (1 + sc2) + sh2
    f, conv_state = conv_ffn(h2, conv_prev, w_gate, w_up, conv_w, conv_b, w_down)
    x = x + gt2 * f
    return x, k_state, v_state, gm_state, conv_state


def setup_inputs(seed: int = 0) -> dict:
    key = jax.random.key(seed)
    ks = jax.random.split(key, 24)
    nrm = lambda k, shape, s: jax.random.normal(k, shape, dtype=jnp.float32) * s
    D = D_MODEL
    return {
        "x_prompt": nrm(ks[0], (BATCH, SEQ, D), 1.0),
        "x_sample": nrm(ks[1], (DEC_BATCH, DEC_SEQ, D), 1.0),
        "cache_k": nrm(ks[2], (DEPTH, DEC_BATCH, WINDOW, N_KV_HEADS, HEAD_DIM), 1.0),
        "cache_v": nrm(ks[3], (DEPTH, DEC_BATCH, WINDOW, N_KV_HEADS, HEAD_DIM), 1.0),
        "state_conv": nrm(ks[4], (DEPTH, DEC_BATCH, CONV_W - 1, D_FF), 1.0),
        "c_prompt": nrm(ks[5], (BATCH, D), 1.0),
        "c_sample": nrm(ks[6], (DEC_BATCH, D), 1.0),
        "w_ada": nrm(ks[7], (DEPTH, D, 6 * D), 0.3 * D ** -0.5),
        "b_ada": nrm(ks[8], (DEPTH, 6 * D), 0.02),
        "g_norm1": 1.0 + nrm(ks[9], (DEPTH, D), 0.02),
        "g_norm2": 1.0 + nrm(ks[10], (DEPTH, D), 0.02),
        "w_in": nrm(ks[11], (DEPTH, D, IN_COLS), D ** -0.5),
        "gm_gain": 1.0 + nrm(ks[12], (DEPTH, GM_WIDTH), 0.02),
        "gm_ws": nrm(ks[13], (DEPTH, GM_HEADS, CHUNK, CHUNK), CHUNK ** -0.5),
        "gm_bs": 1.0 + nrm(ks[14], (DEPTH, GM_HEADS, CHUNK), 0.02),
        "sinks": nrm(ks[15], (DEPTH, N_HEADS), 1.0),
        "w_out": nrm(ks[16], (DEPTH, MIX_WIDTH, D), MIX_WIDTH ** -0.5),
        "w_gate": nrm(ks[17], (DEPTH, D, D_FF), D ** -0.5),
        "w_up": nrm(ks[18], (DEPTH, D, D_FF), D ** -0.5),
        "conv_w": nrm(ks[19], (DEPTH, CONV_W, D_FF), CONV_W ** -0.5),
        "conv_b": nrm(ks[20], (DEPTH, D_FF), 0.02),
        "w_down": nrm(ks[21], (DEPTH, D_FF, D), D_FF ** -0.5),
        "g_final": 1.0 + nrm(ks[22], (D,), 0.02),
    }


def reference(x_prompt, x_sample, cache_k, cache_v, state_conv, c_prompt, c_sample,
              w_ada, b_ada, g_norm1, g_norm2, w_in, gm_gain, gm_ws, gm_bs, sinks, w_out,
              w_gate, w_up, conv_w, conv_b, w_down, g_final):
    pos_p = jnp.arange(x_prompt.shape[1], dtype=jnp.int32)
    pos_s = PAST_LEN + jnp.arange(x_sample.shape[1], dtype=jnp.int32)
    hp, hs = x_prompt, x_sample
    kp, vp, gp, cp, ksl, vsl, gsl, csl = [], [], [], [], [], [], [], []
    for l in range(DEPTH):
        params = (w_ada[l], b_ada[l], g_norm1[l], g_norm2[l], w_in[l], gm_gain[l], gm_ws[l], gm_bs[l],
                  sinks[l], w_out[l], w_gate[l], w_up[l], conv_w[l], conv_b[l], w_down[l])
        conv0 = jnp.zeros((hp.shape[0], CONV_W - 1, D_FF), dtype=hp.dtype)
        hp, k1, v1, g1, c1 = block(hp, c_prompt, pos_p, None, conv0, *params)
        hs, k2, v2, g2, c2 = block(hs, c_sample, pos_s, (cache_k[l], cache_v[l]), state_conv[l], *params)
        kp.append(k1); vp.append(v1); gp.append(g1); cp.append(c1)
        ksl.append(k2); vsl.append(v2); gsl.append(g2); csl.append(c2)
    y_prompt = rms_norm(hp, g_final)
    y_sample = rms_norm(hs, g_final)
    return (y_prompt, y_sample,
            jnp.stack(kp), jnp.stack(vp), jnp.stack(gp), jnp.stack(cp),
            jnp.stack(ksl), jnp.stack(vsl), jnp.stack(gsl), jnp.stack(csl))
```

```cpp
#include <hip/hip_runtime.h>
#include <hip/hip_cooperative_groups.h>
#include <cstdio>
namespace cg = cooperative_groups;
namespace pg8 {
#define PG8_LAS __attribute__((address_space(3)))
typedef unsigned short bf16_t;
typedef short bf16x8 __attribute__((ext_vector_type(8)));
typedef float f32x4 __attribute__((ext_vector_type(4)));
typedef unsigned u32x4 __attribute__((ext_vector_type(4)));
constexpr int BM = 256, BK = 64, HALF = 128, HTB = HALF * BK * 2  , STAGE_BYTES = 8 * HTB, NXCD = 8, WGM = 8;

__host__ __device__ __forceinline__ int lds_byte(int r, int c) { const int st = (r >> 4) * 2 + (c >> 5), rr = r & 15, cc = c & 31, ob = rr * 64 + cc * 2; return st * 1024 + (ob ^ (((ob >> 9) & 1) << 5)); }
__host__ __device__ __forceinline__ void stage_rc(int b, int& R, int& C) { const int st = b / 1024, sb = b % 1024, swz = sb ^ (((sb >> 9) & 1) << 5); R = (st >> 1) * 16 + swz / 64; C = (st & 1) * 32 + (swz % 64) / 2; }
__host__ __device__ __forceinline__ int perm32(int rho) { const int n = rho >> 4, i = rho & 15; return 8 * (i >> 2) + 4 * n + (i & 3); }

struct Unit { int pm, pn; };
struct Gemm { const bf16_t* A; const bf16_t* Bt; int M, N, K; };

struct StaticOrder {
    int nM, nN, nwg, G, c;
    __host__ __device__ void init(int M, int N, int G_, int c_) { nM = M / BM; nN = N / BM; nwg = nM * nN; G = G_; c = c_; }
    __host__ __device__ bool next(int i, Unit& u) const {
        const long L = (long)i * G + c; if (L >= nwg) return false;
        int wgid = (int)L; { const int q = nwg / NXCD, r = nwg % NXCD, xcd = wgid % NXCD, off = wgid / NXCD; wgid = (xcd < r ? xcd * (q + 1) : r * (q + 1) + (xcd - r) * q) + off; }
        const int nig = WGM * nN, gid = wgid / nig, fm = gid * WGM, gsz = (nM - fm) < WGM ? (nM - fm) : WGM;
        u.pm = fm + ((wgid % nig) % gsz); u.pn = (wgid % nig) / gsz; return true;
    }
    __device__ __forceinline__ void a_ready(const Unit&) const {}
    __device__ __forceinline__ void done(const Unit&) const {}
};
__device__ __forceinline__ unsigned cvt_pk_bf16(float lo, float hi) { unsigned r; asm volatile("v_cvt_pk_bf16_f32 %0, %1, %2" : "=v"(r) : "v"(lo), "v"(hi)); return r; }
template <class Epi, class Sched, bool STAMP = false>
__device__ __forceinline__ void gemm_phase(PG8_LAS unsigned char* lds, const Gemm g, const Sched& S, const Epi& E, unsigned long long* stamps, int wave_in) {
    int wv_l = wave_in; asm volatile("" : "+s"(wv_l)); int tid_l = wv_l * 64 + (int)__builtin_amdgcn_mbcnt_hi(~0u, __builtin_amdgcn_mbcnt_lo(~0u, 0u)); asm volatile("" : "+v"(tid_l)); const int tid = tid_l, wid = __builtin_amdgcn_readfirstlane(tid >> 6), lane = tid & 63, wr = wid >> 2, wc = wid & 3, fr = lane & 15, fq = lane >> 4;
    const int K = g.K, nt = K / BK;
    int ts_lo = 0, ts_hi = 0, nts = 0; const unsigned long long rt_entry = STAMP ? (unsigned long long)wall_clock64() : 0ull;
#define PG8_STAMP() do { if (STAMP && wid == 0 && nts < 64) { const unsigned long long _c = (unsigned long long)clock64(); \
        ts_lo = (lane == nts) ? (int)(unsigned)_c : ts_lo; ts_hi = (lane == nts) ? (int)(unsigned)(_c >> 32) : ts_hi; ++nts; } } while (0)
    PG8_STAMP();
    unsigned voffA[2], voffB[2];
#pragma unroll
    for (int i = 0; i < 2; ++i) { int R, C; stage_rc(tid * 16 + i * 8192, R, C); const int Rb = Epi::PERM ? ((R & ~31) + perm32(R & 31)) : R;
        voffA[i] = (unsigned)(R * K + C) * 2u; voffB[i] = (unsigned)(Rb * K + C) * 2u; }
    const size_t kstep = (size_t)(BK * 2);
    const size_t hstep = (size_t)HALF * K * 2;
    const size_t tstep = 2 * hstep;
    const unsigned ldsw = (unsigned)wid * 1024u;
    const int aoff = lds_byte(wr * 64 + fr, fq * 8), boff = lds_byte(wc * 32 + fr, fq * 8);
#define PG8_SA(b, h) (((b) * 2 + (h)) * HTB)
#define PG8_SB(b, h) ((4 + (b) * 2 + (h)) * HTB)
#define PG8_STAGE(bufoff, gbase, voff) do { _Pragma("unroll") for (int _i = 0; _i < 2; ++_i) \
        __builtin_amdgcn_global_load_lds((const unsigned*)((const char*)(gbase) + (voff)[_i]), (PG8_LAS unsigned*)(lds + (bufoff) + ldsw + _i * 8192), 16, 0, 0); } while (0)
#define PG8_LDA(dst, b, h) do { _Pragma("unroll") for (int m = 0; m < 4; ++m) _Pragma("unroll") for (int k = 0; k < 2; ++k) dst[m][k] = *(const PG8_LAS bf16x8*)(lds + PG8_SA(b, h) + aoff + m * 2048 + k * 1024); } while (0)
#define PG8_LDB(dst, b, h) do { _Pragma("unroll") for (int n = 0; n < 2; ++n) _Pragma("unroll") for (int k = 0; k < 2; ++k) dst[n][k] = *(const PG8_LAS bf16x8*)(lds + PG8_SB(b, h) + boff + n * 2048 + k * 1024); } while (0)
#define PG8_MMA(ai, bj, At, Bt) do { __builtin_amdgcn_s_setprio(1); _Pragma("unroll") for (int m = 0; m < 4; ++m) _Pragma("unroll") for (int n = 0; n < 2; ++n) _Pragma("unroll") for (int k = 0; k < 2; ++k) \
        acc[ai][bj][m][n] = __builtin_amdgcn_mfma_f32_16x16x32_bf16(Bt[n][k], At[m][k], acc[ai][bj][m][n], 0, 0, 0); __builtin_amdgcn_s_setprio(0); } while (0)
#define PG8_WAIT_V(n) asm volatile("s_waitcnt vmcnt(" #n ")" ::: "memory")
#define PG8_WAIT_L(n) asm volatile("s_waitcnt lgkmcnt(" #n ")" ::: "memory")
#define PG8_BAR __builtin_amdgcn_s_barrier()
#define PG8_SCHED __builtin_amdgcn_sched_barrier(0)
    Unit cur, nxt; int ui = 0;
    if (!S.next(0, cur)) return;
    f32x4 acc[2][2][4][2];
#pragma unroll
    for (int a = 0; a < 2; ++a)
#pragma unroll
        for (int b = 0; b < 2; ++b)
#pragma unroll
            for (int m = 0; m < 4; ++m)
#pragma unroll
                for (int n = 0; n < 2; ++n) acc[a][b][m][n] = (f32x4){0.f, 0.f, 0.f, 0.f};
    bf16x8 At[4][2], B0[2][2], B1[2][2];
    const char* cA = (const char*)g.A + (size_t)cur.pm * tstep; const char* cB = (const char*)g.Bt + (size_t)cur.pn * tstep;
    S.a_ready(cur);
    PG8_STAGE(PG8_SB(0, 0), cB, voffB); PG8_STAGE(PG8_SA(0, 0), cA, voffA); PG8_STAGE(PG8_SB(0, 1), cB + hstep, voffB); PG8_STAGE(PG8_SA(0, 1), cA + hstep, voffA);
    if (wr == 1) PG8_BAR;
    PG8_WAIT_V(4); PG8_BAR;
    PG8_STAGE(PG8_SB(1, 0), cB + kstep, voffB); PG8_STAGE(PG8_SA(1, 0), cA + kstep, voffA); PG8_STAGE(PG8_SB(1, 1), cB + hstep + kstep, voffB);
    PG8_WAIT_V(6); PG8_BAR;
    PG8_STAMP();
    for (;;) {
        const bool has_next = S.next(ui + 1, nxt);
        const char* nA = has_next ? (const char*)g.A + (size_t)nxt.pm * tstep : cA; const char* nB = has_next ? (const char*)g.Bt + (size_t)nxt.pn * tstep : cB;
        for (int t = 0; t < nt; t += 2) {
            const bool last = (t == nt - 2);
            const char* a1 = cA + (size_t)(t + 1) * kstep;
            const char* a2 = last ? nA : cA + (size_t)(t + 2) * kstep; const char* b2 = last ? nB : cB + (size_t)(t + 2) * kstep;
            const char* a3 = a2 + kstep; const char* b3 = b2 + kstep;
            if (last && has_next) S.a_ready(nxt);
            PG8_LDB(B0, 0, 0); PG8_SCHED; PG8_LDA(At, 0, 0); PG8_STAGE(PG8_SA(1, 1), a1 + hstep, voffA);
            PG8_WAIT_L(8); PG8_BAR; PG8_WAIT_L(0); PG8_MMA(0, 0, At, B0); PG8_BAR; PG8_SCHED;
            PG8_LDB(B1, 0, 1); PG8_STAGE(PG8_SB(0, 0), b2, voffB);
            PG8_BAR; PG8_WAIT_L(0); PG8_MMA(0, 1, At, B1); PG8_BAR;
            PG8_LDA(At, 0, 1); PG8_STAGE(PG8_SA(0, 0), a2, voffA);
            PG8_BAR; PG8_WAIT_L(0); PG8_MMA(1, 0, At, B0); PG8_BAR; PG8_SCHED;
            PG8_STAGE(PG8_SB(0, 1), b2 + hstep, voffB);
            PG8_WAIT_V(6); PG8_BAR; PG8_MMA(1, 1, At, B1); PG8_BAR;
            PG8_LDB(B0, 1, 0); PG8_SCHED; PG8_LDA(At, 1, 0); PG8_STAGE(PG8_SA(0, 1), a2 + hstep, voffA);
            PG8_WAIT_L(8); PG8_BAR; PG8_WAIT_L(0); PG8_MMA(0, 0, At, B0); PG8_BAR; PG8_SCHED;
            PG8_LDB(B1, 1, 1); PG8_STAGE(PG8_SB(1, 0), b3, voffB);
            PG8_BAR; PG8_WAIT_L(0); PG8_MMA(0, 1, At, B1); PG8_BAR;
            PG8_LDA(At, 1, 1); PG8_STAGE(PG8_SA(1, 0), a3, voffA);
            PG8_BAR; PG8_WAIT_L(0); PG8_MMA(1, 0, At, B0); PG8_BAR; PG8_SCHED;
            PG8_STAGE(PG8_SB(1, 1), b3 + hstep, voffB);
            PG8_WAIT_V(6); PG8_BAR; PG8_MMA(1, 1, At, B1); PG8_BAR;
        }
        PG8_STAMP();
        if constexpr (!Epi::AFTER_DRAIN) { E(acc, cur, wr, wc, fr, fq); S.done(cur); }
        PG8_STAMP();
        if (!has_next) break;
#pragma unroll
        for (int a = 0; a < 2; ++a)
#pragma unroll
            for (int b = 0; b < 2; ++b)
#pragma unroll
                for (int m = 0; m < 4; ++m)
#pragma unroll
                    for (int n = 0; n < 2; ++n) acc[a][b][m][n] = (f32x4){0.f, 0.f, 0.f, 0.f};
        cur = nxt; cA = nA; cB = nB; ++ui;
    }
    PG8_WAIT_V(0);
    if (wr == 0) PG8_BAR;
    PG8_BAR;
    if constexpr (Epi::AFTER_DRAIN) { E.fused(acc, cur, wr, wc, fr, fq, lds, wid, lane); S.done(cur); }
    PG8_STAMP();
    if (STAMP && wid == 0) { stamps[lane] = lane < nts ? (((unsigned long long)(unsigned)ts_hi << 32) | (unsigned)ts_lo) : 0ull;
        if (lane == 62) stamps[62] = rt_entry; if (lane == 63) stamps[63] = (unsigned long long)wall_clock64(); }
#undef PG8_STAMP
#undef PG8_SA
#undef PG8_SB
#undef PG8_STAGE
#undef PG8_LDA
#undef PG8_LDB
#undef PG8_MMA
#undef PG8_WAIT_V
#undef PG8_WAIT_L
#undef PG8_BAR
#undef PG8_SCHED
}
}
using pg8::bf16_t; using pg8::bf16x8; using pg8::f32x4; using pg8::u32x4;
typedef float f32x16 __attribute__((ext_vector_type(16)));
typedef float f32x2 __attribute__((ext_vector_type(2)));
typedef unsigned u32x2 __attribute__((ext_vector_type(2)));
#define LAS __attribute__((address_space(3)))
#define DI __device__ __forceinline__

constexpr int D = 2048, SEQ = 2048, NB = 4, M = NB * SEQ, NS = 32, DEPTH = 2;
constexpr int INC = 3584, DFF = 5632, WIN = 128, NH = 16, NKV = 4, HD = 64, GMW = 1024, KVW = 256, AW = 1024;
constexpr int PAST = 16384;
constexpr float EPS = 1e-6f;
constexpr int NMODROWS = NB + NS;
#define G ((int)gridDim.x)

constexpr size_t O_YP = 0;
constexpr size_t O_YS = O_YP + (size_t)M * D;
constexpr size_t O_KWP = O_YS + (size_t)NS * D;
constexpr size_t O_VWP = O_KWP + (size_t)DEPTH * NB * WIN * KVW;
constexpr size_t O_GMP = O_VWP + (size_t)DEPTH * NB * WIN * KVW;
constexpr size_t O_CVP = O_GMP + (size_t)DEPTH * NB * 128 * GMW;
constexpr size_t O_KWS = O_CVP + (size_t)DEPTH * NB * 2 * DFF;
constexpr size_t O_VWS = O_KWS + (size_t)DEPTH * NS * WIN * KVW;
constexpr size_t O_GMS = O_VWS + (size_t)DEPTH * NS * WIN * KVW;
constexpr size_t O_CVS = O_GMS + (size_t)DEPTH * NS * GMW;
constexpr size_t O_END = O_CVS + (size_t)DEPTH * NS * 2 * DFF;

constexpr size_t MiB = 1u << 20;
constexpr size_t WS_WIN = 0;
constexpr size_t WS_WOUT = WS_WIN + 2 * 14 * MiB;
constexpr size_t WS_WGU = WS_WOUT + 2 * 8 * MiB;
constexpr size_t WS_WDN = WS_WGU + 2 * 44 * MiB;
constexpr size_t WS_XN = WS_WDN + 2 * 22 * MiB;
constexpr size_t WS_Q = WS_XN + 32 * MiB;
constexpr size_t WS_K = WS_Q + 16 * MiB;
constexpr size_t WS_V = WS_K + 4 * MiB;
constexpr size_t WS_U = WS_V + 4 * MiB;
constexpr size_t WS_GT = WS_U + 16 * MiB;
constexpr size_t WS_MIX = WS_GT + 16 * MiB;
constexpr size_t WS_XR = WS_MIX + 32 * MiB;
constexpr size_t WS_GA = WS_XR + 64 * MiB;
constexpr size_t WS_UP = WS_GA + 88 * MiB;
constexpr size_t WS_MOD = WS_UP + 88 * MiB;
constexpr size_t WS_ROPE = WS_MOD + 4 * MiB;
constexpr size_t WS_SSQ = WS_ROPE + 1 * MiB;
constexpr size_t WS_SMP = WS_SSQ + 1 * MiB;
constexpr size_t WS_END = WS_SMP + 4 * MiB;
constexpr size_t SM_XS = 0;
constexpr size_t SM_HS = SM_XS + 32 * 2048 * 4;
constexpr size_t SM_Q = SM_HS + 32 * 2048 * 2;
constexpr size_t SM_KK = SM_Q + 32 * 1024 * 4;
constexpr size_t SM_VV = SM_KK + 32 * 256 * 4;
constexpr size_t SM_UU = SM_VV + 32 * 256 * 4;
constexpr size_t SM_GG = SM_UU + 32 * 1024 * 4;
constexpr size_t SM_MIX = SM_GG + 32 * 1024 * 4;
constexpr size_t SM_ACT = SM_MIX + 32 * 2048 * 2;
constexpr size_t SM_END = SM_ACT + 32 * 5632 * 2;
static_assert(SM_END <= 4 * MiB, "sample buffers");

constexpr int LDS_BYTES = 147456;

struct Args {
    const float* in[23];
    float* out;
    unsigned char* ws;
    int ph_lo, ph_hi;
};

DI unsigned f2bf(float f) { unsigned u = __builtin_bit_cast(unsigned, f); return (u + 0x7fffu + ((u >> 16) & 1u)) >> 16; }
DI unsigned pk2(float lo, float hi) { return pg8::cvt_pk_bf16(lo, hi); }
DI float bf2f(unsigned short b) { return __builtin_bit_cast(float, ((unsigned)b) << 16); }
DI float bflo(unsigned w) { return __builtin_bit_cast(float, w << 16); }
DI float bfhi(unsigned w) { return __builtin_bit_cast(float, w & 0xffff0000u); }
DI float wave_sum(float v) {
#pragma unroll
    for (int o = 1; o < 64; o <<= 1) v += __shfl_xor(v, o);
    return v;
}
DI float gelu_tanh(float x) {
    const float u = 0.7978845608028654f * (x + 0.044715f * x * x * x);
    return x * __builtin_amdgcn_rcpf(1.0f + __expf(-2.0f * u));
}
DI float silu_f(float x) { return x * __builtin_amdgcn_rcpf(1.0f + __expf(-x)); }

DI int pair8_phys(int r32) { const int fq = r32 >> 3, n = (r32 >> 2) & 1, e = r32 & 3; return 16 * n + 4 * fq + e; }
DI int win_phys(int L) {
    if (L < 1280) { const int h2 = L >> 7, r = L & 127, hd = r >> 6, d = r & 63, n = d >> 5, d5 = d & 31, wcl = d5 >> 4, fq = (d5 >> 2) & 3, e = d5 & 3;
        return 128 * h2 + 32 * (2 * hd + wcl) + 16 * n + 4 * fq + e; }
    if (L < 2560) return (L & ~31) + pair8_phys(L & 31);
    return L;
}

template <class PF>
DI void conv_item(const float* __restrict__ W, int K, int N, bf16_t* __restrict__ WT, LAS float* scr, int item, int lane, PF phys) {
    const int nblk = N / 32, kb = item / nblk, nb = item % nblk, k0 = 64 * kb, n0 = 32 * nb;
#pragma unroll
    for (int i = 0; i < 8; ++i) { const int kk = 8 * i + (lane >> 3); const f32x4 v = *(const f32x4*)(W + (size_t)(k0 + kk) * N + n0 + 4 * (lane & 7));
        LAS float* s = scr + kk * 33 + 4 * (lane & 7); s[0] = v.x; s[1] = v.y; s[2] = v.z; s[3] = v.w; }
    asm volatile("s_waitcnt lgkmcnt(0)" ::: "memory");
    const int c = lane & 7;
#pragma unroll
    for (int j = 0; j < 4; ++j) { const int n = (lane >> 3) + 8 * j; const LAS float* s = scr + (8 * c) * 33 + n;
        u32x4 o; o.x = pk2(s[0 * 33], s[1 * 33]); o.y = pk2(s[2 * 33], s[3 * 33]); o.z = pk2(s[4 * 33], s[5 * 33]); o.w = pk2(s[6 * 33], s[7 * 33]);
        *(u32x4*)(WT + (size_t)phys(n0 + n) * K + k0 + 8 * c) = o; }
    asm volatile("s_waitcnt lgkmcnt(0)" ::: "memory");
}

struct P {
    const float *xp, *xs, *ck, *cv, *sconv, *cp, *cs, *wada, *bada, *g1, *g2, *win, *gmgain, *gmws, *gmbs, *sinks, *wout, *wgate, *wup, *convw, *convb, *wdown, *gfinal;
    float* out; unsigned char* ws;
};
DI bf16x8 pack8(const float (&w)[8]) { u32x4 o; o.x = pk2(w[0], w[1]); o.y = pk2(w[2], w[3]); o.z = pk2(w[4], w[5]); o.w = pk2(w[6], w[7]); return __builtin_bit_cast(bf16x8, o); }
DI bf16x8 pack8v(f32x4 a, f32x4 b) { u32x4 o; o.x = pk2(a.x, a.y); o.y = pk2(a.z, a.w); o.z = pk2(b.x, b.y); o.w = pk2(b.z, b.w); return __builtin_bit_cast(bf16x8, o); }
#define MFMA16(a, b, c) __builtin_amdgcn_mfma_f32_16x16x32_bf16((a), (b), (c), 0, 0, 0)
#define MFMA32(a, b, c) __builtin_amdgcn_mfma_f32_32x32x16_bf16((a), (b), (c), 0, 0, 0)

DI void phaseA(const P& p, LAS unsigned char* lds, int tid, int wave, int lane) {
    const int gw = blockIdx.x * 8 + wave, NGW = G * 8;
    { float* ssq = (float*)(p.ws + WS_SSQ); for (int i = blockIdx.x * 512 + tid; i < 2 * M; i += G * 512) ssq[i] = 0.f; }
    { float* rc = (float*)(p.ws + WS_ROPE);
      for (int i = blockIdx.x * 512 + tid; i < 2048 * 32 + 32; i += G * 512) {
          const int pos = i < 2048 * 32 ? (i >> 5) : PAST, j = i & 31;
          const float inv = exp2f(-(float)j * (13.287712379549449f / 32.0f));
          const float ang = (float)pos * inv; float sn, cs; sincosf(ang, &sn, &cs);
          if (i < 2048 * 32) { rc[i] = cs; rc[2048 * 32 + i] = sn; } else { rc[2 * 2048 * 32 + j] = cs; rc[2 * 2048 * 32 + 32 + j] = sn; }
      } }
    for (int item = blockIdx.x; item < 2 * 384; item += G) {
        const int l = item / 384, cs = item % 384, h = lane >> 5, r = lane & 31;
        const float* W = p.wada + (size_t)l * D * 6 * D + cs * 32 + r;
        const float* c0 = (r < 4) ? p.cp + r * D : p.cs + (r - 4) * D;
        const float* c1 = p.cs + (28 + (r & 3)) * D;
        f32x16 acc0, acc1;
#pragma unroll
        for (int q = 0; q < 16; ++q) { acc0[q] = 0.f; acc1[q] = 0.f; }
#pragma unroll 2
        for (int ks = 0; ks < 16; ++ks) {
            const int k = wave * 256 + ks * 16 + h * 8;
            float w[8];
#pragma unroll
            for (int j = 0; j < 8; ++j) w[j] = W[(size_t)(k + j) * (6 * D)];
            const bf16x8 bfr = pack8(w);
            f32x4 a0 = *(const f32x4*)(c0 + k), a1 = *(const f32x4*)(c0 + k + 4);
            f32x4 e0 = {0.f, 0.f, 0.f, 0.f}, e1 = e0;
            if (r < 4) { e0 = *(const f32x4*)(c1 + k); e1 = *(const f32x4*)(c1 + k + 4); }
#pragma unroll
            for (int q = 0; q < 4; ++q) { a0[q] = silu_f(a0[q]); a1[q] = silu_f(a1[q]); e0[q] = silu_f(e0[q]); e1[q] = silu_f(e1[q]); }
            acc0 = MFMA32(pack8v(a0, a1), bfr, acc0);
            acc1 = MFMA32(pack8v(e0, e1), bfr, acc1);
        }
        LAS float* red = (LAS float*)lds;
#pragma unroll
        for (int q = 0; q < 16; ++q) { red[((wave * 2 + 0) * 16 + q) * 64 + lane] = acc0[q]; red[((wave * 2 + 1) * 16 + q) * 64 + lane] = acc1[q]; }
        __syncthreads();
        for (int idx = tid; idx < NMODROWS * 32; idx += 512) {
            const int row = idx >> 5, col = idx & 31, mt = row >> 5, rr = row & 31, q = (rr >> 3) * 4 + (rr & 3), ln = ((rr >> 2) & 1) * 32 + col;
            float s = 0.f;
#pragma unroll
            for (int w8 = 0; w8 < 8; ++w8) s += red[((w8 * 2 + mt) * 16 + q) * 64 + ln];
            ((float*)(p.ws + WS_MOD))[((size_t)l * NMODROWS + row) * (6 * D) + cs * 32 + col] = s + p.bada[l * 6 * D + cs * 32 + col];
        }
        __syncthreads();
    }
    LAS float* scr = (LAS float*)(lds + wave * 8448);
    constexpr int I_IN = 32 * 112, I_OUT = 32 * 64, I_G = 32 * 176, I_DN = 88 * 64, I_L = I_IN + I_OUT + 2 * I_G + I_DN;
    for (int it = gw; it < 2 * I_L; it += NGW) {
        const int l = it / I_L; int r = it % I_L;
        if (r < I_IN) { conv_item(p.win + (size_t)l * D * INC, D, INC, (bf16_t*)(p.ws + WS_WIN + l * 14 * MiB), scr, r, lane, [](int L) { return win_phys(L); }); continue; } r -= I_IN;
        if (r < I_OUT) { conv_item(p.wout + (size_t)l * D * D, D, D, (bf16_t*)(p.ws + WS_WOUT + l * 8 * MiB), scr, r, lane, [](int L) { return L; }); continue; } r -= I_OUT;
        if (r < I_G) { conv_item(p.wgate + (size_t)l * D * DFF, D, DFF, (bf16_t*)(p.ws + WS_WGU + l * 44 * MiB), scr, r, lane, [](int L) { return 256 * (L >> 7) + (L & 96) + pair8_phys(L & 31); }); continue; } r -= I_G;
        if (r < I_G) { conv_item(p.wup + (size_t)l * D * DFF, D, DFF, (bf16_t*)(p.ws + WS_WGU + l * 44 * MiB), scr, r, lane, [](int L) { return 256 * (L >> 7) + 128 + (L & 96) + pair8_phys(L & 31); }); continue; } r -= I_G;
        conv_item(p.wdown + (size_t)l * DFF * D, DFF, D, (bf16_t*)(p.ws + WS_WDN + l * 22 * MiB), scr, r, lane, [](int L) { return L; });
    }
}

DI void phase_norm(const P& p, int l, int which, int wave, int lane) {
    const int gw = blockIdx.x * 8 + wave, NGW = G * 8;
    const float* mod = (const float*)(p.ws + WS_MOD) + (size_t)l * NMODROWS * 6 * D;
    const float* gvec = which == 0 ? p.g1 + l * D : which == 1 ? p.g2 + l * D : p.gfinal;
    const bool first = (l == 0 && which == 0);
    for (int row = gw; row < M + NS; row += NGW) {
        const float* x; bf16_t* o; float* of; int mrow;
        if (row < M) { x = (first ? p.xp : (const float*)(p.ws + WS_XR)) + (size_t)row * D; o = (bf16_t*)(p.ws + WS_XN) + (size_t)row * D; of = p.out + O_YP + (size_t)row * D; mrow = row >> 11; }
        else { const int s = row - M; x = (first ? p.xs : (const float*)(p.ws + WS_SMP + SM_XS)) + (size_t)s * D; o = (bf16_t*)(p.ws + WS_SMP + SM_HS) + (size_t)s * D; of = p.out + O_YS + (size_t)s * D; mrow = NB + s; }
        f32x4 v[8]; float ss = 0.f;
#pragma unroll
        for (int j = 0; j < 8; ++j) { v[j] = ((const f32x4*)x)[lane + 64 * j]; ss += (v[j].x * v[j].x + v[j].y * v[j].y) + (v[j].z * v[j].z + v[j].w * v[j].w); }
        const float rstd = rsqrtf(wave_sum(ss) * (1.0f / D) + EPS);
        if (which == 2) {
#pragma unroll
            for (int j = 0; j < 8; ++j) { const f32x4 g = ((const f32x4*)gvec)[lane + 64 * j]; ((f32x4*)of)[lane + 64 * j] = v[j] * rstd * g; }
        } else {
            const float* sh = mod + (size_t)mrow * 6 * D + (which == 0 ? 0 : 3) * D; const float* sc = sh + D;
#pragma unroll
            for (int j = 0; j < 8; ++j) { const f32x4 g = ((const f32x4*)gvec)[lane + 64 * j], c = ((const f32x4*)sc)[lane + 64 * j], h = ((const f32x4*)sh)[lane + 64 * j];
                const f32x4 y = v[j] * rstd * g * (c + 1.0f) + h; u32x2 w; w.x = pk2(y.x, y.y); w.y = pk2(y.z, y.w); ((u32x2*)o)[lane + 64 * j] = w; }
        }
    }
}

struct EpiIn {
    static constexpr bool PERM = false, AFTER_DRAIN = false;
    bf16_t *Q, *K, *V, *U, *GT; float* ssq; const float* rope; float *kwin, *vwin, *gmv;
    DI void operator()(const f32x4 (&acc)[2][2][4][2], const pg8::Unit& u, int wr, int wc, int fr, int fq) const {
        const int pn = u.pn, b = u.pm >> 3;
#pragma unroll
        for (int ai = 0; ai < 2; ++ai)
#pragma unroll
            for (int m = 0; m < 4; ++m) {
                const int row = u.pm * 256 + ai * 128 + wr * 64 + m * 16 + fr, t = row & 2047;
                if (pn <= 4) {
                    const int dh = 16 * (wc & 1) + 4 * fq;
                    const f32x4 cs = *(const f32x4*)(rope + t * 32 + dh), sn = *(const f32x4*)(rope + 65536 + t * 32 + dh);
#pragma unroll
                    for (int bj = 0; bj < 2; ++bj) {
                        const f32x4 x1 = acc[ai][bj][m][0], x2 = acc[ai][bj][m][1];
                        const f32x4 o1 = x1 * cs - x2 * sn, o2 = x2 * cs + x1 * sn;
                        const int hc = (2 * bj + (wc >> 1)) * 64 + dh;
                        u32x2 w1, w2; w1.x = pk2(o1.x, o1.y); w1.y = pk2(o1.z, o1.w); w2.x = pk2(o2.x, o2.y); w2.y = pk2(o2.z, o2.w);
                        if (pn < 4) { bf16_t* dst = Q + (size_t)row * 1024 + pn * 256 + hc; *(u32x2*)dst = w1; *(u32x2*)(dst + 32) = w2; }
                        else { bf16_t* dst = K + (size_t)row * 256 + hc; *(u32x2*)dst = w1; *(u32x2*)(dst + 32) = w2;
                            if (t >= 1920) { float* w = kwin + ((size_t)(b * 128 + t - 1920) * 256 + hc); *(f32x4*)w = o1; *(f32x4*)(w + 32) = o2; } }
                    }
                } else if (pn == 5) {
#pragma unroll
                    for (int bj = 0; bj < 2; ++bj) {
                        const int col = 128 * bj + 32 * wc + 8 * fq; const f32x4 v0 = acc[ai][bj][m][0], v1 = acc[ai][bj][m][1];
                        u32x4 w; w.x = pk2(v0.x, v0.y); w.y = pk2(v0.z, v0.w); w.z = pk2(v1.x, v1.y); w.w = pk2(v1.z, v1.w);
                        *(u32x4*)(V + (size_t)row * 256 + col) = w;
                        if (t >= 1920) { float* o = vwin + ((size_t)(b * 128 + t - 1920) * 256 + col); *(f32x4*)o = v0; *(f32x4*)(o + 4) = v1; }
                    }
                } else if (pn < 10) {
#pragma unroll
                    for (int bj = 0; bj < 2; ++bj) {
                        const int col = 256 * (pn - 6) + 128 * bj + 32 * wc + 8 * fq; f32x4 v0 = acc[ai][bj][m][0], v1 = acc[ai][bj][m][1];
#pragma unroll
                        for (int e = 0; e < 4; ++e) { v0[e] = gelu_tanh(v0[e]); v1[e] = gelu_tanh(v1[e]); }
                        u32x4 w; w.x = pk2(v0.x, v0.y); w.y = pk2(v0.z, v0.w); w.z = pk2(v1.x, v1.y); w.w = pk2(v1.z, v1.w);
                        *(u32x4*)(U + (size_t)row * 1024 + col) = w;
                    }
                } else {
                    float s = 0.f;
#pragma unroll
                    for (int bj = 0; bj < 2; ++bj)
#pragma unroll
                        for (int n = 0; n < 2; ++n) {
                            const int col = 256 * (pn - 10) + 128 * bj + 32 * wc + 16 * n + 4 * fq; f32x4 g = acc[ai][bj][m][n];
#pragma unroll
                            for (int e = 0; e < 4; ++e) { g[e] = gelu_tanh(g[e]); s += g[e] * g[e]; GT[((size_t)(b * 1024 + col + e)) * 2048 + t] = (bf16_t)f2bf(g[e]); }
                            if (t >= 1920) *(f32x4*)(gmv + ((size_t)(b * 128 + t - 1920) * 1024 + col)) = g;
                        }
                    s += __shfl_xor(s, 16); s += __shfl_xor(s, 32);
                    if (fq == 0) __hip_atomic_fetch_add(ssq + row, s, __ATOMIC_RELAXED, __HIP_MEMORY_SCOPE_AGENT);
                }
            }
    }
};
struct EpiRes {
    static constexpr bool PERM = false, AFTER_DRAIN = false;
    const float* base; float* out; const float* gate;
    DI void operator()(const f32x4 (&acc)[2][2][4][2], const pg8::Unit& u, int wr, int wc, int fr, int fq) const {
        const int b = u.pm >> 3; const int col0 = u.pn * 256 + wc * 32 + 4 * fq;
        f32x4 gv[2][2];
#pragma unroll
        for (int bj = 0; bj < 2; ++bj)
#pragma unroll
            for (int n = 0; n < 2; ++n) gv[bj][n] = *(const f32x4*)(gate + (size_t)b * 6 * D + col0 + bj * 128 + n * 16);
#pragma unroll
        for (int ai = 0; ai < 2; ++ai)
#pragma unroll
            for (int m = 0; m < 4; ++m) { const size_t off = (size_t)(u.pm * 256 + ai * 128 + wr * 64 + m * 16 + fr) * D + col0;
#pragma unroll
                for (int bj = 0; bj < 2; ++bj)
#pragma unroll
                    for (int n = 0; n < 2; ++n) { const f32x4 bs = *(const f32x4*)(base + off + bj * 128 + n * 16); *(f32x4*)(out + off + bj * 128 + n * 16) = bs + gv[bj][n] * acc[ai][bj][m][n]; }
                asm volatile("" ::: "memory"); }
    }
};
struct EpiGU {
    static constexpr bool PERM = false, AFTER_DRAIN = false;
    bf16_t *GA, *UP; float* cvp;
    DI void operator()(const f32x4 (&acc)[2][2][4][2], const pg8::Unit& u, int wr, int wc, int fr, int fq) const {
        const int b = u.pm >> 3, f0 = u.pn * 128 + wc * 32 + 8 * fq;
#pragma unroll
        for (int ai = 0; ai < 2; ++ai)
#pragma unroll
            for (int m = 0; m < 4; ++m) { const int row = u.pm * 256 + ai * 128 + wr * 64 + m * 16 + fr, t = row & 2047;
                const f32x4 g0 = acc[ai][0][m][0], g1 = acc[ai][0][m][1], u0 = acc[ai][1][m][0], u1 = acc[ai][1][m][1];
                u32x4 w; w.x = pk2(g0.x, g0.y); w.y = pk2(g0.z, g0.w); w.z = pk2(g1.x, g1.y); w.w = pk2(g1.z, g1.w);
                *(u32x4*)(GA + (size_t)row * DFF + f0) = w;
                w.x = pk2(u0.x, u0.y); w.y = pk2(u0.z, u0.w); w.z = pk2(u1.x, u1.y); w.w = pk2(u1.z, u1.w);
                *(u32x4*)(UP + (size_t)row * DFF + f0) = w;
                if (t >= 2046) { float* o = cvp + ((size_t)(b * 2 + t - 2046) * DFF + f0); *(f32x4*)o = g0; *(f32x4*)(o + 4) = g1; }
            }
    }
};
DI void attn_unit(const P& p, int l, int unit, LAS unsigned char* lds, int tid, int wave, int lane) {
    const int b = unit >> 6, n = (unit >> 2) & 15, kvh = unit & 3;
    const bf16_t* Kb = (const bf16_t*)(p.ws + WS_K); const bf16_t* Vb = (const bf16_t*)(p.ws + WS_V); const bf16_t* Qb = (const bf16_t*)(p.ws + WS_Q);
    bf16_t* MIX = (bf16_t*)(p.ws + WS_MIX);
    LAS unsigned char* Ks = lds;
    LAS unsigned char* Vt = lds + 256 * 144;
    const int tok0 = b * 2048 + (n - 1) * 128;
#pragma unroll
    for (int i = 0; i < 4; ++i) { const int id = i * 512 + tid, key = id >> 3, part = id & 7;
        u32x4 v = {0u, 0u, 0u, 0u}; if (n > 0 || key >= 128) v = *(const u32x4*)(Kb + (size_t)(tok0 + key) * 256 + kvh * 64 + part * 8);
        *(LAS u32x4*)(Ks + key * 144 + part * 16) = v; }
#pragma unroll
    for (int i = 0; i < 4; ++i) { const int id = i * 512 + tid, key = id & 255, part = id >> 8;
        u32x4 v = {0u, 0u, 0u, 0u}; if (n > 0 || key >= 128) v = *(const u32x4*)(Vb + (size_t)(tok0 + key) * 256 + kvh * 64 + part * 8);
        LAS unsigned short* d = (LAS unsigned short*)(Vt + (part * 8) * 528 + key * 2);
        d[0 * 264] = (unsigned short)(v.x & 0xffffu); d[1 * 264] = (unsigned short)(v.x >> 16); d[2 * 264] = (unsigned short)(v.y & 0xffffu); d[3 * 264] = (unsigned short)(v.y >> 16);
        d[4 * 264] = (unsigned short)(v.z & 0xffffu); d[5 * 264] = (unsigned short)(v.z >> 16); d[6 * 264] = (unsigned short)(v.w & 0xffffu); d[7 * 264] = (unsigned short)(v.w >> 16); }
    __syncthreads();
    const int q16 = lane & 15, g4 = lane >> 4;
    for (int it = 0; it < 4; ++it) {
        const int qg = wave * 4 + it, g = qg >> 3, i0 = (qg & 7) * 16, head = kvh * 4 + g, nt0 = i0 >> 4;
        const size_t qtok = (size_t)b * 2048 + n * 128 + i0 + q16;
        const bf16x8 q0 = *(const bf16x8*)(Qb + qtok * 1024 + head * 64 + g4 * 8), q1 = *(const bf16x8*)(Qb + qtok * 1024 + head * 64 + 32 + g4 * 8);
        f32x4 s[9];
#pragma unroll
        for (int tt = 0; tt < 9; ++tt) { const LAS unsigned char* kp = Ks + ((nt0 + tt) * 16 + q16) * 144 + g4 * 16;
            const bf16x8 a0 = *(const LAS bf16x8*)kp, a1 = *(const LAS bf16x8*)(kp + 64);
            f32x4 z = {0.f, 0.f, 0.f, 0.f}; z = MFMA16(a0, q0, z); s[tt] = MFMA16(a1, q1, z); }
        const int iq = i0 + q16; float mx = -1e30f;
#pragma unroll
        for (int tt = 0; tt < 9; ++tt)
#pragma unroll
            for (int r = 0; r < 4; ++r) { const int j = (nt0 + tt) * 16 + g4 * 4 + r; const bool ok = (j >= iq) && (j <= iq + 128) && (n > 0 || j >= 128);
                const float v = ok ? s[tt][r] * 0.125f : -1e30f; s[tt][r] = v; mx = fmaxf(mx, v); }
        mx = fmaxf(mx, __shfl_xor(mx, 16)); mx = fmaxf(mx, __shfl_xor(mx, 32));
        const float sink = p.sinks[l * NH + head]; const float mm = fmaxf(mx, sink);
        float sum = 0.f;
#pragma unroll
        for (int tt = 0; tt < 9; ++tt)
#pragma unroll
            for (int r = 0; r < 4; ++r) { const float e = __expf(s[tt][r] - mm); s[tt][r] = e; sum += e; }
        sum += __shfl_xor(sum, 16); sum += __shfl_xor(sum, 32);
        const float inv = 1.0f / (sum + __expf(sink - mm));
        f32x4 o[4];
#pragma unroll
        for (int dt = 0; dt < 4; ++dt) o[dt] = (f32x4){0.f, 0.f, 0.f, 0.f};
#pragma unroll
        for (int i = 0; i < 5; ++i) {
            const f32x4 pl = s[2 * i], ph = (2 * i + 1 < 9) ? s[(2 * i + 1 < 9) ? 2 * i + 1 : 8] : (f32x4){0.f, 0.f, 0.f, 0.f};
            const bf16x8 pb = pack8v(pl, ph);
#pragma unroll
            for (int dt = 0; dt < 4; ++dt) { const LAS unsigned char* vp = Vt + (16 * dt + q16) * 528 + ((nt0 + 2 * i) * 16 + g4 * 4) * 2;
                u32x4 va; const u32x2 lo = *(const LAS u32x2*)vp; va.x = lo.x; va.y = lo.y;
                if (2 * i + 1 < 9) { const u32x2 hi = *(const LAS u32x2*)(vp + 32); va.z = hi.x; va.w = hi.y; } else { va.z = 0u; va.w = 0u; }
                o[dt] = MFMA16(__builtin_bit_cast(bf16x8, va), pb, o[dt]); }
        }
#pragma unroll
        for (int dt = 0; dt < 4; ++dt) { u32x2 w; w.x = pk2(o[dt].x * inv, o[dt].y * inv); w.y = pk2(o[dt].z * inv, o[dt].w * inv);
            *(u32x2*)(MIX + qtok * 2048 + head * 64 + 16 * dt + 4 * g4) = w; }
    }
    __syncthreads();
}

DI void gmlp_unit(const P& p, int l, int unit, int wave, int lane) {
    const int b = unit >> 7, c = (unit >> 3) & 15, h = unit & 7;
    const int q16 = lane & 15, g4 = lane >> 4, i = 16 * wave + q16;
    const float* Wrow = p.gmws + (((size_t)l * 8 + h) * 128 + i) * 128;
    const float* ssq = (const float*)(p.ws + WS_SSQ) + l * M + b * 2048 + c * 128;
    const bf16_t* GT = (const bf16_t*)(p.ws + WS_GT) + ((size_t)(b * 1024 + h * 128)) * 2048 + c * 128;
    const bf16_t* U = (const bf16_t*)(p.ws + WS_U); bf16_t* MIX = (bf16_t*)(p.ws + WS_MIX);
    f32x4 acc[8];
#pragma unroll
    for (int dt = 0; dt < 8; ++dt) acc[dt] = (f32x4){0.f, 0.f, 0.f, 0.f};
    const int ksmax = wave >> 1;
    for (int ks = 0; ks <= ksmax; ++ks) {
        const int j0 = 32 * ks + 8 * g4;
        const f32x4 w0 = *(const f32x4*)(Wrow + j0), w1 = *(const f32x4*)(Wrow + j0 + 4), s0 = *(const f32x4*)(ssq + j0), s1 = *(const f32x4*)(ssq + j0 + 4);
        float wv[8];
#pragma unroll
        for (int jj = 0; jj < 4; ++jj) { wv[jj] = (j0 + jj <= i) ? w0[jj] * rsqrtf(s0[jj] * (1.0f / GMW) + EPS) : 0.f; wv[4 + jj] = (j0 + 4 + jj <= i) ? w1[jj] * rsqrtf(s1[jj] * (1.0f / GMW) + EPS) : 0.f; }
        const bf16x8 bw = pack8(wv);
#pragma unroll
        for (int dt = 0; dt < 8; ++dt) { const bf16x8 a = *(const bf16x8*)(GT + (size_t)(16 * dt + q16) * 2048 + j0); acc[dt] = MFMA16(a, bw, acc[dt]); }
    }
    const size_t tok = (size_t)b * 2048 + c * 128 + i;
    const float bias = p.gmbs[(l * 8 + h) * 128 + i];
#pragma unroll
    for (int dt = 0; dt < 8; ++dt) { const int col = h * 128 + 16 * dt + 4 * g4;
        const f32x4 gain = *(const f32x4*)(p.gmgain + l * GMW + col); const u32x2 uu = *(const u32x2*)(U + tok * 1024 + col);
        const float o0 = bflo(uu.x) * (gain.x * acc[dt].x + bias), o1 = bfhi(uu.x) * (gain.y * acc[dt].y + bias), o2 = bflo(uu.y) * (gain.z * acc[dt].z + bias), o3 = bfhi(uu.y) * (gain.w * acc[dt].w + bias);
        u32x2 w; w.x = pk2(o0, o1); w.y = pk2(o2, o3); *(u32x2*)(MIX + tok * 2048 + 1024 + col) = w; }
}

DI void sample_mid(const P& p, int l, int s, LAS unsigned char* lds, int tid, int wave, int lane) {
    const float* qS = (const float*)(p.ws + WS_SMP + SM_Q) + s * 1024; const float* kS = (const float*)(p.ws + WS_SMP + SM_KK) + s * 256; const float* vS = (const float*)(p.ws + WS_SMP + SM_VV) + s * 256;
    const float* uS = (const float*)(p.ws + WS_SMP + SM_UU) + s * 1024; const float* gS = (const float*)(p.ws + WS_SMP + SM_GG) + s * 1024;
    bf16_t* mix = (bf16_t*)(p.ws + WS_SMP + SM_MIX) + s * 2048;
    const float* ck = p.ck + ((size_t)l * NS + s) * WIN * KVW; const float* cv = p.cv + ((size_t)l * NS + s) * WIN * KVW;
    LAS float* red = (LAS float*)lds;
    LAS float* ql = (LAS float*)(lds + 64);
    LAS float* pl = (LAS float*)(lds + 64 + 4096);
    const float g0 = gS[tid], g1 = gS[tid + 512];
    float ss = wave_sum(g0 * g0 + g1 * g1);
    if (lane == 0) red[wave] = ss;
    ql[tid] = qS[tid]; ql[tid + 512] = qS[tid + 512];
    __syncthreads();
    ss = 0.f;
#pragma unroll
    for (int w = 0; w < 8; ++w) ss += red[w];
    const float rstd = rsqrtf(ss * (1.0f / GMW) + EPS);
#pragma unroll
    for (int q = 0; q < 2; ++q) { const int c = tid + 512 * q, h = c >> 7; const float gvn = (q ? g1 : g0) * rstd * p.gmgain[l * GMW + c];
        p.out[O_GMS + ((size_t)l * NS + s) * GMW + c] = gvn;
        const float sv = p.gmws[((size_t)l * 8 + h) * 128 * 128] * gvn + p.gmbs[(l * 8 + h) * 128];
        mix[1024 + c] = (bf16_t)f2bf(uS[c] * sv); }
    { float* ko = p.out + O_KWS + ((size_t)l * NS + s) * WIN * KVW; float* vo = p.out + O_VWS + ((size_t)l * NS + s) * WIN * KVW;
      for (int i = tid; i < WIN * KVW / 4; i += 512) { const int j = i >> 6, c4 = i & 63;
          const f32x4 kv = (j < 127) ? ((const f32x4*)ck)[(j + 1) * 64 + c4] : ((const f32x4*)kS)[c4];
          const f32x4 vv = (j < 127) ? ((const f32x4*)cv)[(j + 1) * 64 + c4] : ((const f32x4*)vS)[c4];
          ((f32x4*)ko)[i] = kv; ((f32x4*)vo)[i] = vv; } }
    const int head = tid >> 5, sub = tid & 31, kvh = head >> 2;
    float sc[5];
#pragma unroll
    for (int q = 0; q < 5; ++q) { asm volatile("" ::: "memory"); const int j = sub + 32 * q; sc[q] = -1e30f;
        if (q < 4 || sub == 0) { const float* kr = (q < 4) ? ck + (size_t)j * KVW + kvh * 64 : kS + kvh * 64; float d = 0.f;
#pragma unroll 4
            for (int e = 0; e < 16; ++e) { const f32x4 kk = ((const f32x4*)kr)[e]; const LAS float* qq = ql + head * 64 + 4 * e; d += kk.x * qq[0] + kk.y * qq[1] + kk.z * qq[2] + kk.w * qq[3]; }
            sc[q] = d * 0.125f; } }
    float mx = fmaxf(fmaxf(fmaxf(sc[0], sc[1]), fmaxf(sc[2], sc[3])), sc[4]);
#pragma unroll
    for (int o = 1; o < 32; o <<= 1) mx = fmaxf(mx, __shfl_xor(mx, o));
    const float sink = p.sinks[l * NH + head], mm = fmaxf(mx, sink);
    float sum = 0.f;
#pragma unroll
    for (int q = 0; q < 5; ++q) { sc[q] = (q < 4 || sub == 0) ? __expf(sc[q] - mm) : 0.f; sum += sc[q]; }
#pragma unroll
    for (int o = 1; o < 32; o <<= 1) sum += __shfl_xor(sum, o);
    const float inv = 1.0f / (sum + __expf(sink - mm));
#pragma unroll
    for (int q = 0; q < 4; ++q) pl[head * 132 + sub + 32 * q] = sc[q] * inv;
    if (sub == 0) pl[head * 132 + 128] = sc[4] * inv;
    __syncthreads();
    { const int d2 = sub * 2; float o0 = 0.f, o1 = 0.f;
      for (int j = 0; j < 129; ++j) { const float pj = pl[head * 132 + j]; const float* vr = (j < 128) ? cv + (size_t)j * KVW + kvh * 64 + d2 : vS + kvh * 64 + d2; const f32x2 vv = *(const f32x2*)vr; o0 += pj * vv.x; o1 += pj * vv.y; }
      *(unsigned*)(mix + head * 64 + d2) = pk2(o0, o1); }
    __syncthreads();
}

DI void gmv_fix(const P& p, int l, int tid) {
    float* gmv = p.out + O_GMP + (size_t)l * NB * 128 * GMW; const float* ssq = (const float*)(p.ws + WS_SSQ) + l * M;
    for (int i = blockIdx.x * 512 + tid; i < NB * 128 * GMW / 4; i += G * 512) { const int c4 = i & 255, r = i >> 8, b = r >> 7, tt = r & 127;
        const float rs = rsqrtf(ssq[b * 2048 + 1920 + tt] * (1.0f / GMW) + EPS); const f32x4 g = ((const f32x4*)(p.gmgain + l * GMW))[c4];
        f32x4 v = ((f32x4*)gmv)[i]; v = v * rs * g; ((f32x4*)gmv)[i] = v; }
}

DI void phase_act(const P& p, int l, int tid) {
    const bf16_t* GA = (const bf16_t*)(p.ws + WS_GA); bf16_t* UP = (bf16_t*)(p.ws + WS_UP);
    const float* cw = p.convw + (size_t)l * 3 * DFF; const float* cb = p.convb + (size_t)l * DFF;
    constexpr int NCH = DFF / 8, RB = 32;
    for (int task = blockIdx.x * 512 + tid; task < (M / RB) * NCH; task += G * 512) {
        const int ch = task % NCH, rb = task / NCH, f = ch * 8, row0 = rb * RB;
        float w0[8], w1[8], w2[8], bb[8];
#pragma unroll
        for (int e = 0; e < 8; ++e) { w0[e] = cw[f + e]; w1[e] = cw[DFF + f + e]; w2[e] = cw[2 * DFF + f + e]; bb[e] = cb[f + e]; }
        u32x4 a0 = {0u, 0u, 0u, 0u}, a1 = a0;
        if ((row0 & 2047) != 0) { a0 = *(const u32x4*)(GA + (size_t)(row0 - 2) * DFF + f); a1 = *(const u32x4*)(GA + (size_t)(row0 - 1) * DFF + f); }
#pragma unroll 4
        for (int r = 0; r < RB; ++r) { const size_t off = (size_t)(row0 + r) * DFF + f;
            const u32x4 a2 = *(const u32x4*)(GA + off), uu = *(const u32x4*)(UP + off); u32x4 o;
#pragma unroll
            for (int q = 0; q < 4; ++q) {
                const float c0 = bb[2 * q] + w0[2 * q] * bflo(a0[q]) + w1[2 * q] * bflo(a1[q]) + w2[2 * q] * bflo(a2[q]);
                const float c1 = bb[2 * q + 1] + w0[2 * q + 1] * bfhi(a0[q]) + w1[2 * q + 1] * bfhi(a1[q]) + w2[2 * q + 1] * bfhi(a2[q]);
                o[q] = pk2(silu_f(c0) * bflo(uu[q]), silu_f(c1) * bfhi(uu[q])); }
            *(u32x4*)(UP + off) = o; a0 = a1; a1 = a2; }
    }
}
template <int NBLK, class Epi>
DI void skinny(LAS unsigned char* lds, const bf16_t* A, int K, const bf16_t* B0, const bf16_t* B1, int wave, int lane, const Epi& epi) {
    const int r = lane & 31, h = lane >> 5, kw = K / 8;
    const bf16_t* ap = A + (size_t)r * K + wave * kw + h * 8;
    const bf16_t* b0 = B0 + (size_t)r * K + wave * kw + h * 8;
    const bf16_t* b1 = (NBLK == 2 ? B1 : B0) + (size_t)r * K + wave * kw + h * 8;
    f32x16 acc0, acc1;
#pragma unroll
    for (int q = 0; q < 16; ++q) { acc0[q] = 0.f; acc1[q] = 0.f; }
#pragma unroll 4
    for (int k = 0; k < kw; k += 16) { const bf16x8 a = *(const bf16x8*)(ap + k);
        acc0 = MFMA32(*(const bf16x8*)(b0 + k), a, acc0);
        if (NBLK == 2) acc1 = MFMA32(*(const bf16x8*)(b1 + k), a, acc1); }
    LAS float* red = (LAS float*)lds;
#pragma unroll
    for (int q = 0; q < 16; ++q) { red[((wave * 2 + 0) * 16 + q) * 64 + lane] = acc0[q]; if (NBLK == 2) red[((wave * 2 + 1) * 16 + q) * 64 + lane] = acc1[q]; }
    __syncthreads();
    if (wave == 0) {
#pragma unroll
        for (int q = 0; q < 16; ++q) { float s0 = 0.f, s1 = 0.f;
#pragma unroll
            for (int w = 0; w < 8; ++w) { s0 += red[((w * 2 + 0) * 16 + q) * 64 + lane]; if (NBLK == 2) s1 += red[((w * 2 + 1) * 16 + q) * 64 + lane]; }
            acc0[q] = s0; acc1[q] = s1; }
        epi(acc0, acc1, lane);
    }
    __syncthreads();
}
struct SkIn {
    int item; float *qS, *kS, *vS, *uS, *gS; const float* ropeS;
    DI void operator()(const f32x16& acc, const f32x16&, int lane) const {
        const int s = lane & 31, h = lane >> 5, p0 = item * 32, pn = p0 >> 8, bj = (p0 >> 7) & 1, wc = (p0 >> 5) & 3;
        if (pn <= 4) {
#pragma unroll
            for (int q = 0; q < 8; ++q) { const int fq = 2 * ((q >> 2) & 1) + h, e = q & 3, dh = 16 * (wc & 1) + 4 * fq + e;
                const float cs = ropeS[dh], sn = ropeS[32 + dh], x1 = acc[q], x2 = acc[q + 8], o1 = x1 * cs - x2 * sn, o2 = x2 * cs + x1 * sn;
                const int hc = 128 * bj + 64 * (wc >> 1) + dh;
                if (pn < 4) { qS[s * 1024 + pn * 256 + hc] = o1; qS[s * 1024 + pn * 256 + hc + 32] = o2; } else { kS[s * 256 + hc] = o1; kS[s * 256 + hc + 32] = o2; } }
        } else if (pn < 10) {
#pragma unroll
            for (int q = 0; q < 16; ++q) { const int n = q >> 3, fq = 2 * ((q >> 2) & 1) + h, e = q & 3, L = p0 + 8 * fq + 4 * n + e;
                if (pn == 5) vS[s * 256 + L - 1280] = acc[q]; else uS[s * 1024 + L - 1536] = gelu_tanh(acc[q]); }
        } else {
#pragma unroll
            for (int q = 0; q < 16; ++q) { const int L = p0 + (q & 3) + 8 * (q >> 2) + 4 * h; gS[s * 1024 + L - 2560] = gelu_tanh(acc[q]); }
        }
    }
};
struct SkRes {
    int item; const float* base; float* out; const float* gate;
    DI void operator()(const f32x16& acc, const f32x16&, int lane) const {
        const int s = lane & 31, h = lane >> 5;
#pragma unroll
        for (int q = 0; q < 16; ++q) { const int col = item * 32 + (q & 3) + 8 * (q >> 2) + 4 * h;
            out[s * D + col] = base[s * D + col] + gate[(size_t)(NB + s) * 6 * D + col] * acc[q]; }
    }
};
struct SkGU {
    int item, l; const float *sconv, *cw, *cb; bf16_t* act; float* cvs;
    DI void operator()(const f32x16& ga, const f32x16& up, int lane) const {
        const int s = lane & 31, h = lane >> 5, pn = item >> 2, wc = item & 3;
#pragma unroll
        for (int q = 0; q < 16; ++q) { const int n = q >> 3, fq = 2 * ((q >> 2) & 1) + h, e = q & 3, f = 128 * pn + 32 * wc + 8 * fq + 4 * n + e;
            const float p0 = sconv[((size_t)(l * NS + s) * 2 + 0) * DFF + f], p1 = sconv[((size_t)(l * NS + s) * 2 + 1) * DFF + f], a = ga[q];
            const float cv = cb[l * DFF + f] + cw[((size_t)l * 3 + 0) * DFF + f] * p0 + cw[((size_t)l * 3 + 1) * DFF + f] * p1 + cw[((size_t)l * 3 + 2) * DFF + f] * a;
            act[s * DFF + f] = (bf16_t)f2bf(silu_f(cv) * up[q]);
            cvs[((size_t)(l * NS + s) * 2 + 0) * DFF + f] = p1; cvs[((size_t)(l * NS + s) * 2 + 1) * DFF + f] = a; }
    }
};

#ifndef MULTI
#define MULTI 0
#endif
constexpr int NPHASE = 18;
__global__ void __launch_bounds__(512, 2) fwd(Args a) {
    extern __shared__ __attribute__((aligned(16))) unsigned char lds_raw[];
    LAS unsigned char* lds = (LAS unsigned char*)lds_raw;
    cg::grid_group grid = cg::this_grid();
    const int wave0 = __builtin_amdgcn_readfirstlane(threadIdx.x >> 6);
    P p;
    p.xp = a.in[0]; p.xs = a.in[1]; p.ck = a.in[2]; p.cv = a.in[3]; p.sconv = a.in[4]; p.cp = a.in[5]; p.cs = a.in[6]; p.wada = a.in[7]; p.bada = a.in[8];
    p.g1 = a.in[9]; p.g2 = a.in[10]; p.win = a.in[11]; p.gmgain = a.in[12]; p.gmws = a.in[13]; p.gmbs = a.in[14]; p.sinks = a.in[15]; p.wout = a.in[16];
    p.wgate = a.in[17]; p.wup = a.in[18]; p.convw = a.in[19]; p.convb = a.in[20]; p.wdown = a.in[21]; p.gfinal = a.in[22]; p.out = a.out; p.ws = a.ws;
    const int lo = a.ph_lo, hi = a.ph_hi;
#define IN(k) (lo <= (k) && (k) < hi)
#define FRESH() int wv_f = wave0; asm volatile("" : "+s"(wv_f)); int tid_f = wv_f * 64 + (int)__builtin_amdgcn_mbcnt_hi(~0u, __builtin_amdgcn_mbcnt_lo(~0u, 0u)); asm volatile("" : "+v"(tid_f)); const int tid = tid_f, lane = tid & 63, wave = __builtin_amdgcn_readfirstlane(tid >> 6); (void)lane; (void)wave
#define SEAM(k) do { if (IN(k) && IN((k) + 1)) grid.sync(); } while (0)
    unsigned char* ws = a.ws;
    bf16_t* XN = (bf16_t*)(ws + WS_XN); float* XR = (float*)(ws + WS_XR); float* XS = (float*)(ws + WS_SMP + SM_XS);
    bf16_t* HS = (bf16_t*)(ws + WS_SMP + SM_HS); bf16_t* MIXS = (bf16_t*)(ws + WS_SMP + SM_MIX); bf16_t* ACTS = (bf16_t*)(ws + WS_SMP + SM_ACT);
    const float* MOD = (const float*)(ws + WS_MOD);

    if (IN(0)) { FRESH(); phaseA(p, lds, tid, wave, lane); }
    SEAM(0);
    for (int l = 0; l < DEPTH; ++l) {
        const int pb = 1 + 8 * l;
        const bf16_t* Win = (const bf16_t*)(ws + WS_WIN + l * 14 * MiB); const bf16_t* Wout = (const bf16_t*)(ws + WS_WOUT + l * 8 * MiB);
        const bf16_t* Wgu = (const bf16_t*)(ws + WS_WGU + l * 44 * MiB); const bf16_t* Wdn = (const bf16_t*)(ws + WS_WDN + l * 22 * MiB);
        const float* modl = MOD + (size_t)l * NMODROWS * 6 * D;
        if (IN(pb + 0)) { FRESH(); phase_norm(p, l, 0, wave, lane); }
        SEAM(pb + 0);
        if (IN(pb + 1)) {
            pg8::Gemm g{XN, Win, M, INC, D}; pg8::StaticOrder S; S.init(M, INC, gridDim.x, blockIdx.x);
            EpiIn E{(bf16_t*)(ws + WS_Q), (bf16_t*)(ws + WS_K), (bf16_t*)(ws + WS_V), (bf16_t*)(ws + WS_U), (bf16_t*)(ws + WS_GT), (float*)(ws + WS_SSQ) + l * M, (const float*)(ws + WS_ROPE),
                    p.out + O_KWP + (size_t)l * NB * WIN * KVW, p.out + O_VWP + (size_t)l * NB * WIN * KVW, p.out + O_GMP + (size_t)l * NB * 128 * GMW};
            pg8::gemm_phase<EpiIn, pg8::StaticOrder>(lds, g, S, E, nullptr, wave0); FRESH();
            for (int item = (int)gridDim.x - 1 - (int)blockIdx.x; item < INC / 32; item += gridDim.x) {
                SkIn e{item, (float*)(ws + WS_SMP + SM_Q), (float*)(ws + WS_SMP + SM_KK), (float*)(ws + WS_SMP + SM_VV), (float*)(ws + WS_SMP + SM_UU), (float*)(ws + WS_SMP + SM_GG), (const float*)(ws + WS_ROPE) + 2 * 2048 * 32};
                skinny<1>(lds, HS, D, Win + (size_t)item * 32 * D, nullptr, wave, lane, e); }
        }
        SEAM(pb + 1);
        if (IN(pb + 2)) { FRESH();
            for (int u = blockIdx.x; u < NB * 16 * NKV; u += gridDim.x) attn_unit(p, l, u, lds, tid, wave, lane);
            for (int u = blockIdx.x; u < NB * 16 * 8; u += gridDim.x) gmlp_unit(p, l, u, wave, lane);
            for (int s = (int)gridDim.x - 1 - (int)blockIdx.x; s < NS; s += gridDim.x) sample_mid(p, l, s, lds, tid, wave, lane);
            gmv_fix(p, l, tid);
        }
        SEAM(pb + 2);
        if (IN(pb + 3)) {
            pg8::Gemm g{(const bf16_t*)(ws + WS_MIX), Wout, M, D, D}; pg8::StaticOrder S; S.init(M, D, gridDim.x, blockIdx.x);
            EpiRes E{l == 0 ? p.xp : XR, XR, modl + 2 * D};
            pg8::gemm_phase<EpiRes, pg8::StaticOrder>(lds, g, S, E, nullptr, wave0); FRESH();
            for (int item = (int)gridDim.x - 1 - (int)blockIdx.x; item < D / 32; item += gridDim.x) {
                SkRes e{item, l == 0 ? p.xs : XS, XS, modl + 2 * D};
                skinny<1>(lds, MIXS, D, Wout + (size_t)item * 32 * D, nullptr, wave, lane, e); }
        }
        SEAM(pb + 3);
        if (IN(pb + 4)) { FRESH(); phase_norm(p, l, 1, wave, lane); }
        SEAM(pb + 4);
        if (IN(pb + 5)) {
            pg8::Gemm g{XN, Wgu, M, 2 * DFF, D}; pg8::StaticOrder S; S.init(M, 2 * DFF, gridDim.x, blockIdx.x);
            EpiGU E{(bf16_t*)(ws + WS_GA), (bf16_t*)(ws + WS_UP), p.out + O_CVP + (size_t)l * NB * 2 * DFF};
            pg8::gemm_phase<EpiGU, pg8::StaticOrder>(lds, g, S, E, nullptr, wave0); FRESH();
            for (int item = (int)gridDim.x - 1 - (int)blockIdx.x; item < DFF / 32; item += gridDim.x) {
                SkGU e{item, l, p.sconv, p.convw, p.convb, ACTS, p.out + O_CVS};
                const bf16_t* b0 = Wgu + (size_t)(256 * (item >> 2) + 32 * (item & 3)) * D;
                skinny<2>(lds, HS, D, b0, b0 + (size_t)128 * D, wave, lane, e); }
        }
        SEAM(pb + 5);
        if (IN(pb + 6)) { FRESH(); phase_act(p, l, tid); }
        SEAM(pb + 6);
        if (IN(pb + 7)) {
            pg8::Gemm g{(const bf16_t*)(ws + WS_UP), Wdn, M, D, DFF}; pg8::StaticOrder S; S.init(M, D, gridDim.x, blockIdx.x);
            EpiRes E{XR, XR, modl + 5 * D};
            pg8::gemm_phase<EpiRes, pg8::StaticOrder>(lds, g, S, E, nullptr, wave0); FRESH();
            for (int item = (int)gridDim.x - 1 - (int)blockIdx.x; item < D / 32; item += gridDim.x) {
                SkRes e{item, XS, XS, modl + 5 * D};
                skinny<1>(lds, ACTS, DFF, Wdn + (size_t)item * 32 * DFF, nullptr, wave, lane, e); }
        }
        SEAM(pb + 7);
    }
    if (IN(17)) { FRESH(); phase_norm(p, 0, 2, wave, lane); }
}

extern "C" void kernel_launch(void* const* d_in, const int* in_sizes, int n_in, void* d_out, int out_size, void* d_ws, size_t ws_size, hipStream_t stream) {
    static int grid = 0;
    if (grid == 0) {
        if (n_in != 23 || (size_t)out_size != O_END || ws_size < WS_END) { fprintf(stderr, "kernel_launch: unexpected shapes: n_in %d out %d (want %zu) ws %zu (want %zu)\n", n_in, out_size, (size_t)O_END, ws_size, (size_t)WS_END); grid = -1; return; }
        int dev = 0, cus = 0, per = 0;
        (void)hipGetDevice(&dev); (void)hipDeviceGetAttribute(&cus, hipDeviceAttributeMultiprocessorCount, dev);
        if (hipFuncSetAttribute((const void*)fwd, hipFuncAttributeMaxDynamicSharedMemorySize, LDS_BYTES) != hipSuccess) { fprintf(stderr, "kernel_launch: hipFuncSetAttribute failed\n"); grid = -1; return; }
        (void)hipOccupancyMaxActiveBlocksPerMultiprocessor(&per, (const void*)fwd, 512, LDS_BYTES);
        if (per < 1) { fprintf(stderr, "kernel_launch: occupancy query says %d blocks per CU\n", per); per = 1; }
        grid = cus * 1;
        fprintf(stderr, "kernel_launch: grid %d (cus %d, per-cu %d)\n", grid, cus, per);
    }
    if (grid < 0) return;
    Args a{};
    for (int i = 0; i < 23; ++i) a.in[i] = (const float*)d_in[i];
    a.out = (float*)d_out; a.ws = (unsigned char*)d_ws;
#if MULTI
    for (int k = 0; k < NPHASE; ++k) { a.ph_lo = k; a.ph_hi = k + 1; hipLaunchKernelGGL(fwd, dim3(grid), dim3(512), LDS_BYTES, stream, a); }
#else
    a.ph_lo = 0; a.ph_hi = NPHASE;
    void* args[] = {&a};
    hipError_t e = hipLaunchCooperativeKernel((void*)fwd, dim3(grid), dim3(512), args, LDS_BYTES, stream);
    if (e != hipSuccess) fprintf(stderr, "kernel_launch: cooperative launch failed: %s (grid %d)\n", hipGetErrorString(e), grid);
#endif
}
```

```cpp
#include <hip/hip_runtime.h>
#include <hip/hip_cooperative_groups.h>
#include <cstdio>
namespace cg = cooperative_groups;
namespace pg8 {
#define PG8_LAS __attribute__((address_space(3)))
typedef unsigned short bf16_t;
typedef short bf16x8 __attribute__((ext_vector_type(8)));
typedef float f32x4 __attribute__((ext_vector_type(4)));
typedef unsigned u32x4 __attribute__((ext_vector_type(4)));
constexpr int BM = 256, BK = 64, HALF = 128, HTB = HALF * BK * 2  , STAGE_BYTES = 8 * HTB, NXCD = 8, WGM = 8;

__host__ __device__ __forceinline__ int lds_byte(int r, int c) { const int st = (r >> 4) * 2 + (c >> 5), rr = r & 15, cc = c & 31, ob = rr * 64 + cc * 2; return st * 1024 + (ob ^ (((ob >> 9) & 1) << 5)); }
__host__ __device__ __forceinline__ void stage_rc(int b, int& R, int& C) { const int st = b / 1024, sb = b % 1024, swz = sb ^ (((sb >> 9) & 1) << 5); R = (st >> 1) * 16 + swz / 64; C = (st & 1) * 32 + (swz % 64) / 2; }
__host__ __device__ __forceinline__ int perm32(int rho) { const int n = rho >> 4, i = rho & 15; return 8 * (i >> 2) + 4 * n + (i & 3); }

struct Unit { int pm, pn; };
struct Gemm { const bf16_t* A; const bf16_t* Bt; int M, N, K; };

struct StaticOrder {
    int nM, nN, nwg, G, c;
    __host__ __device__ void init(int M, int N, int G_, int c_) { nM = M / BM; nN = N / BM; nwg = nM * nN; G = G_; c = c_; }
    __host__ __device__ bool next(int i, Unit& u) const {
        const long L = (long)i * G + c; if (L >= nwg) return false;
        int wgid = (int)L; { const int q = nwg / NXCD, r = nwg % NXCD, xcd = wgid % NXCD, off = wgid / NXCD; wgid = (xcd < r ? xcd * (q + 1) : r * (q + 1) + (xcd - r) * q) + off; }
        const int nig = WGM * nN, gid = wgid / nig, fm = gid * WGM, gsz = (nM - fm) < WGM ? (nM - fm) : WGM;
        u.pm = fm + ((wgid % nig) % gsz); u.pn = (wgid % nig) / gsz; return true;
    }
    __device__ __forceinline__ void a_ready(const Unit&) const {}
    __device__ __forceinline__ void done(const Unit&) const {}
};
__device__ __forceinline__ unsigned cvt_pk_bf16(float lo, float hi) { unsigned r; asm volatile("v_cvt_pk_bf16_f32 %0, %1, %2" : "=v"(r) : "v"(lo), "v"(hi)); return r; }
template <class Epi, class Sched, bool STAMP = false>
__device__ __forceinline__ void gemm_phase(PG8_LAS unsigned char* lds, const Gemm g, const Sched& S, const Epi& E, unsigned long long* stamps, int wave_in) {
    int wv_l = wave_in; asm volatile("" : "+s"(wv_l)); int tid_l = wv_l * 64 + (int)__builtin_amdgcn_mbcnt_hi(~0u, __builtin_amdgcn_mbcnt_lo(~0u, 0u)); asm volatile("" : "+v"(tid_l)); const int tid = tid_l, wid = __builtin_amdgcn_readfirstlane(tid >> 6), lane = tid & 63, wr = wid >> 2, wc = wid & 3, fr = lane & 15, fq = lane >> 4;
    const int K = g.K, nt = K / BK, LD = K + 64;
    int ts_lo = 0, ts_hi = 0, nts = 0; const unsigned long long rt_entry = STAMP ? (unsigned long long)wall_clock64() : 0ull;
#define PG8_STAMP() do { if (STAMP && wid == 0 && nts < 64) { const unsigned long long _c = (unsigned long long)clock64(); \
        ts_lo = (lane == nts) ? (int)(unsigned)_c : ts_lo; ts_hi = (lane == nts) ? (int)(unsigned)(_c >> 32) : ts_hi; ++nts; } } while (0)
    PG8_STAMP();
    unsigned voffA[2], voffB[2];
#pragma unroll
    for (int i = 0; i < 2; ++i) { int R, C; stage_rc(tid * 16 + i * 8192, R, C); const int Rb = Epi::PERM ? ((R & ~31) + perm32(R & 31)) : R;
        voffA[i] = (unsigned)(R * LD + C) * 2u; voffB[i] = (unsigned)(Rb * LD + C) * 2u; }
    const size_t kstep = (size_t)(BK * 2);
    const size_t hstep = (size_t)HALF * LD * 2;
    const size_t tstep = 2 * hstep;
    const unsigned ldsw = (unsigned)wid * 1024u;
    const int aoff = lds_byte(wr * 64 + fr, fq * 8), boff = lds_byte(wc * 32 + fr, fq * 8);
#define PG8_SA(b, h) (((b) * 2 + (h)) * HTB)
#define PG8_SB(b, h) ((4 + (b) * 2 + (h)) * HTB)
#define PG8_STAGE(bufoff, gbase, voff) do { _Pragma("unroll") for (int _i = 0; _i < 2; ++_i) \
        __builtin_amdgcn_global_load_lds((const unsigned*)((const char*)(gbase) + (voff)[_i]), (PG8_LAS unsigned*)(lds + (bufoff) + ldsw + _i * 8192), 16, 0, 0); } while (0)
#define PG8_LDA(dst, b, h) do { _Pragma("unroll") for (int m = 0; m < 4; ++m) _Pragma("unroll") for (int k = 0; k < 2; ++k) dst[m][k] = *(const PG8_LAS bf16x8*)(lds + PG8_SA(b, h) + aoff + m * 2048 + k * 1024); } while (0)
#define PG8_LDB(dst, b, h) do { _Pragma("unroll") for (int n = 0; n < 2; ++n) _Pragma("unroll") for (int k = 0; k < 2; ++k) dst[n][k] = *(const PG8_LAS bf16x8*)(lds + PG8_SB(b, h) + boff + n * 2048 + k * 1024); } while (0)
#define PG8_MMA(ai, bj, At, Bt) do { __builtin_amdgcn_s_setprio(1); _Pragma("unroll") for (int m = 0; m < 4; ++m) _Pragma("unroll") for (int n = 0; n < 2; ++n) _Pragma("unroll") for (int k = 0; k < 2; ++k) \
        acc[ai][bj][m][n] = __builtin_amdgcn_mfma_f32_16x16x32_bf16(Bt[n][k], At[m][k], acc[ai][bj][m][n], 0, 0, 0); __builtin_amdgcn_s_setprio(0); } while (0)
#define PG8_WAIT_V(n) asm volatile("s_waitcnt vmcnt(" #n ")" ::: "memory")
#define PG8_WAIT_L(n) asm volatile("s_waitcnt lgkmcnt(" #n ")" ::: "memory")
#define PG8_BAR __builtin_amdgcn_s_barrier()
#define PG8_SCHED __builtin_amdgcn_sched_barrier(0)
    Unit cur, nxt; int ui = 0;
    if (!S.next(0, cur)) return;
    f32x4 acc[2][2][4][2];
#pragma unroll
    for (int a = 0; a < 2; ++a)
#pragma unroll
        for (int b = 0; b < 2; ++b)
#pragma unroll
            for (int m = 0; m < 4; ++m)
#pragma unroll
                for (int n = 0; n < 2; ++n) acc[a][b][m][n] = (f32x4){0.f, 0.f, 0.f, 0.f};
    bf16x8 At[4][2], B0[2][2], B1[2][2];
    const char* cA = (const char*)g.A + (size_t)cur.pm * tstep; const char* cB = (const char*)g.Bt + (size_t)cur.pn * tstep;
    S.a_ready(cur);
    PG8_STAGE(PG8_SB(0, 0), cB, voffB); PG8_STAGE(PG8_SA(0, 0), cA, voffA); PG8_STAGE(PG8_SB(0, 1), cB + hstep, voffB); PG8_STAGE(PG8_SA(0, 1), cA + hstep, voffA);
    if (wr == 1) PG8_BAR;
    PG8_WAIT_V(4); PG8_BAR;
    PG8_STAGE(PG8_SB(1, 0), cB + kstep, voffB); PG8_STAGE(PG8_SA(1, 0), cA + kstep, voffA); PG8_STAGE(PG8_SB(1, 1), cB + hstep + kstep, voffB);
    PG8_WAIT_V(6); PG8_BAR;
    PG8_STAMP();
    for (;;) {
        const bool has_next = S.next(ui + 1, nxt);
        const char* nA = has_next ? (const char*)g.A + (size_t)nxt.pm * tstep : cA; const char* nB = has_next ? (const char*)g.Bt + (size_t)nxt.pn * tstep : cB;
        for (int t = 0; t < nt; t += 2) {
            const bool last = (t == nt - 2);
            const char* a1 = cA + (size_t)(t + 1) * kstep;
            const char* a2 = last ? nA : cA + (size_t)(t + 2) * kstep; const char* b2 = last ? nB : cB + (size_t)(t + 2) * kstep;
            const char* a3 = a2 + kstep; const char* b3 = b2 + kstep;
            if (last && has_next) S.a_ready(nxt);
            PG8_LDB(B0, 0, 0); PG8_SCHED; PG8_LDA(At, 0, 0); PG8_STAGE(PG8_SA(1, 1), a1 + hstep, voffA);
            PG8_WAIT_L(8); PG8_BAR; PG8_WAIT_L(0); PG8_MMA(0, 0, At, B0); PG8_BAR; PG8_SCHED;
            PG8_LDB(B1, 0, 1); PG8_STAGE(PG8_SB(0, 0), b2, voffB);
            PG8_BAR; PG8_WAIT_L(0); PG8_MMA(0, 1, At, B1); PG8_BAR;
            PG8_LDA(At, 0, 1); PG8_STAGE(PG8_SA(0, 0), a2, voffA);
            PG8_BAR; PG8_WAIT_L(0); PG8_MMA(1, 0, At, B0); PG8_BAR; PG8_SCHED;
            PG8_STAGE(PG8_SB(0, 1), b2 + hstep, voffB);
            PG8_WAIT_V(6); PG8_BAR; PG8_MMA(1, 1, At, B1); PG8_BAR;
            PG8_LDB(B0, 1, 0); PG8_SCHED; PG8_LDA(At, 1, 0); PG8_STAGE(PG8_SA(0, 1), a2 + hstep, voffA);
            PG8_WAIT_L(8); PG8_BAR; PG8_WAIT_L(0); PG8_MMA(0, 0, At, B0); PG8_BAR; PG8_SCHED;
            PG8_LDB(B1, 1, 1); PG8_STAGE(PG8_SB(1, 0), b3, voffB);
            PG8_BAR; PG8_WAIT_L(0); PG8_MMA(0, 1, At, B1); PG8_BAR;
            PG8_LDA(At, 1, 1); PG8_STAGE(PG8_SA(1, 0), a3, voffA);
            PG8_BAR; PG8_WAIT_L(0); PG8_MMA(1, 0, At, B0); PG8_BAR; PG8_SCHED;
            PG8_STAGE(PG8_SB(1, 1), b3 + hstep, voffB);
            PG8_WAIT_V(6); PG8_BAR; PG8_MMA(1, 1, At, B1); PG8_BAR;
        }
        PG8_STAMP();
        if constexpr (!Epi::AFTER_DRAIN) { E(acc, cur, wr, wc, fr, fq); S.done(cur); }
        PG8_STAMP();
        if (!has_next) break;
#pragma unroll
        for (int a = 0; a < 2; ++a)
#pragma unroll
            for (int b = 0; b < 2; ++b)
#pragma unroll
                for (int m = 0; m < 4; ++m)
#pragma unroll
                    for (int n = 0; n < 2; ++n) acc[a][b][m][n] = (f32x4){0.f, 0.f, 0.f, 0.f};
        cur = nxt; cA = nA; cB = nB; ++ui;
    }
    PG8_WAIT_V(0);
    if (wr == 0) PG8_BAR;
    PG8_BAR;
    if constexpr (Epi::AFTER_DRAIN) { E.fused(acc, cur, wr, wc, fr, fq, lds, wid, lane); S.done(cur); }
    PG8_STAMP();
    if (STAMP && wid == 0) { stamps[lane] = lane < nts ? (((unsigned long long)(unsigned)ts_hi << 32) | (unsigned)ts_lo) : 0ull;
        if (lane == 62) stamps[62] = rt_entry; if (lane == 63) stamps[63] = (unsigned long long)wall_clock64(); }
#undef PG8_STAMP
#undef PG8_SA
#undef PG8_SB
#undef PG8_STAGE
#undef PG8_LDA
#undef PG8_LDB
#undef PG8_MMA
#undef PG8_WAIT_V
#undef PG8_WAIT_L
#undef PG8_BAR
#undef PG8_SCHED
}
}
using pg8::bf16_t; using pg8::bf16x8; using pg8::f32x4; using pg8::u32x4;
typedef float f32x16 __attribute__((ext_vector_type(16)));
typedef float f32x2 __attribute__((ext_vector_type(2)));
typedef unsigned u32x2 __attribute__((ext_vector_type(2)));
#define LAS __attribute__((address_space(3)))
#define DI __device__ __forceinline__

constexpr int D = 2048, SEQ = 2048, NB = 4, M = NB * SEQ, NS = 32, DEPTH = 2;
constexpr int INC = 3584, DFF = 5632, WIN = 128, NH = 16, NKV = 4, HD = 64, GMW = 1024, KVW = 256, AW = 1024;
constexpr int PAST = 16384;
constexpr float EPS = 1e-6f;
constexpr int NMODROWS = NB + NS;
#define G ((int)gridDim.x)

constexpr size_t O_YP = 0;
constexpr size_t O_YS = O_YP + (size_t)M * D;
constexpr size_t O_KWP = O_YS + (size_t)NS * D;
constexpr size_t O_VWP = O_KWP + (size_t)DEPTH * NB * WIN * KVW;
constexpr size_t O_GMP = O_VWP + (size_t)DEPTH * NB * WIN * KVW;
constexpr size_t O_CVP = O_GMP + (size_t)DEPTH * NB * 128 * GMW;
constexpr size_t O_KWS = O_CVP + (size_t)DEPTH * NB * 2 * DFF;
constexpr size_t O_VWS = O_KWS + (size_t)DEPTH * NS * WIN * KVW;
constexpr size_t O_GMS = O_VWS + (size_t)DEPTH * NS * WIN * KVW;
constexpr size_t O_CVS = O_GMS + (size_t)DEPTH * NS * GMW;
constexpr size_t O_END = O_CVS + (size_t)DEPTH * NS * 2 * DFF;

constexpr size_t MiB = 1u << 20;
constexpr int LDD = D + 64, LDF = DFF + 64;
constexpr size_t SZ_WIN = 15 * MiB, SZ_WOUT = 9 * MiB, SZ_WGU = 46 * MiB, SZ_WDN = 23 * MiB;
constexpr size_t WS_WIN = 0;
constexpr size_t WS_WOUT = WS_WIN + 2 * SZ_WIN;
constexpr size_t WS_WGU = WS_WOUT + 2 * SZ_WOUT;
constexpr size_t WS_WDN = WS_WGU + 2 * SZ_WGU;
constexpr size_t WS_XN = WS_WDN + 2 * SZ_WDN;
constexpr size_t WS_Q = WS_XN + 34 * MiB;
constexpr size_t WS_K = WS_Q + 16 * MiB;
constexpr size_t WS_V = WS_K + 4 * MiB;
constexpr size_t WS_U = WS_V + 4 * MiB;
constexpr size_t WS_GT = WS_U + 16 * MiB;
constexpr size_t WS_MIX = WS_GT + 16 * MiB;
constexpr size_t WS_XR = WS_MIX + 34 * MiB;
constexpr size_t WS_GA = WS_XR + 64 * MiB;
constexpr size_t WS_UP = WS_GA + 88 * MiB;
constexpr size_t WS_MOD = WS_UP + 90 * MiB;
constexpr size_t WS_ROPE = WS_MOD + 4 * MiB;
constexpr size_t WS_SSQ = WS_ROPE + 1 * MiB;
constexpr size_t WS_SMP = WS_SSQ + 1 * MiB;
constexpr size_t WS_END = WS_SMP + 4 * MiB;
constexpr size_t SM_XS = 0;
constexpr size_t SM_HS = SM_XS + 32 * 2048 * 4;
constexpr size_t SM_Q = SM_HS + 32 * 2048 * 2;
constexpr size_t SM_KK = SM_Q + 32 * 1024 * 4;
constexpr size_t SM_VV = SM_KK + 32 * 256 * 4;
constexpr size_t SM_UU = SM_VV + 32 * 256 * 4;
constexpr size_t SM_GG = SM_UU + 32 * 1024 * 4;
constexpr size_t SM_MIX = SM_GG + 32 * 1024 * 4;
constexpr size_t SM_ACT = SM_MIX + 32 * 2048 * 2;
constexpr size_t SM_END = SM_ACT + 32 * 5632 * 2;
static_assert(SM_END <= 4 * MiB, "sample buffers");

constexpr int LDS_BYTES = 147456;

struct Args {
    const float* in[23];
    float* out;
    unsigned char* ws;
    int ph_lo, ph_hi;
};

DI unsigned f2bf(float f) { unsigned u = __builtin_bit_cast(unsigned, f); return (u + 0x7fffu + ((u >> 16) & 1u)) >> 16; }
DI unsigned pk2(float lo, float hi) { return pg8::cvt_pk_bf16(lo, hi); }
DI float bf2f(unsigned short b) { return __builtin_bit_cast(float, ((unsigned)b) << 16); }
DI float bflo(unsigned w) { return __builtin_bit_cast(float, w << 16); }
DI float bfhi(unsigned w) { return __builtin_bit_cast(float, w & 0xffff0000u); }
DI float wave_sum(float v) {
#pragma unroll
    for (int o = 1; o < 64; o <<= 1) v += __shfl_xor(v, o);
    return v;
}
DI float gelu_tanh(float x) {
    const float u = 0.7978845608028654f * (x + 0.044715f * x * x * x);
    return x * __builtin_amdgcn_rcpf(1.0f + __expf(-2.0f * u));
}
DI float silu_f(float x) { return x * __builtin_amdgcn_rcpf(1.0f + __expf(-x)); }

DI int pair8_phys(int r32) { const int fq = r32 >> 3, n = (r32 >> 2) & 1, e = r32 & 3; return 16 * n + 4 * fq + e; }
DI int win_phys(int L) {
    if (L < 1280) { const int h2 = L >> 7, r = L & 127, hd = r >> 6, d = r & 63, n = d >> 5, d5 = d & 31, wcl = d5 >> 4, fq = (d5 >> 2) & 3, e = d5 & 3;
        return 128 * h2 + 32 * (2 * hd + wcl) + 16 * n + 4 * fq + e; }
    if (L < 2560) return (L & ~31) + pair8_phys(L & 31);
    return L;
}

struct ConvDesc { const float* W; bf16_t* WT; int K, N, type, item; };
DI int conv_phys(int type, int L) {
    if (type == 0) return win_phys(L);
    if (type == 1) return L;
    return 256 * (L >> 7) + (type == 3 ? 128 : 0) + (L & 96) + pair8_phys(L & 31);
}
DI void conv_load(const ConvDesc& d, int lane, f32x4 (&v)[8]) {
    const int nblk = d.N / 32, kb = d.item / nblk, nb = d.item % nblk, k0 = 64 * kb, n0 = 32 * nb;
#pragma unroll
    for (int i = 0; i < 8; ++i) { const int kk = 8 * i + (lane >> 3); v[i] = *(const f32x4*)(d.W + (size_t)(k0 + kk) * d.N + n0 + 4 * (lane & 7)); }
}
DI void conv_store(const ConvDesc& d, int lane, const f32x4 (&v)[8], LAS float* scr) {
    const int nblk = d.N / 32, kb = d.item / nblk, nb = d.item % nblk, k0 = 64 * kb, n0 = 32 * nb;
#pragma unroll
    for (int i = 0; i < 8; ++i) { const int kk = 8 * i + (lane >> 3); LAS float* s = scr + kk * 33 + 4 * (lane & 7); s[0] = v[i].x; s[1] = v[i].y; s[2] = v[i].z; s[3] = v[i].w; }
    asm volatile("s_waitcnt lgkmcnt(0)" ::: "memory");
    const int c = lane & 7;
#pragma unroll
    for (int j = 0; j < 4; ++j) { const int n = (lane >> 3) + 8 * j; const LAS float* s = scr + (8 * c) * 33 + n;
        u32x4 o; o.x = pk2(s[0 * 33], s[1 * 33]); o.y = pk2(s[2 * 33], s[3 * 33]); o.z = pk2(s[4 * 33], s[5 * 33]); o.w = pk2(s[6 * 33], s[7 * 33]);
        *(u32x4*)(d.WT + (size_t)conv_phys(d.type, n0 + n) * (d.K + 64) + k0 + 8 * c) = o; }
    asm volatile("s_waitcnt lgkmcnt(0)" ::: "memory");
}

struct P {
    const float *xp, *xs, *ck, *cv, *sconv, *cp, *cs, *wada, *bada, *g1, *g2, *win, *gmgain, *gmws, *gmbs, *sinks, *wout, *wgate, *wup, *convw, *convb, *wdown, *gfinal;
    float* out; unsigned char* ws;
};
DI bf16x8 pack8(const float (&w)[8]) { u32x4 o; o.x = pk2(w[0], w[1]); o.y = pk2(w[2], w[3]); o.z = pk2(w[4], w[5]); o.w = pk2(w[6], w[7]); return __builtin_bit_cast(bf16x8, o); }
DI bf16x8 pack8v(f32x4 a, f32x4 b) { u32x4 o; o.x = pk2(a.x, a.y); o.y = pk2(a.z, a.w); o.z = pk2(b.x, b.y); o.w = pk2(b.z, b.w); return __builtin_bit_cast(bf16x8, o); }
#define MFMA16(a, b, c) __builtin_amdgcn_mfma_f32_16x16x32_bf16((a), (b), (c), 0, 0, 0)
#define MFMA32(a, b, c) __builtin_amdgcn_mfma_f32_32x32x16_bf16((a), (b), (c), 0, 0, 0)

DI void phaseA(const P& p, LAS unsigned char* lds, int tid, int wave, int lane) {
    const int gw = blockIdx.x * 8 + wave, NGW = G * 8;
    { float* ssq = (float*)(p.ws + WS_SSQ); for (int i = blockIdx.x * 512 + tid; i < 2 * M; i += G * 512) ssq[i] = 0.f; }
    { float* rc = (float*)(p.ws + WS_ROPE);
      for (int i = blockIdx.x * 512 + tid; i < 2048 * 32 + 32; i += G * 512) {
          const int pos = i < 2048 * 32 ? (i >> 5) : PAST, j = i & 31;
          const float inv = exp2f(-(float)j * (13.287712379549449f / 32.0f));
          const float ang = (float)pos * inv; float sn, cs; sincosf(ang, &sn, &cs);
          if (i < 2048 * 32) { rc[i] = cs; rc[2048 * 32 + i] = sn; } else { rc[2 * 2048 * 32 + j] = cs; rc[2 * 2048 * 32 + 32 + j] = sn; }
      } }
    for (int item = blockIdx.x; item < 2 * 384; item += G) {
        const int l = item / 384, cs = item % 384, h = lane >> 5, r = lane & 31;
        const float* W = p.wada + (size_t)l * D * 6 * D + cs * 32 + r;
        const float* c0 = (r < 4) ? p.cp + r * D : p.cs + (r - 4) * D;
        const float* c1 = p.cs + (28 + (r & 3)) * D;
        f32x16 acc0, acc1;
#pragma unroll
        for (int q = 0; q < 16; ++q) { acc0[q] = 0.f; acc1[q] = 0.f; }
#pragma unroll 4
        for (int ks = 0; ks < 16; ++ks) {
            const int k = wave * 256 + ks * 16 + h * 8;
            float w[8];
#pragma unroll
            for (int j = 0; j < 8; ++j) w[j] = W[(size_t)(k + j) * (6 * D)];
            const bf16x8 bfr = pack8(w);
            f32x4 a0 = *(const f32x4*)(c0 + k), a1 = *(const f32x4*)(c0 + k + 4);
            f32x4 e0 = {0.f, 0.f, 0.f, 0.f}, e1 = e0;
            if (r < 4) { e0 = *(const f32x4*)(c1 + k); e1 = *(const f32x4*)(c1 + k + 4); }
#pragma unroll
            for (int q = 0; q < 4; ++q) { a0[q] = silu_f(a0[q]); a1[q] = silu_f(a1[q]); e0[q] = silu_f(e0[q]); e1[q] = silu_f(e1[q]); }
            acc0 = MFMA32(pack8v(a0, a1), bfr, acc0);
            acc1 = MFMA32(pack8v(e0, e1), bfr, acc1);
        }
        LAS float* red = (LAS float*)lds;
#pragma unroll
        for (int q = 0; q < 16; ++q) { red[((wave * 2 + 0) * 16 + q) * 64 + lane] = acc0[q]; red[((wave * 2 + 1) * 16 + q) * 64 + lane] = acc1[q]; }
        __syncthreads();
        for (int idx = tid; idx < NMODROWS * 32; idx += 512) {
            const int row = idx >> 5, col = idx & 31, mt = row >> 5, rr = row & 31, q = (rr >> 3) * 4 + (rr & 3), ln = ((rr >> 2) & 1) * 32 + col;
            float s = 0.f;
#pragma unroll
            for (int w8 = 0; w8 < 8; ++w8) s += red[((w8 * 2 + mt) * 16 + q) * 64 + ln];
            ((float*)(p.ws + WS_MOD))[((size_t)l * NMODROWS + row) * (6 * D) + cs * 32 + col] = s + p.bada[l * 6 * D + cs * 32 + col];
        }
        __syncthreads();
    }
    LAS float* scr = (LAS float*)(lds + wave * 8448);
    constexpr int I_IN = 32 * 112, I_OUT = 32 * 64, I_G = 32 * 176, I_DN = 88 * 64, I_L = I_IN + I_OUT + 2 * I_G + I_DN;
    auto decode = [&](int it) { ConvDesc d; const int l = it / I_L; int r = it % I_L;
        if (r < I_IN) { d.W = p.win + (size_t)l * D * INC; d.WT = (bf16_t*)(p.ws + WS_WIN + l * SZ_WIN); d.K = D; d.N = INC; d.type = 0; d.item = r; return d; } r -= I_IN;
        if (r < I_OUT) { d.W = p.wout + (size_t)l * D * D; d.WT = (bf16_t*)(p.ws + WS_WOUT + l * SZ_WOUT); d.K = D; d.N = D; d.type = 1; d.item = r; return d; } r -= I_OUT;
        if (r < I_G) { d.W = p.wgate + (size_t)l * D * DFF; d.WT = (bf16_t*)(p.ws + WS_WGU + l * SZ_WGU); d.K = D; d.N = DFF; d.type = 2; d.item = r; return d; } r -= I_G;
        if (r < I_G) { d.W = p.wup + (size_t)l * D * DFF; d.WT = (bf16_t*)(p.ws + WS_WGU + l * SZ_WGU); d.K = D; d.N = DFF; d.type = 3; d.item = r; return d; } r -= I_G;
        d.W = p.wdown + (size_t)l * DFF * D; d.WT = (bf16_t*)(p.ws + WS_WDN + l * SZ_WDN); d.K = DFF; d.N = D; d.type = 1; d.item = r; return d; };
    { int it = gw; ConvDesc d = decode(it < 2 * I_L ? it : 0); f32x4 v[8];
      if (it < 2 * I_L) conv_load(d, lane, v);
      while (it < 2 * I_L) {
          const int nit = it + NGW; ConvDesc nd = decode(nit < 2 * I_L ? nit : 0); f32x4 nv[8];
          if (nit < 2 * I_L) conv_load(nd, lane, nv);
          conv_store(d, lane, v, scr);
          it = nit; d = nd;
#pragma unroll
          for (int i = 0; i < 8; ++i) v[i] = nv[i];
      } }
}

DI void phase_norm(const P& p, int l, int which, int wave, int lane) {
    const int gw = blockIdx.x * 8 + wave, NGW = G * 8;
    const float* mod = (const float*)(p.ws + WS_MOD) + (size_t)l * NMODROWS * 6 * D;
    const float* gvec = which == 0 ? p.g1 + l * D : which == 1 ? p.g2 + l * D : p.gfinal;
    const bool first = (l == 0 && which == 0);
    for (int row = gw; row < M + NS; row += NGW) {
        const float* x; bf16_t* o; float* of; int mrow;
        if (row < M) { x = (first ? p.xp : (const float*)(p.ws + WS_XR)) + (size_t)row * D; o = (bf16_t*)(p.ws + WS_XN) + (size_t)row * LDD; of = p.out + O_YP + (size_t)row * D; mrow = row >> 11; }
        else { const int s = row - M; x = (first ? p.xs : (const float*)(p.ws + WS_SMP + SM_XS)) + (size_t)s * D; o = (bf16_t*)(p.ws + WS_SMP + SM_HS) + (size_t)s * D; of = p.out + O_YS + (size_t)s * D; mrow = NB + s; }
        f32x4 v[8]; float ss = 0.f;
#pragma unroll
        for (int j = 0; j < 8; ++j) { v[j] = ((const f32x4*)x)[lane + 64 * j]; ss += (v[j].x * v[j].x + v[j].y * v[j].y) + (v[j].z * v[j].z + v[j].w * v[j].w); }
        const float rstd = rsqrtf(wave_sum(ss) * (1.0f / D) + EPS);
        if (which == 2) {
#pragma unroll
            for (int j = 0; j < 8; ++j) { const f32x4 g = ((const f32x4*)gvec)[lane + 64 * j]; ((f32x4*)of)[lane + 64 * j] = v[j] * rstd * g; }
        } else {
            const float* sh = mod + (size_t)mrow * 6 * D + (which == 0 ? 0 : 3) * D; const float* sc = sh + D;
#pragma unroll
            for (int j = 0; j < 8; ++j) { const f32x4 g = ((const f32x4*)gvec)[lane + 64 * j], c = ((const f32x4*)sc)[lane + 64 * j], h = ((const f32x4*)sh)[lane + 64 * j];
                const f32x4 y = v[j] * rstd * g * (c + 1.0f) + h; u32x2 w; w.x = pk2(y.x, y.y); w.y = pk2(y.z, y.w); ((u32x2*)o)[lane + 64 * j] = w; }
        }
    }
}

struct EpiIn {
    static constexpr bool PERM = false, AFTER_DRAIN = false;
    bf16_t *Q, *K, *V, *U, *GT; float* ssq; const float* rope; float *kwin, *vwin, *gmv; LAS unsigned char* tbuf;
    DI void operator()(const f32x4 (&acc)[2][2][4][2], const pg8::Unit& u, int wr, int wc, int fr, int fq) const {
        const int pn = u.pn, b = u.pm >> 3;
#pragma unroll
        for (int ai = 0; ai < 2; ++ai)
#pragma unroll
            for (int m = 0; m < 4; ++m) {
                const int row = u.pm * 256 + ai * 128 + wr * 64 + m * 16 + fr, t = row & 2047;
                if (pn <= 4) {
                    const int dh = 16 * (wc & 1) + 4 * fq;
                    const f32x4 cs = *(const f32x4*)(rope + t * 32 + dh), sn = *(const f32x4*)(rope + 65536 + t * 32 + dh);
#pragma unroll
                    for (int bj = 0; bj < 2; ++bj) {
                        const f32x4 x1 = acc[ai][bj][m][0], x2 = acc[ai][bj][m][1];
                        const f32x4 o1 = x1 * cs - x2 * sn, o2 = x2 * cs + x1 * sn;
                        const int hc = (2 * bj + (wc >> 1)) * 64 + dh;
                        u32x2 w1, w2; w1.x = pk2(o1.x, o1.y); w1.y = pk2(o1.z, o1.w); w2.x = pk2(o2.x, o2.y); w2.y = pk2(o2.z, o2.w);
                        if (pn < 4) { bf16_t* dst = Q + (size_t)row * 1024 + pn * 256 + hc; *(u32x2*)dst = w1; *(u32x2*)(dst + 32) = w2; }
                        else { bf16_t* dst = K + (size_t)row * 256 + hc; *(u32x2*)dst = w1; *(u32x2*)(dst + 32) = w2;
                            if (t >= 1920) { float* w = kwin + ((size_t)(b * 128 + t - 1920) * 256 + hc); *(f32x4*)w = o1; *(f32x4*)(w + 32) = o2; } }
                    }
                } else if (pn == 5) {
#pragma unroll
                    for (int bj = 0; bj < 2; ++bj) {
                        const int col = 128 * bj + 32 * wc + 8 * fq; const f32x4 v0 = acc[ai][bj][m][0], v1 = acc[ai][bj][m][1];
                        u32x4 w; w.x = pk2(v0.x, v0.y); w.y = pk2(v0.z, v0.w); w.z = pk2(v1.x, v1.y); w.w = pk2(v1.z, v1.w);
                        *(u32x4*)(V + (size_t)row * 256 + col) = w;
                        if (t >= 1920) { float* o = vwin + ((size_t)(b * 128 + t - 1920) * 256 + col); *(f32x4*)o = v0; *(f32x4*)(o + 4) = v1; }
                    }
                } else if (pn < 10) {
#pragma unroll
                    for (int bj = 0; bj < 2; ++bj) {
                        const int col = 256 * (pn - 6) + 128 * bj + 32 * wc + 8 * fq; f32x4 v0 = acc[ai][bj][m][0], v1 = acc[ai][bj][m][1];
#pragma unroll
                        for (int e = 0; e < 4; ++e) { v0[e] = gelu_tanh(v0[e]); v1[e] = gelu_tanh(v1[e]); }
                        u32x4 w; w.x = pk2(v0.x, v0.y); w.y = pk2(v0.z, v0.w); w.z = pk2(v1.x, v1.y); w.w = pk2(v1.z, v1.w);
                        *(u32x4*)(U + (size_t)row * 1024 + col) = w;
                    }
                } else {
                    float s = 0.f; LAS unsigned char* tb = tbuf + (wr * 4 + wc) * 2048;
#pragma unroll
                    for (int bj = 0; bj < 2; ++bj)
#pragma unroll
                        for (int n = 0; n < 2; ++n) {
                            const int col = 256 * (pn - 10) + 128 * bj + 32 * wc + 16 * n + 4 * fq; f32x4 g = acc[ai][bj][m][n];
#pragma unroll
                            for (int e = 0; e < 4; ++e) { g[e] = gelu_tanh(g[e]); s += g[e] * g[e]; *(LAS unsigned short*)(tb + (32 * bj + 16 * n + 4 * fq + e) * 32 + fr * 2) = (unsigned short)f2bf(g[e]); }
                            if (t >= 1920) *(f32x4*)(gmv + ((size_t)(b * 128 + t - 1920) * 1024 + col)) = g;
                        }
                    asm volatile("s_waitcnt lgkmcnt(0)" ::: "memory");
                    { const int lane = fq * 16 + fr, t0 = (u.pm * 256 + ai * 128 + wr * 64 + m * 16) & 2047;
#pragma unroll
                      for (int q = 0; q < 2; ++q) { const int id = lane + 64 * q, lc = id & 63, half = id >> 6;
                          const u32x4 v = *(const LAS u32x4*)(tb + lc * 32 + half * 16);
                          const int col = 256 * (pn - 10) + 128 * (lc >> 5) + 32 * wc + (lc & 31);
                          *(u32x4*)(GT + ((((size_t)b * 256 + (t0 >> 3) + half) * 1024 + col) << 3)) = v; }
                    }
                    asm volatile("s_waitcnt lgkmcnt(0)" ::: "memory");
                    s += __shfl_xor(s, 16); s += __shfl_xor(s, 32);
                    if (fq == 0) __hip_atomic_fetch_add(ssq + row, s, __ATOMIC_RELAXED, __HIP_MEMORY_SCOPE_AGENT);
                }
            }
    }
};
struct EpiRes {
    static constexpr bool PERM = false, AFTER_DRAIN = false;
    const float* base; float* out; const float* gate;
    DI void operator()(const f32x4 (&acc)[2][2][4][2], const pg8::Unit& u, int wr, int wc, int fr, int fq) const {
        const int b = u.pm >> 3; const int col0 = u.pn * 256 + wc * 32 + 4 * fq;
        f32x4 gv[2][2];
#pragma unroll
        for (int bj = 0; bj < 2; ++bj)
#pragma unroll
            for (int n = 0; n < 2; ++n) gv[bj][n] = *(const f32x4*)(gate + (size_t)b * 6 * D + col0 + bj * 128 + n * 16);
#pragma unroll
        for (int ai = 0; ai < 2; ++ai) {
            f32x4 bs[4][2][2];
#pragma unroll
            for (int m = 0; m < 4; ++m) { const size_t off = (size_t)(u.pm * 256 + ai * 128 + wr * 64 + m * 16 + fr) * D + col0;
#pragma unroll
                for (int bj = 0; bj < 2; ++bj)
#pragma unroll
                    for (int n = 0; n < 2; ++n) bs[m][bj][n] = *(const f32x4*)(base + off + bj * 128 + n * 16); }
#pragma unroll
            for (int m = 0; m < 4; ++m) { const size_t off = (size_t)(u.pm * 256 + ai * 128 + wr * 64 + m * 16 + fr) * D + col0;
#pragma unroll
                for (int bj = 0; bj < 2; ++bj)
#pragma unroll
                    for (int n = 0; n < 2; ++n) *(f32x4*)(out + off + bj * 128 + n * 16) = bs[m][bj][n] + gv[bj][n] * acc[ai][bj][m][n]; }
            asm volatile("" ::: "memory"); }
    }
};
DI float dpp_ror1(float v) { return __builtin_bit_cast(float, __builtin_amdgcn_update_dpp(0, __builtin_bit_cast(int, v), 0x121, 0xf, 0xf, false)); }
DI float dpp_ror2(float v) { return __builtin_bit_cast(float, __builtin_amdgcn_update_dpp(0, __builtin_bit_cast(int, v), 0x122, 0xf, 0xf, false)); }
struct EpiGU {
    static constexpr bool PERM = false, AFTER_DRAIN = false;
    bf16_t* ACT; float* SA; float* SU; float* cvp; const float* cw; const float* cb;
    DI void operator()(const f32x4 (&acc)[2][2][4][2], const pg8::Unit& u, int wr, int wc, int fr, int fq) const {
        const int b = u.pm >> 3, f0 = u.pn * 128 + wc * 32 + 8 * fq;
        float w0[8], w1[8], w2[8], bb[8];
#pragma unroll
        for (int q = 0; q < 2; ++q) { const f32x4 x0 = *(const f32x4*)(cw + f0 + 4 * q), x1 = *(const f32x4*)(cw + DFF + f0 + 4 * q), x2 = *(const f32x4*)(cw + 2 * DFF + f0 + 4 * q), x3 = *(const f32x4*)(cb + f0 + 4 * q);
#pragma unroll
            for (int e = 0; e < 4; ++e) { w0[4 * q + e] = x0[e]; w1[4 * q + e] = x1[e]; w2[4 * q + e] = x2[e]; bb[4 * q + e] = x3[e]; } }
#pragma unroll
        for (int ai = 0; ai < 2; ++ai) {
            const int blk = u.pm * 4 + ai * 2 + wr;
#pragma unroll
            for (int m = 0; m < 4; ++m) { const int row = u.pm * 256 + ai * 128 + wr * 64 + m * 16 + fr, t = row & 2047;
                float o[8];
#pragma unroll
                for (int n = 0; n < 2; ++n)
#pragma unroll
                    for (int e = 0; e < 4; ++e) { const float a = acc[ai][0][m][n][e], ap = acc[ai][0][m > 0 ? m - 1 : 0][n][e];
                        const float r1a = dpp_ror1(a), r1b = dpp_ror1(ap), r2a = dpp_ror2(a), r2b = dpp_ror2(ap);
                        const float p1 = fr >= 1 ? r1a : r1b, p2 = fr >= 2 ? r2a : r2b;
                        const int c = 4 * n + e; const float cv = bb[c] + w0[c] * p2 + w1[c] * p1 + w2[c] * a;
                        o[c] = silu_f(cv) * acc[ai][1][m][n][e]; }
                const f32x4 g0 = acc[ai][0][m][0], g1 = acc[ai][0][m][1];
                if (m == 0 && fr < 2) {
                    float* sa = SA + ((size_t)(blk * 4 + 2 + fr)) * DFF + f0; *(f32x4*)sa = g0; *(f32x4*)(sa + 4) = g1;
                    float* su = SU + ((size_t)(blk * 2 + fr)) * DFF + f0; *(f32x4*)su = acc[ai][1][m][0]; *(f32x4*)(su + 4) = acc[ai][1][m][1];
                } else {
                    u32x4 w; w.x = pk2(o[0], o[1]); w.y = pk2(o[2], o[3]); w.z = pk2(o[4], o[5]); w.w = pk2(o[6], o[7]);
                    *(u32x4*)(ACT + (size_t)row * LDF + f0) = w;
                }
                if (m == 3 && fr >= 14) { float* sa = SA + ((size_t)(blk * 4 + fr - 14)) * DFF + f0; *(f32x4*)sa = g0; *(f32x4*)(sa + 4) = g1; }
                if (t >= 2046) { float* oo = cvp + ((size_t)(b * 2 + t - 2046) * DFF + f0); *(f32x4*)oo = g0; *(f32x4*)(oo + 4) = g1; }
            }
        }
    }
};

struct EpiNull {
    static constexpr bool PERM = false, AFTER_DRAIN = false;
    float* sink;
    DI void operator()(const f32x4 (&acc)[2][2][4][2], const pg8::Unit& u, int wr, int wc, int fr, int fq) const {
        f32x4 s = {0.f, 0.f, 0.f, 0.f};
#pragma unroll
        for (int ai = 0; ai < 2; ++ai)
#pragma unroll
            for (int bj = 0; bj < 2; ++bj)
#pragma unroll
                for (int m = 0; m < 4; ++m)
#pragma unroll
                    for (int n = 0; n < 2; ++n) s += acc[ai][bj][m][n];
        if (s.x + s.y + s.z + s.w == 1234567.0f) sink[8191] = s.x;
    }
};
DI void attn_unit(const P& p, int l, int unit, LAS unsigned char* lds, int tid, int wave, int lane) {
    const int b = unit >> 6, n = (unit >> 2) & 15, kvh = unit & 3;
    const bf16_t* Kb = (const bf16_t*)(p.ws + WS_K); const bf16_t* Vb = (const bf16_t*)(p.ws + WS_V); const bf16_t* Qb = (const bf16_t*)(p.ws + WS_Q);
    bf16_t* MIX = (bf16_t*)(p.ws + WS_MIX);
    LAS unsigned char* Ks = lds;
    LAS unsigned char* Vt = lds + 256 * 144;
    const int tok0 = b * 2048 + (n - 1) * 128;
#pragma unroll
    for (int i = 0; i < 4; ++i) { const int id = i * 512 + tid, key = id >> 3, part = id & 7;
        u32x4 v = {0u, 0u, 0u, 0u}; if (n > 0 || key >= 128) v = *(const u32x4*)(Kb + (size_t)(tok0 + key) * 256 + kvh * 64 + part * 8);
        *(LAS u32x4*)(Ks + key * 144 + part * 16) = v; }
#pragma unroll
    for (int i = 0; i < 4; ++i) { const int id = i * 512 + tid, key = id & 255, part = id >> 8;
        u32x4 v = {0u, 0u, 0u, 0u}; if (n > 0 || key >= 128) v = *(const u32x4*)(Vb + (size_t)(tok0 + key) * 256 + kvh * 64 + part * 8);
        LAS unsigned short* d = (LAS unsigned short*)(Vt + (part * 8) * 528 + key * 2);
        d[0 * 264] = (unsigned short)(v.x & 0xffffu); d[1 * 264] = (unsigned short)(v.x >> 16); d[2 * 264] = (unsigned short)(v.y & 0xffffu); d[3 * 264] = (unsigned short)(v.y >> 16);
        d[4 * 264] = (unsigned short)(v.z & 0xffffu); d[5 * 264] = (unsigned short)(v.z >> 16); d[6 * 264] = (unsigned short)(v.w & 0xffffu); d[7 * 264] = (unsigned short)(v.w >> 16); }
    __syncthreads();
    const int q16 = lane & 15, g4 = lane >> 4;
    for (int it = 0; it < 4; ++it) {
        const int qg = wave * 4 + it, g = qg >> 3, i0 = (qg & 7) * 16, head = kvh * 4 + g, nt0 = i0 >> 4;
        const size_t qtok = (size_t)b * 2048 + n * 128 + i0 + q16;
        const bf16x8 q0 = *(const bf16x8*)(Qb + qtok * 1024 + head * 64 + g4 * 8), q1 = *(const bf16x8*)(Qb + qtok * 1024 + head * 64 + 32 + g4 * 8);
        f32x4 s[9];
#pragma unroll
        for (int tt = 0; tt < 9; ++tt) { const LAS unsigned char* kp = Ks + ((nt0 + tt) * 16 + q16) * 144 + g4 * 16;
            const bf16x8 a0 = *(const LAS bf16x8*)kp, a1 = *(const LAS bf16x8*)(kp + 64);
            f32x4 z = {0.f, 0.f, 0.f, 0.f}; z = MFMA16(a0, q0, z); s[tt] = MFMA16(a1, q1, z); }
        const int iq = i0 + q16; float mx = -1e30f;
#pragma unroll
        for (int tt = 0; tt < 9; ++tt)
#pragma unroll
            for (int r = 0; r < 4; ++r) { const int j = (nt0 + tt) * 16 + g4 * 4 + r; const bool ok = (j >= iq) && (j <= iq + 128) && (n > 0 || j >= 128);
                const float v = ok ? s[tt][r] * 0.125f : -1e30f; s[tt][r] = v; mx = fmaxf(mx, v); }
        mx = fmaxf(mx, __shfl_xor(mx, 16)); mx = fmaxf(mx, __shfl_xor(mx, 32));
        const float sink = p.sinks[l * NH + head]; const float mm = fmaxf(mx, sink);
        float sum = 0.f;
#pragma unroll
        for (int tt = 0; tt < 9; ++tt)
#pragma unroll
            for (int r = 0; r < 4; ++r) { const float e = __expf(s[tt][r] - mm); s[tt][r] = e; sum += e; }
        sum += __shfl_xor(sum, 16); sum += __shfl_xor(sum, 32);
        const float inv = 1.0f / (sum + __expf(sink - mm));
        f32x4 o[4];
#pragma unroll
        for (int dt = 0; dt < 4; ++dt) o[dt] = (f32x4){0.f, 0.f, 0.f, 0.f};
#pragma unroll
        for (int i = 0; i < 5; ++i) {
            const f32x4 pl = s[2 * i], ph = (2 * i + 1 < 9) ? s[(2 * i + 1 < 9) ? 2 * i + 1 : 8] : (f32x4){0.f, 0.f, 0.f, 0.f};
            const bf16x8 pb = pack8v(pl, ph);
#pragma unroll
            for (int dt = 0; dt < 4; ++dt) { const LAS unsigned char* vp = Vt + (16 * dt + q16) * 528 + ((nt0 + 2 * i) * 16 + g4 * 4) * 2;
                u32x4 va; const u32x2 lo = *(const LAS u32x2*)vp; va.x = lo.x; va.y = lo.y;
                if (2 * i + 1 < 9) { const u32x2 hi = *(const LAS u32x2*)(vp + 32); va.z = hi.x; va.w = hi.y; } else { va.z = 0u; va.w = 0u; }
                o[dt] = MFMA16(__builtin_bit_cast(bf16x8, va), pb, o[dt]); }
        }
#pragma unroll
        for (int dt = 0; dt < 4; ++dt) { u32x2 w; w.x = pk2(o[dt].x * inv, o[dt].y * inv); w.y = pk2(o[dt].z * inv, o[dt].w * inv);
            *(u32x2*)(MIX + qtok * LDD + head * 64 + 16 * dt + 4 * g4) = w; }
    }
    __syncthreads();
}

DI void gmlp_unit(const P& p, int l, int unit, int wave, int lane) {
    const int b = unit >> 7, c = (unit >> 3) & 15, h = unit & 7;
    const int q16 = lane & 15, g4 = lane >> 4, i = 16 * wave + q16;
    const float* Wrow = p.gmws + (((size_t)l * 8 + h) * 128 + i) * 128;
    const float* ssq = (const float*)(p.ws + WS_SSQ) + l * M + b * 2048 + c * 128;
    const bf16_t* GT = (const bf16_t*)(p.ws + WS_GT) + (((size_t)(b * 16 + c) * 16) * 1024 + h * 128) * 8;
    const bf16_t* U = (const bf16_t*)(p.ws + WS_U); bf16_t* MIX = (bf16_t*)(p.ws + WS_MIX);
    f32x4 acc[8];
#pragma unroll
    for (int dt = 0; dt < 8; ++dt) acc[dt] = (f32x4){0.f, 0.f, 0.f, 0.f};
    const int ksmax = wave >> 1;
    for (int ks = 0; ks <= ksmax; ++ks) {
        const int j0 = 32 * ks + 8 * g4;
        const f32x4 w0 = *(const f32x4*)(Wrow + j0), w1 = *(const f32x4*)(Wrow + j0 + 4), s0 = *(const f32x4*)(ssq + j0), s1 = *(const f32x4*)(ssq + j0 + 4);
        float wv[8];
#pragma unroll
        for (int jj = 0; jj < 4; ++jj) { wv[jj] = (j0 + jj <= i) ? w0[jj] * rsqrtf(s0[jj] * (1.0f / GMW) + EPS) : 0.f; wv[4 + jj] = (j0 + 4 + jj <= i) ? w1[jj] * rsqrtf(s1[jj] * (1.0f / GMW) + EPS) : 0.f; }
        const bf16x8 bw = pack8(wv);
#pragma unroll
        for (int dt = 0; dt < 8; ++dt) { const bf16x8 a = *(const bf16x8*)(GT + ((size_t)(4 * ks + g4) * 1024 + 16 * dt + q16) * 8); acc[dt] = MFMA16(a, bw, acc[dt]); }
    }
    const size_t tok = (size_t)b * 2048 + c * 128 + i;
    const float bias = p.gmbs[(l * 8 + h) * 128 + i];
#pragma unroll
    for (int dt = 0; dt < 8; ++dt) { const int col = h * 128 + 16 * dt + 4 * g4;
        const f32x4 gain = *(const f32x4*)(p.gmgain + l * GMW + col); const u32x2 uu = *(const u32x2*)(U + tok * 1024 + col);
        const float o0 = bflo(uu.x) * (gain.x * acc[dt].x + bias), o1 = bfhi(uu.x) * (gain.y * acc[dt].y + bias), o2 = bflo(uu.y) * (gain.z * acc[dt].z + bias), o3 = bfhi(uu.y) * (gain.w * acc[dt].w + bias);
        u32x2 w; w.x = pk2(o0, o1); w.y = pk2(o2, o3); *(u32x2*)(MIX + tok * LDD + 1024 + col) = w; }
}

DI void sample_part(const P& p, int l, int s, int hp, LAS unsigned char* lds, int tid, int wave, int lane) {
    const float* qS = (const float*)(p.ws + WS_SMP + SM_Q) + s * 1024; const float* kS = (const float*)(p.ws + WS_SMP + SM_KK) + s * 256; const float* vS = (const float*)(p.ws + WS_SMP + SM_VV) + s * 256;
    const float* uS = (const float*)(p.ws + WS_SMP + SM_UU) + s * 1024; const float* gS = (const float*)(p.ws + WS_SMP + SM_GG) + s * 1024;
    bf16_t* mix = (bf16_t*)(p.ws + WS_SMP + SM_MIX) + s * 2048;
    const float* ck = p.ck + ((size_t)l * NS + s) * WIN * KVW; const float* cv = p.cv + ((size_t)l * NS + s) * WIN * KVW;
    LAS float* red = (LAS float*)lds;
    LAS float* ql = (LAS float*)(lds + 128);
    LAS float* pl = (LAS float*)(lds + 128 + 512);
    LAS float* po = (LAS float*)(lds + 128 + 512 + 1056);
    const int kvh = hp >> 1, hh = tid >> 8, j = tid & 255, head = 2 * hp + hh;
    const float g0 = gS[tid], g1 = gS[tid + 512];
    if (tid < 128) ql[tid] = qS[2 * hp * 64 + tid];
    f32x4 kk[16];
    { const float* kr = (j < 128) ? ck + (size_t)j * KVW + kvh * 64 : kS + kvh * 64;
#pragma unroll
      for (int e = 0; e < 16; ++e) kk[e] = (j < 129) ? ((const f32x4*)kr)[e] : (f32x4){0.f, 0.f, 0.f, 0.f}; }
    { float* ko = p.out + O_KWS + ((size_t)l * NS + s) * WIN * KVW; float* vo = p.out + O_VWS + ((size_t)l * NS + s) * WIN * KVW;
#pragma unroll
      for (int q = 0; q < 2; ++q) { const int i = hp * 1024 + tid + 512 * q, jj = i >> 6, c4 = i & 63;
          const f32x4 kv = (jj < 127) ? ((const f32x4*)ck)[(jj + 1) * 64 + c4] : ((const f32x4*)kS)[c4];
          const f32x4 vv = (jj < 127) ? ((const f32x4*)cv)[(jj + 1) * 64 + c4] : ((const f32x4*)vS)[c4];
          ((f32x4*)ko)[i] = kv; ((f32x4*)vo)[i] = vv; } }
    float ss = wave_sum(g0 * g0 + g1 * g1);
    if (lane == 0) red[wave] = ss;
    __syncthreads();
    if (tid < 128) { float tot = 0.f;
#pragma unroll
        for (int w = 0; w < 8; ++w) tot += red[w];
        const float rstd = rsqrtf(tot * (1.0f / GMW) + EPS); const int c = 128 * hp + tid;
        const float gvn = gS[c] * rstd * p.gmgain[l * GMW + c];
        p.out[O_GMS + ((size_t)l * NS + s) * GMW + c] = gvn;
        const float sv = p.gmws[((size_t)l * 8 + hp) * 128 * 128] * gvn + p.gmbs[(l * 8 + hp) * 128];
        mix[1024 + c] = (bf16_t)f2bf(uS[c] * sv); }
    float sc = -1e30f;
    if (j < 129) { float d = 0.f;
#pragma unroll
        for (int e = 0; e < 16; ++e) { const LAS float* qq = ql + hh * 64 + 4 * e; d += kk[e].x * qq[0] + kk[e].y * qq[1] + kk[e].z * qq[2] + kk[e].w * qq[3]; }
        sc = d * 0.125f; }
    float mx = sc;
#pragma unroll
    for (int o = 1; o < 64; o <<= 1) mx = fmaxf(mx, __shfl_xor(mx, o));
    if (lane == 0) red[8 + wave] = mx;
    __syncthreads();
    mx = fmaxf(fmaxf(red[8 + 4 * hh], red[9 + 4 * hh]), fmaxf(red[10 + 4 * hh], red[11 + 4 * hh]));
    const float sink = p.sinks[l * NH + head], mm = fmaxf(mx, sink);
    const float pe = (j < 129) ? __expf(sc - mm) : 0.f;
    const float sm = wave_sum(pe);
    if (lane == 0) red[16 + wave] = sm;
    __syncthreads();
    const float inv = 1.0f / ((red[16 + 4 * hh] + red[17 + 4 * hh]) + (red[18 + 4 * hh] + red[19 + 4 * hh]) + __expf(sink - mm));
    if (j < 129) pl[hh * 132 + j] = pe * inv;
    __syncthreads();
    { const int part = (tid >> 5) & 7, d2 = (tid & 31) * 2; float o0 = 0.f, o1 = 0.f; f32x2 vv[16];
#pragma unroll
      for (int q = 0; q < 16; ++q) vv[q] = *(const f32x2*)(cv + (size_t)(part * 16 + q) * KVW + kvh * 64 + d2);
#pragma unroll
      for (int q = 0; q < 16; ++q) { const float pj = pl[hh * 132 + part * 16 + q]; o0 += pj * vv[q].x; o1 += pj * vv[q].y; }
      if (part == 0) { const float pj = pl[hh * 132 + 128]; const f32x2 v2 = *(const f32x2*)(vS + kvh * 64 + d2); o0 += pj * v2.x; o1 += pj * v2.y; }
      po[(hh * 8 + part) * 64 + d2] = o0; po[(hh * 8 + part) * 64 + d2 + 1] = o1; }
    __syncthreads();
    if (tid < 128) { const int h2 = tid >> 6, d = tid & 63; float o = 0.f;
#pragma unroll
        for (int q = 0; q < 8; ++q) o += po[(h2 * 8 + q) * 64 + d];
        mix[(2 * hp + h2) * 64 + d] = (bf16_t)f2bf(o); }
    __syncthreads();
}

DI void gmv_fix(const P& p, int l, int tid) {
    float* gmv = p.out + O_GMP + (size_t)l * NB * 128 * GMW; const float* ssq = (const float*)(p.ws + WS_SSQ) + l * M;
    for (int i = blockIdx.x * 512 + tid; i < NB * 128 * GMW / 4; i += G * 512) { const int c4 = i & 255, r = i >> 8, b = r >> 7, tt = r & 127;
        const float rs = rsqrtf(ssq[b * 2048 + 1920 + tt] * (1.0f / GMW) + EPS); const f32x4 g = ((const f32x4*)(p.gmgain + l * GMW))[c4];
        f32x4 v = ((f32x4*)gmv)[i]; v = v * rs * g; ((f32x4*)gmv)[i] = v; }
}

DI void phase_fix(const P& p, int l, int tid) {
    const float* SA = (const float*)(p.ws + WS_GA); const float* SU = SA + (size_t)128 * 4 * DFF; bf16_t* ACT = (bf16_t*)(p.ws + WS_UP);
    const float* cw = p.convw + (size_t)l * 3 * DFF; const float* cb = p.convb + (size_t)l * DFF;
    constexpr int NC4 = DFF / 4;
    for (int task = blockIdx.x * 512 + tid; task < 128 * 2 * NC4; task += G * 512) {
        const int c4 = task % NC4, rr = task / NC4, blk = rr >> 1, r = rr & 1, f = c4 * 4; const bool first = (blk & 31) == 0;
        const f32x4 z = {0.f, 0.f, 0.f, 0.f};
        const float* cur = SA + (size_t)blk * 4 * DFF + f; const float* prv = SA + (size_t)(blk - 1) * 4 * DFF + f;
        const f32x4 a2 = *(const f32x4*)(cur + (2 + r) * DFF);
        const f32x4 a1 = r ? *(const f32x4*)(cur + 2 * DFF) : (first ? z : *(const f32x4*)(prv + DFF));
        const f32x4 a0 = r ? (first ? z : *(const f32x4*)(prv + DFF)) : (first ? z : *(const f32x4*)prv);
        const f32x4 uu = *(const f32x4*)(SU + ((size_t)(blk * 2 + r)) * DFF + f);
        const f32x4 x0 = *(const f32x4*)(cw + f), x1 = *(const f32x4*)(cw + DFF + f), x2 = *(const f32x4*)(cw + 2 * DFF + f), x3 = *(const f32x4*)(cb + f);
        float o[4];
#pragma unroll
        for (int e = 0; e < 4; ++e) o[e] = silu_f(x3[e] + x0[e] * a0[e] + x1[e] * a1[e] + x2[e] * a2[e]) * uu[e];
        u32x2 w; w.x = pk2(o[0], o[1]); w.y = pk2(o[2], o[3]);
        *(u32x2*)(ACT + (size_t)(blk * 64 + r) * LDF + f) = w;
    }
}
template <int NBLK, int K, class Epi>
#ifndef SK_REPEAT
#define SK_REPEAT 1
#endif
DI void skinny(LAS unsigned char* lds, const bf16_t* A, const bf16_t* B0, const bf16_t* B1, int wave, int lane, const Epi& epi) {
  for (int rep = 0; rep < SK_REPEAT; ++rep) {
    asm volatile("" ::: "memory");
    const int r = lane & 31, h = lane >> 5; constexpr int kw = K / 8;
    const bf16_t* ap = A + (size_t)r * K + wave * kw + h * 8;
    const bf16_t* b0 = B0 + (size_t)r * (K + 64) + wave * kw + h * 8;
    const bf16_t* b1 = (NBLK == 2 ? B1 : B0) + (size_t)r * (K + 64) + wave * kw + h * 8;
    f32x16 acc0, acc1;
#pragma unroll
    for (int q = 0; q < 16; ++q) { acc0[q] = 0.f; acc1[q] = 0.f; }
#pragma unroll (K == 2048 ? 16 : 11)
    for (int k = 0; k < kw; k += 16) { const bf16x8 a = *(const bf16x8*)(ap + k);
        acc0 = MFMA32(*(const bf16x8*)(b0 + k), a, acc0);
        if (NBLK == 2) acc1 = MFMA32(*(const bf16x8*)(b1 + k), a, acc1); }
    LAS float* red = (LAS float*)lds;
#pragma unroll
    for (int q = 0; q < 16; ++q) { red[((wave * 2 + 0) * 16 + q) * 64 + lane] = acc0[q]; if (NBLK == 2) red[((wave * 2 + 1) * 16 + q) * 64 + lane] = acc1[q]; }
    __syncthreads();
    if (wave == 0) {
#pragma unroll
        for (int q = 0; q < 16; ++q) { float s0 = 0.f, s1 = 0.f;
#pragma unroll
            for (int w = 0; w < 8; ++w) { s0 += red[((w * 2 + 0) * 16 + q) * 64 + lane]; if (NBLK == 2) s1 += red[((w * 2 + 1) * 16 + q) * 64 + lane]; }
            acc0[q] = s0; acc1[q] = s1; }
        if (rep == SK_REPEAT - 1) epi(acc0, acc1, lane);
    }
    __syncthreads();
  }
}
struct SkIn {
    int item; float *qS, *kS, *vS, *uS, *gS; const float* ropeS;
    DI void operator()(const f32x16& acc, const f32x16&, int lane) const {
        const int s = lane & 31, h = lane >> 5, p0 = item * 32, pn = p0 >> 8, bj = (p0 >> 7) & 1, wc = (p0 >> 5) & 3;
        if (pn <= 4) {
#pragma unroll
            for (int q = 0; q < 8; ++q) { const int fq = 2 * ((q >> 2) & 1) + h, e = q & 3, dh = 16 * (wc & 1) + 4 * fq + e;
                const float cs = ropeS[dh], sn = ropeS[32 + dh], x1 = acc[q], x2 = acc[q + 8], o1 = x1 * cs - x2 * sn, o2 = x2 * cs + x1 * sn;
                const int hc = 128 * bj + 64 * (wc >> 1) + dh;
                if (pn < 4) { qS[s * 1024 + pn * 256 + hc] = o1; qS[s * 1024 + pn * 256 + hc + 32] = o2; } else { kS[s * 256 + hc] = o1; kS[s * 256 + hc + 32] = o2; } }
        } else if (pn < 10) {
#pragma unroll
            for (int q = 0; q < 16; ++q) { const int n = q >> 3, fq = 2 * ((q >> 2) & 1) + h, e = q & 3, L = p0 + 8 * fq + 4 * n + e;
                if (pn == 5) vS[s * 256 + L - 1280] = acc[q]; else uS[s * 1024 + L - 1536] = gelu_tanh(acc[q]); }
        } else {
#pragma unroll
            for (int q = 0; q < 16; ++q) { const int L = p0 + (q & 3) + 8 * (q >> 2) + 4 * h; gS[s * 1024 + L - 2560] = gelu_tanh(acc[q]); }
        }
    }
};
struct SkRes {
    int item; const float* base; float* out; const float* gate;
    DI void operator()(const f32x16& acc, const f32x16&, int lane) const {
        const int s = lane & 31, h = lane >> 5;
#pragma unroll
        for (int q = 0; q < 16; ++q) { const int col = item * 32 + (q & 3) + 8 * (q >> 2) + 4 * h;
            out[s * D + col] = base[s * D + col] + gate[(size_t)(NB + s) * 6 * D + col] * acc[q]; }
    }
};
struct SkGU {
    int item, l; const float *sconv, *cw, *cb; bf16_t* act; float* cvs;
    DI void operator()(const f32x16& ga, const f32x16& up, int lane) const {
        const int s = lane & 31, h = lane >> 5, pn = item >> 2, wc = item & 3;
#pragma unroll
        for (int q = 0; q < 16; ++q) { const int n = q >> 3, fq = 2 * ((q >> 2) & 1) + h, e = q & 3, f = 128 * pn + 32 * wc + 8 * fq + 4 * n + e;
            const float p0 = sconv[((size_t)(l * NS + s) * 2 + 0) * DFF + f], p1 = sconv[((size_t)(l * NS + s) * 2 + 1) * DFF + f], a = ga[q];
            const float cv = cb[l * DFF + f] + cw[((size_t)l * 3 + 0) * DFF + f] * p0 + cw[((size_t)l * 3 + 1) * DFF + f] * p1 + cw[((size_t)l * 3 + 2) * DFF + f] * a;
            act[s * DFF + f] = (bf16_t)f2bf(silu_f(cv) * up[q]);
            cvs[((size_t)(l * NS + s) * 2 + 0) * DFF + f] = p1; cvs[((size_t)(l * NS + s) * 2 + 1) * DFF + f] = a; }
    }
};

#ifndef MULTI
#define MULTI 0
#endif
constexpr int NPHASE = 18;
__global__ void __launch_bounds__(512, 2) fwd(Args a) {
    extern __shared__ __attribute__((aligned(16))) unsigned char lds_raw[];
    LAS unsigned char* lds = (LAS unsigned char*)lds_raw;
    cg::grid_group grid = cg::this_grid();
    const int wave0 = __builtin_amdgcn_readfirstlane(threadIdx.x >> 6);
    P p;
    p.xp = a.in[0]; p.xs = a.in[1]; p.ck = a.in[2]; p.cv = a.in[3]; p.sconv = a.in[4]; p.cp = a.in[5]; p.cs = a.in[6]; p.wada = a.in[7]; p.bada = a.in[8];
    p.g1 = a.in[9]; p.g2 = a.in[10]; p.win = a.in[11]; p.gmgain = a.in[12]; p.gmws = a.in[13]; p.gmbs = a.in[14]; p.sinks = a.in[15]; p.wout = a.in[16];
    p.wgate = a.in[17]; p.wup = a.in[18]; p.convw = a.in[19]; p.convb = a.in[20]; p.wdown = a.in[21]; p.gfinal = a.in[22]; p.out = a.out; p.ws = a.ws;
    const int lo = a.ph_lo, hi = a.ph_hi;
#define IN(k) (lo <= (k) && (k) < hi)
#define FRESH() int wv_f = wave0; asm volatile("" : "+s"(wv_f)); int tid_f = wv_f * 64 + (int)__builtin_amdgcn_mbcnt_hi(~0u, __builtin_amdgcn_mbcnt_lo(~0u, 0u)); asm volatile("" : "+v"(tid_f)); const int tid = tid_f, lane = tid & 63, wave = __builtin_amdgcn_readfirstlane(tid >> 6); (void)lane; (void)wave
#ifndef PROBE_MASK
#define PROBE_MASK 0
#endif
#ifndef PROBE_CLK
#define PROBE_CLK 0
#endif
#ifndef PROBE_MUL
#define PROBE_MUL 2
#endif
    unsigned long long pr_acc = 0, pr_t0 = 0, pr_c0 = 0, pr_cacc = 0; (void)pr_c0; (void)pr_cacc;
#define PR_BEGIN(k) do { if (PROBE_MASK & (1u << (k))) { pr_t0 = __builtin_amdgcn_s_memrealtime(); pr_c0 = __builtin_readcyclecounter(); } } while (0)
#define SEAM(k) do { if (IN(k) && IN((k) + 1)) grid.sync(); if (PROBE_MASK & (1u << (k))) { pr_acc += __builtin_amdgcn_s_memrealtime() - pr_t0; pr_cacc += __builtin_readcyclecounter() - pr_c0; } } while (0)
    unsigned char* ws = a.ws;
    bf16_t* XN = (bf16_t*)(ws + WS_XN); float* XR = (float*)(ws + WS_XR); float* XS = (float*)(ws + WS_SMP + SM_XS);
    bf16_t* HS = (bf16_t*)(ws + WS_SMP + SM_HS); bf16_t* MIXS = (bf16_t*)(ws + WS_SMP + SM_MIX); bf16_t* ACTS = (bf16_t*)(ws + WS_SMP + SM_ACT);
    const float* MOD = (const float*)(ws + WS_MOD);

    PR_BEGIN(0);
    if (IN(0)) { FRESH(); phaseA(p, lds, tid, wave, lane); }
    SEAM(0);
    for (int l = 0; l < DEPTH; ++l) {
        const int pb = 1 + 8 * l;
        const bf16_t* Win = (const bf16_t*)(ws + WS_WIN + l * SZ_WIN); const bf16_t* Wout = (const bf16_t*)(ws + WS_WOUT + l * SZ_WOUT);
        const bf16_t* Wgu = (const bf16_t*)(ws + WS_WGU + l * SZ_WGU); const bf16_t* Wdn = (const bf16_t*)(ws + WS_WDN + l * SZ_WDN);
        const float* modl = MOD + (size_t)l * NMODROWS * 6 * D;
        PR_BEGIN(pb + 0);
        if (IN(pb + 0)) { FRESH(); phase_norm(p, l, 0, wave, lane); }
        SEAM(pb + 0);
        PR_BEGIN(pb + 1);
        if (IN(pb + 1)) {
            pg8::Gemm g{XN, Win, M, INC, D}; pg8::StaticOrder S; S.init(M, INC, gridDim.x, blockIdx.x);
            EpiIn E{(bf16_t*)(ws + WS_Q), (bf16_t*)(ws + WS_K), (bf16_t*)(ws + WS_V), (bf16_t*)(ws + WS_U), (bf16_t*)(ws + WS_GT), (float*)(ws + WS_SSQ) + l * M, (const float*)(ws + WS_ROPE),
                    p.out + O_KWP + (size_t)l * NB * WIN * KVW, p.out + O_VWP + (size_t)l * NB * WIN * KVW, p.out + O_GMP + (size_t)l * NB * 128 * GMW, lds + 131072};
            pg8::gemm_phase<EpiIn, pg8::StaticOrder>(lds, g, S, E, nullptr, wave0); FRESH();
            for (int item = (int)gridDim.x - 1 - (int)blockIdx.x; item < INC / 32; item += gridDim.x) {
                SkIn e{item, (float*)(ws + WS_SMP + SM_Q), (float*)(ws + WS_SMP + SM_KK), (float*)(ws + WS_SMP + SM_VV), (float*)(ws + WS_SMP + SM_UU), (float*)(ws + WS_SMP + SM_GG), (const float*)(ws + WS_ROPE) + 2 * 2048 * 32};
                skinny<1, D>(lds, HS, Win + (size_t)item * 32 * LDD, nullptr, wave, lane, e); }
        }
        SEAM(pb + 1);
        PR_BEGIN(pb + 2);
        if (IN(pb + 2)) { FRESH();
#ifndef REP_ATT
#define REP_ATT 1
#endif
#ifndef REP_GM
#define REP_GM 1
#endif
            for (int rep = 0; rep < REP_ATT; ++rep) { asm volatile("" ::: "memory"); for (int u = blockIdx.x; u < NB * 16 * NKV; u += gridDim.x) attn_unit(p, l, u, lds, tid, wave, lane); }
            for (int rep = 0; rep < REP_GM; ++rep) { asm volatile("" ::: "memory"); for (int u = blockIdx.x; u < NB * 16 * 8; u += gridDim.x) gmlp_unit(p, l, u, wave, lane); }
            for (int it = (int)gridDim.x - 1 - (int)blockIdx.x; it < NS * 8; it += gridDim.x) sample_part(p, l, it >> 3, it & 7, lds, tid, wave, lane);
            gmv_fix(p, l, tid);
        }
        SEAM(pb + 2);
        PR_BEGIN(pb + 3);
        if (IN(pb + 3)) {
            pg8::Gemm g{(const bf16_t*)(ws + WS_MIX), Wout, M, D, D}; pg8::StaticOrder S; S.init(M, D, gridDim.x, blockIdx.x);
            EpiRes E{l == 0 ? p.xp : XR, XR, modl + 2 * D};
            pg8::gemm_phase<EpiRes, pg8::StaticOrder>(lds, g, S, E, nullptr, wave0); FRESH();
            for (int item = (int)gridDim.x - 1 - (int)blockIdx.x; item < D / 32; item += gridDim.x) {
                SkRes e{item, l == 0 ? p.xs : XS, XS, modl + 2 * D};
                skinny<1, D>(lds, MIXS, Wout + (size_t)item * 32 * LDD, nullptr, wave, lane, e); }
        }
        SEAM(pb + 3);
        PR_BEGIN(pb + 4);
        if (IN(pb + 4)) { FRESH(); phase_norm(p, l, 1, wave, lane); }
        SEAM(pb + 4);
        PR_BEGIN(pb + 5);
        if (IN(pb + 5)) {
            pg8::Gemm g{XN, Wgu, M, 2 * DFF, D}; pg8::StaticOrder S; S.init(M, 2 * DFF, gridDim.x, blockIdx.x);
            EpiGU E{(bf16_t*)(ws + WS_UP), (float*)(ws + WS_GA), (float*)(ws + WS_GA) + (size_t)128 * 4 * DFF, p.out + O_CVP + (size_t)l * NB * 2 * DFF, p.convw + (size_t)l * 3 * DFF, p.convb + (size_t)l * DFF};
            pg8::gemm_phase<EpiGU, pg8::StaticOrder>(lds, g, S, E, nullptr, wave0);
#if defined(PROBE_GU_EXTRA)
            if (l == 1) { for (int rep = 0; rep < PROBE_GU_EXTRA; ++rep) { grid.sync(); EpiNull EN{(float*)(ws + WS_SSQ)}; pg8::gemm_phase<EpiNull, pg8::StaticOrder>(lds, g, S, EN, nullptr, wave0); } }
#endif
            FRESH();
            for (int item = (int)gridDim.x - 1 - (int)blockIdx.x; item < DFF / 32; item += gridDim.x) {
                SkGU e{item, l, p.sconv, p.convw, p.convb, ACTS, p.out + O_CVS};
                const bf16_t* b0 = Wgu + (size_t)(256 * (item >> 2) + 32 * (item & 3)) * LDD;
                skinny<2, D>(lds, HS, b0, b0 + (size_t)128 * LDD, wave, lane, e); }
        }
        SEAM(pb + 5);
        PR_BEGIN(pb + 6);
        if (IN(pb + 6)) { FRESH(); phase_fix(p, l, tid); }
        SEAM(pb + 6);
        PR_BEGIN(pb + 7);
        if (IN(pb + 7)) {
            pg8::Gemm g{(const bf16_t*)(ws + WS_UP), Wdn, M, D, DFF}; pg8::StaticOrder S; S.init(M, D, gridDim.x, blockIdx.x);
            EpiRes E{XR, XR, modl + 5 * D};
            pg8::gemm_phase<EpiRes, pg8::StaticOrder>(lds, g, S, E, nullptr, wave0); FRESH();
            for (int item = (int)gridDim.x - 1 - (int)blockIdx.x; item < D / 32; item += gridDim.x) {
                SkRes e{item, XS, XS, modl + 5 * D};
                skinny<1, DFF>(lds, ACTS, Wdn + (size_t)item * 32 * LDF, nullptr, wave, lane, e); }
        }
        SEAM(pb + 7);
    }
    if (IN(17)) { FRESH(); phase_norm(p, 0, 2, wave, lane); }
    if (PROBE_MASK) { grid.sync(); if (blockIdx.x == 0) { const unsigned long long t0 = __builtin_amdgcn_s_memrealtime(); const unsigned long long spin = PROBE_CLK ? (pr_cacc * 1000ull / (pr_acc ? pr_acc : 1ull)) : (unsigned long long)PROBE_MUL * pr_acc;
        while (__builtin_amdgcn_s_memrealtime() - t0 < spin) __builtin_amdgcn_s_sleep(8); } }
}

extern "C" void kernel_launch(void* const* d_in, const int* in_sizes, int n_in, void* d_out, int out_size, void* d_ws, size_t ws_size, hipStream_t stream) {
    static int grid = 0;
    if (grid == 0) {
        if (n_in != 23 || (size_t)out_size != O_END || ws_size < WS_END) { fprintf(stderr, "kernel_launch: unexpected shapes: n_in %d out %d (want %zu) ws %zu (want %zu)\n", n_in, out_size, (size_t)O_END, ws_size, (size_t)WS_END); grid = -1; return; }
        int dev = 0, cus = 0, per = 0;
        (void)hipGetDevice(&dev); (void)hipDeviceGetAttribute(&cus, hipDeviceAttributeMultiprocessorCount, dev);
        if (hipFuncSetAttribute((const void*)fwd, hipFuncAttributeMaxDynamicSharedMemorySize, LDS_BYTES) != hipSuccess) { fprintf(stderr, "kernel_launch: hipFuncSetAttribute failed\n"); grid = -1; return; }
        (void)hipOccupancyMaxActiveBlocksPerMultiprocessor(&per, (const void*)fwd, 512, LDS_BYTES);
        if (per < 1) { fprintf(stderr, "kernel_launch: occupancy query says %d blocks per CU\n", per); per = 1; }
        grid = cus * 1;
        fprintf(stderr, "kernel_launch: grid %d (cus %d, per-cu %d)\n", grid, cus, per);
    }
    if (grid < 0) return;
    Args a{};
    for (int i = 0; i < 23; ++i) a.in[i] = (const float*)d_in[i];
    a.out = (float*)d_out; a.ws = (unsigned char*)d_ws;
#if MULTI
    for (int k = 0; k < NPHASE; ++k) { a.ph_lo = k; a.ph_hi = k + 1; hipLaunchKernelGGL(fwd, dim3(grid), dim3(512), LDS_BYTES, stream, a); }
#else
    a.ph_lo = 0; a.ph_hi = NPHASE;
    void* args[] = {&a};
    hipError_t e = hipLaunchCooperativeKernel((void*)fwd, dim3(grid), dim3(512), args, LDS_BYTES, stream);
    if (e != hipSuccess) fprintf(stderr, "kernel_launch: cooperative launch failed: %s (grid %d)\n", hipGetErrorString(e), grid);
#endif
}
```

```cpp
#include <hip/hip_runtime.h>
#include <hip/hip_cooperative_groups.h>
#include <cstdio>
namespace cg = cooperative_groups;
namespace pg8 {
#define PG8_LAS __attribute__((address_space(3)))
typedef unsigned short bf16_t;
typedef short bf16x8 __attribute__((ext_vector_type(8)));
typedef float f32x4 __attribute__((ext_vector_type(4)));
typedef unsigned u32x4 __attribute__((ext_vector_type(4)));
constexpr int BM = 256, BK = 64, HALF = 128, HTB = HALF * BK * 2  , STAGE_BYTES = 8 * HTB, NXCD = 8, WGM = 8;

__host__ __device__ __forceinline__ int lds_byte(int r, int c) { const int st = (r >> 4) * 2 + (c >> 5), rr = r & 15, cc = c & 31, ob = rr * 64 + cc * 2; return st * 1024 + (ob ^ (((ob >> 9) & 1) << 5)); }
__host__ __device__ __forceinline__ void stage_rc(int b, int& R, int& C) { const int st = b / 1024, sb = b % 1024, swz = sb ^ (((sb >> 9) & 1) << 5); R = (st >> 1) * 16 + swz / 64; C = (st & 1) * 32 + (swz % 64) / 2; }
__host__ __device__ __forceinline__ int perm32(int rho) { const int n = rho >> 4, i = rho & 15; return 8 * (i >> 2) + 4 * n + (i & 3); }

struct Unit { int pm, pn; };
struct Gemm { const bf16_t* A; const bf16_t* Bt; int M, N, K; };

struct StaticOrder {
    int nM, nN, nwg, G, c;
    __host__ __device__ void init(int M, int N, int G_, int c_) { nM = M / BM; nN = N / BM; nwg = nM * nN; G = G_; c = c_; }
    __host__ __device__ bool next(int i, Unit& u) const {
        const long L = (long)i * G + c; if (L >= nwg) return false;
        int wgid = (int)L; { const int q = nwg / NXCD, r = nwg % NXCD, xcd = wgid % NXCD, off = wgid / NXCD; wgid = (xcd < r ? xcd * (q + 1) : r * (q + 1) + (xcd - r) * q) + off; }
        const int nig = WGM * nN, gid = wgid / nig, fm = gid * WGM, gsz = (nM - fm) < WGM ? (nM - fm) : WGM;
        u.pm = fm + ((wgid % nig) % gsz); u.pn = (wgid % nig) / gsz; return true;
    }
    __device__ __forceinline__ void a_ready(const Unit&) const {}
    __device__ __forceinline__ void done(const Unit&) const {}
};
__device__ __forceinline__ unsigned cvt_pk_bf16(float lo, float hi) { unsigned r; asm volatile("v_cvt_pk_bf16_f32 %0, %1, %2" : "=v"(r) : "v"(lo), "v"(hi)); return r; }
template <class Epi, class Sched, bool STAMP = false>
__device__ __forceinline__ void gemm_phase(PG8_LAS unsigned char* lds, const Gemm g, const Sched& S, const Epi& E, unsigned long long* stamps, int wave_in) {
    int wv_l = wave_in; asm volatile("" : "+s"(wv_l)); int tid_l = wv_l * 64 + (int)__builtin_amdgcn_mbcnt_hi(~0u, __builtin_amdgcn_mbcnt_lo(~0u, 0u)); asm volatile("" : "+v"(tid_l)); const int tid = tid_l, wid = __builtin_amdgcn_readfirstlane(tid >> 6), lane = tid & 63, wr = wid >> 2, wc = wid & 3, fr = lane & 15, fq = lane >> 4;
    const int K = g.K, nt = K / BK, LD = K + 64;
    int ts_lo = 0, ts_hi = 0, nts = 0; const unsigned long long rt_entry = STAMP ? (unsigned long long)wall_clock64() : 0ull;
#define PG8_STAMP() do { if (STAMP && wid == 0 && nts < 64) { const unsigned long long _c = (unsigned long long)clock64(); \
        ts_lo = (lane == nts) ? (int)(unsigned)_c : ts_lo; ts_hi = (lane == nts) ? (int)(unsigned)(_c >> 32) : ts_hi; ++nts; } } while (0)
    PG8_STAMP();
    unsigned voffA[2], voffB[2];
#pragma unroll
    for (int i = 0; i < 2; ++i) { int R, C; stage_rc(tid * 16 + i * 8192, R, C); const int Rb = Epi::PERM ? ((R & ~31) + perm32(R & 31)) : R;
        voffA[i] = (unsigned)(R * LD + C) * 2u; voffB[i] = (unsigned)(Rb * LD + C) * 2u; }
    const size_t kstep = (size_t)(BK * 2);
    const size_t hstep = (size_t)HALF * LD * 2;
    const size_t tstep = 2 * hstep;
    const unsigned ldsw = (unsigned)wid * 1024u;
    const int aoff = lds_byte(wr * 64 + fr, fq * 8), boff = lds_byte(wc * 32 + fr, fq * 8);
#define PG8_SA(b, h) (((b) * 2 + (h)) * HTB)
#define PG8_SB(b, h) ((4 + (b) * 2 + (h)) * HTB)
#define PG8_STAGE(bufoff, gbase, voff) do { _Pragma("unroll") for (int _i = 0; _i < 2; ++_i) \
        __builtin_amdgcn_global_load_lds((const unsigned*)((const char*)(gbase) + (voff)[_i]), (PG8_LAS unsigned*)(lds + (bufoff) + ldsw + _i * 8192), 16, 0, 0); } while (0)
#define PG8_LDA(dst, b, h) do { _Pragma("unroll") for (int m = 0; m < 4; ++m) _Pragma("unroll") for (int k = 0; k < 2; ++k) dst[m][k] = *(const PG8_LAS bf16x8*)(lds + PG8_SA(b, h) + aoff + m * 2048 + k * 1024); } while (0)
#define PG8_LDB(dst, b, h) do { _Pragma("unroll") for (int n = 0; n < 2; ++n) _Pragma("unroll") for (int k = 0; k < 2; ++k) dst[n][k] = *(const PG8_LAS bf16x8*)(lds + PG8_SB(b, h) + boff + n * 2048 + k * 1024); } while (0)
#define PG8_MMA(ai, bj, At, Bt) do { __builtin_amdgcn_s_setprio(1); _Pragma("unroll") for (int m = 0; m < 4; ++m) _Pragma("unroll") for (int n = 0; n < 2; ++n) _Pragma("unroll") for (int k = 0; k < 2; ++k) \
        acc[ai][bj][m][n] = __builtin_amdgcn_mfma_f32_16x16x32_bf16(Bt[n][k], At[m][k], acc[ai][bj][m][n], 0, 0, 0); __builtin_amdgcn_s_setprio(0); } while (0)
#define PG8_WAIT_V(n) asm volatile("s_waitcnt vmcnt(" #n ")" ::: "memory")
#define PG8_WAIT_L(n) asm volatile("s_waitcnt lgkmcnt(" #n ")" ::: "memory")
#define PG8_BAR __builtin_amdgcn_s_barrier()
#define PG8_SCHED __builtin_amdgcn_sched_barrier(0)
    Unit cur, nxt; int ui = 0;
    if (!S.next(0, cur)) return;
    f32x4 acc[2][2][4][2];
#pragma unroll
    for (int a = 0; a < 2; ++a)
#pragma unroll
        for (int b = 0; b < 2; ++b)
#pragma unroll
            for (int m = 0; m < 4; ++m)
#pragma unroll
                for (int n = 0; n < 2; ++n) acc[a][b][m][n] = (f32x4){0.f, 0.f, 0.f, 0.f};
    bf16x8 At[4][2], B0[2][2], B1[2][2];
    const char* cA = (const char*)g.A + (size_t)cur.pm * tstep; const char* cB = (const char*)g.Bt + (size_t)cur.pn * tstep;
    S.a_ready(cur);
    PG8_STAGE(PG8_SB(0, 0), cB, voffB); PG8_STAGE(PG8_SA(0, 0), cA, voffA); PG8_STAGE(PG8_SB(0, 1), cB + hstep, voffB); PG8_STAGE(PG8_SA(0, 1), cA + hstep, voffA);
    if (wr == 1) PG8_BAR;
    PG8_WAIT_V(4); PG8_BAR;
    PG8_STAGE(PG8_SB(1, 0), cB + kstep, voffB); PG8_STAGE(PG8_SA(1, 0), cA + kstep, voffA); PG8_STAGE(PG8_SB(1, 1), cB + hstep + kstep, voffB);
    PG8_WAIT_V(6); PG8_BAR;
    PG8_STAMP();
    for (;;) {
        const bool has_next = S.next(ui + 1, nxt);
        const char* nA = has_next ? (const char*)g.A + (size_t)nxt.pm * tstep : cA; const char* nB = has_next ? (const char*)g.Bt + (size_t)nxt.pn * tstep : cB;
        for (int t = 0; t < nt; t += 2) {
            const bool last = (t == nt - 2);
            const char* a1 = cA + (size_t)(t + 1) * kstep;
            const char* a2 = last ? nA : cA + (size_t)(t + 2) * kstep; const char* b2 = last ? nB : cB + (size_t)(t + 2) * kstep;
            const char* a3 = a2 + kstep; const char* b3 = b2 + kstep;
            if (last && has_next) S.a_ready(nxt);
            PG8_LDB(B0, 0, 0); PG8_SCHED; PG8_LDA(At, 0, 0); PG8_STAGE(PG8_SA(1, 1), a1 + hstep, voffA);
            PG8_WAIT_L(8); PG8_BAR; PG8_WAIT_L(0); PG8_MMA(0, 0, At, B0); PG8_BAR; PG8_SCHED;
            PG8_LDB(B1, 0, 1); PG8_STAGE(PG8_SB(0, 0), b2, voffB);
            PG8_BAR; PG8_WAIT_L(0); PG8_MMA(0, 1, At, B1); PG8_BAR;
            PG8_LDA(At, 0, 1); PG8_STAGE(PG8_SA(0, 0), a2, voffA);
            PG8_BAR; PG8_WAIT_L(0); PG8_MMA(1, 0, At, B0); PG8_BAR; PG8_SCHED;
            PG8_STAGE(PG8_SB(0, 1), b2 + hstep, voffB);
            PG8_WAIT_V(6); PG8_BAR; PG8_MMA(1, 1, At, B1); PG8_BAR;
            PG8_LDB(B0, 1, 0); PG8_SCHED; PG8_LDA(At, 1, 0); PG8_STAGE(PG8_SA(0, 1), a2 + hstep, voffA);
            PG8_WAIT_L(8); PG8_BAR; PG8_WAIT_L(0); PG8_MMA(0, 0, At, B0); PG8_BAR; PG8_SCHED;
            PG8_LDB(B1, 1, 1); PG8_STAGE(PG8_SB(1, 0), b3, voffB);
            PG8_BAR; PG8_WAIT_L(0); PG8_MMA(0, 1, At, B1); PG8_BAR;
            PG8_LDA(At, 1, 1); PG8_STAGE(PG8_SA(1, 0), a3, voffA);
            PG8_BAR; PG8_WAIT_L(0); PG8_MMA(1, 0, At, B0); PG8_BAR; PG8_SCHED;
            PG8_STAGE(PG8_SB(1, 1), b3 + hstep, voffB);
            PG8_WAIT_V(6); PG8_BAR; PG8_MMA(1, 1, At, B1); PG8_BAR;
        }
        PG8_STAMP();
        if constexpr (!Epi::AFTER_DRAIN) { E(acc, cur, wr, wc, fr, fq); S.done(cur); }
        PG8_STAMP();
        if (!has_next) break;
#pragma unroll
        for (int a = 0; a < 2; ++a)
#pragma unroll
            for (int b = 0; b < 2; ++b)
#pragma unroll
                for (int m = 0; m < 4; ++m)
#pragma unroll
                    for (int n = 0; n < 2; ++n) acc[a][b][m][n] = (f32x4){0.f, 0.f, 0.f, 0.f};
        cur = nxt; cA = nA; cB = nB; ++ui;
    }
    PG8_WAIT_V(0);
    if (wr == 0) PG8_BAR;
    PG8_BAR;
    if constexpr (Epi::AFTER_DRAIN) { E.fused(acc, cur, wr, wc, fr, fq, lds, wid, lane); S.done(cur); }
    PG8_STAMP();
    if (STAMP && wid == 0) { stamps[lane] = lane < nts ? (((unsigned long long)(unsigned)ts_hi << 32) | (unsigned)ts_lo) : 0ull;
        if (lane == 62) stamps[62] = rt_entry; if (lane == 63) stamps[63] = (unsigned long long)wall_clock64(); }
#undef PG8_STAMP
#undef PG8_SA
#undef PG8_SB
#undef PG8_STAGE
#undef PG8_LDA
#undef PG8_LDB
#undef PG8_MMA
#undef PG8_WAIT_V
#undef PG8_WAIT_L
#undef PG8_BAR
#undef PG8_SCHED
}
}
using pg8::bf16_t; using pg8::bf16x8; using pg8::f32x4; using pg8::u32x4;
typedef float f32x16 __attribute__((ext_vector_type(16)));
typedef float f32x2 __attribute__((ext_vector_type(2)));
typedef unsigned u32x2 __attribute__((ext_vector_type(2)));
#define LAS __attribute__((address_space(3)))
#define DI __device__ __forceinline__

constexpr int D = 2048, SEQ = 2048, NB = 4, M = NB * SEQ, NS = 32, DEPTH = 2;
constexpr int INC = 3584, DFF = 5632, WIN = 128, NH = 16, NKV = 4, HD = 64, GMW = 1024, KVW = 256, AW = 1024;
constexpr int PAST = 16384;
constexpr float EPS = 1e-6f;
constexpr int NMODROWS = NB + NS;
#define G ((int)gridDim.x)

constexpr size_t O_YP = 0;
constexpr size_t O_YS = O_YP + (size_t)M * D;
constexpr size_t O_KWP = O_YS + (size_t)NS * D;
constexpr size_t O_VWP = O_KWP + (size_t)DEPTH * NB * WIN * KVW;
constexpr size_t O_GMP = O_VWP + (size_t)DEPTH * NB * WIN * KVW;
constexpr size_t O_CVP = O_GMP + (size_t)DEPTH * NB * 128 * GMW;
constexpr size_t O_KWS = O_CVP + (size_t)DEPTH * NB * 2 * DFF;
constexpr size_t O_VWS = O_KWS + (size_t)DEPTH * NS * WIN * KVW;
constexpr size_t O_GMS = O_VWS + (size_t)DEPTH * NS * WIN * KVW;
constexpr size_t O_CVS = O_GMS + (size_t)DEPTH * NS * GMW;
constexpr size_t O_END = O_CVS + (size_t)DEPTH * NS * 2 * DFF;

constexpr size_t MiB = 1u << 20;
constexpr int LDD = D + 64, LDF = DFF + 64;
constexpr size_t SZ_WIN = 15 * MiB, SZ_WOUT = 9 * MiB, SZ_WGU = 46 * MiB, SZ_WDN = 23 * MiB;
constexpr size_t WS_WIN = 0;
constexpr size_t WS_WOUT = WS_WIN + 2 * SZ_WIN;
constexpr size_t WS_WGU = WS_WOUT + 2 * SZ_WOUT;
constexpr size_t WS_WDN = WS_WGU + 2 * SZ_WGU;
constexpr size_t WS_XN = WS_WDN + 2 * SZ_WDN;
constexpr size_t WS_Q = WS_XN + 34 * MiB;
constexpr size_t WS_K = WS_Q + 16 * MiB;
constexpr size_t WS_V = WS_K + 4 * MiB;
constexpr size_t WS_U = WS_V + 4 * MiB;
constexpr size_t WS_GT = WS_U + 16 * MiB;
constexpr size_t WS_MIX = WS_GT + 16 * MiB;
constexpr size_t WS_XR = WS_MIX + 34 * MiB;
constexpr size_t WS_GA = WS_XR + 64 * MiB;
constexpr size_t WS_UP = WS_GA + 88 * MiB;
constexpr size_t WS_MOD = WS_UP + 90 * MiB;
constexpr size_t WS_ROPE = WS_MOD + 4 * MiB;
constexpr size_t WS_SSQ = WS_ROPE + 1 * MiB;
constexpr size_t WS_SMP = WS_SSQ + 1 * MiB;
constexpr size_t WS_BAR = WS_SMP + 4 * MiB;
constexpr size_t WS_END = WS_BAR + 1 * MiB;
constexpr size_t SM_XS = 0;
constexpr size_t SM_HS = SM_XS + 32 * 2048 * 4;
constexpr size_t SM_Q = SM_HS + 32 * 2048 * 2;
constexpr size_t SM_KK = SM_Q + 32 * 1024 * 4;
constexpr size_t SM_VV = SM_KK + 32 * 256 * 4;
constexpr size_t SM_UU = SM_VV + 32 * 256 * 4;
constexpr size_t SM_GG = SM_UU + 32 * 1024 * 4;
constexpr size_t SM_MIX = SM_GG + 32 * 1024 * 4;
constexpr size_t SM_ACT = SM_MIX + 32 * 2048 * 2;
constexpr size_t SM_END = SM_ACT + 32 * 5632 * 2;
static_assert(SM_END <= 4 * MiB, "sample buffers");

constexpr int LDS_BYTES = 148480;

struct Args {
    const float* in[23];
    float* out;
    unsigned char* ws;
    int ph_lo, ph_hi;
};

DI unsigned f2bf(float f) { unsigned u = __builtin_bit_cast(unsigned, f); return (u + 0x7fffu + ((u >> 16) & 1u)) >> 16; }
DI unsigned pk2(float lo, float hi) { return pg8::cvt_pk_bf16(lo, hi); }
DI float bf2f(unsigned short b) { return __builtin_bit_cast(float, ((unsigned)b) << 16); }
DI float bflo(unsigned w) { return __builtin_bit_cast(float, w << 16); }
DI float bfhi(unsigned w) { return __builtin_bit_cast(float, w & 0xffff0000u); }
DI float wave_sum(float v) {
#pragma unroll
    for (int o = 1; o < 64; o <<= 1) v += __shfl_xor(v, o);
    return v;
}
DI float gelu_tanh(float x) {
    const float u = 0.7978845608028654f * (x + 0.044715f * x * x * x);
    return x * __builtin_amdgcn_rcpf(1.0f + __expf(-2.0f * u));
}
DI float silu_f(float x) { return x * __builtin_amdgcn_rcpf(1.0f + __expf(-x)); }

DI int pair8_phys(int r32) { const int fq = r32 >> 3, n = (r32 >> 2) & 1, e = r32 & 3; return 16 * n + 4 * fq + e; }
DI int win_phys(int L) {
    if (L < 1280) { const int h2 = L >> 7, r = L & 127, hd = r >> 6, d = r & 63, n = d >> 5, d5 = d & 31, wcl = d5 >> 4, fq = (d5 >> 2) & 3, e = d5 & 3;
        return 128 * h2 + 32 * (2 * hd + wcl) + 16 * n + 4 * fq + e; }
    if (L < 2560) return (L & ~31) + pair8_phys(L & 31);
    return L;
}

struct ConvDesc { const float* W; bf16_t* WT; int K, N, type, item; };
DI int conv_phys(int type, int L) {
    if (type == 0) return win_phys(L);
    if (type == 1) return L;
    return 256 * (L >> 7) + (type == 3 ? 128 : 0) + (L & 96) + pair8_phys(L & 31);
}
DI void conv_load(const ConvDesc& d, int lane, f32x4 (&v)[8]) {
    const int nblk = d.N / 32, kb = d.item / nblk, nb = d.item % nblk, k0 = 64 * kb, n0 = 32 * nb;
#pragma unroll
    for (int i = 0; i < 8; ++i) { const int kk = 8 * i + (lane >> 3); v[i] = *(const f32x4*)(d.W + (size_t)(k0 + kk) * d.N + n0 + 4 * (lane & 7)); }
}
DI void conv_store(const ConvDesc& d, int lane, const f32x4 (&v)[8], LAS float* scr) {
    const int nblk = d.N / 32, kb = d.item / nblk, nb = d.item % nblk, k0 = 64 * kb, n0 = 32 * nb;
#pragma unroll
    for (int i = 0; i < 8; ++i) { const int kk = 8 * i + (lane >> 3); LAS float* s = scr + kk * 33 + 4 * (lane & 7); s[0] = v[i].x; s[1] = v[i].y; s[2] = v[i].z; s[3] = v[i].w; }
    asm volatile("s_waitcnt lgkmcnt(0)" ::: "memory");
    const int c = lane & 7;
#pragma unroll
    for (int j = 0; j < 4; ++j) { const int n = (lane >> 3) + 8 * j; const LAS float* s = scr + (8 * c) * 33 + n;
        u32x4 o; o.x = pk2(s[0 * 33], s[1 * 33]); o.y = pk2(s[2 * 33], s[3 * 33]); o.z = pk2(s[4 * 33], s[5 * 33]); o.w = pk2(s[6 * 33], s[7 * 33]);
        *(u32x4*)(d.WT + (size_t)conv_phys(d.type, n0 + n) * (d.K + 64) + k0 + 8 * c) = o; }
    asm volatile("s_waitcnt lgkmcnt(0)" ::: "memory");
}

struct P {
    const float *xp, *xs, *ck, *cv, *sconv, *cp, *cs, *wada, *bada, *g1, *g2, *win, *gmgain, *gmws, *gmbs, *sinks, *wout, *wgate, *wup, *convw, *convb, *wdown, *gfinal;
    float* out; unsigned char* ws;
};
#define RLX_AGENT __ATOMIC_RELAXED, __HIP_MEMORY_SCOPE_AGENT
#define XB_TMO      128
#define XB_XCNT(j)  (256  + 64 * (j))
#define XB_XSUB(j)  (1280 + 64 * (j))
#define XB_XGEN(j)  (2304 + 64 * (j))
#define XB_TOP      3328
#define XB_TOPGEN   3392
#define XCD_BAR_WORDS 3456
#define XB_SPIN_CAP (1u << 18)

__device__ __forceinline__ unsigned xb_ld(unsigned* p)              { return __hip_atomic_load(p, __ATOMIC_RELAXED, __HIP_MEMORY_SCOPE_AGENT); }
__device__ __forceinline__ unsigned xb_add(unsigned* p, unsigned v) { return __hip_atomic_fetch_add(p, v, __ATOMIC_RELAXED, __HIP_MEMORY_SCOPE_AGENT); }
__device__ __forceinline__ unsigned xb_xcc_id() { return (unsigned)__builtin_amdgcn_s_getreg((3 << 11) | 20) & 0xFu; }
#define XB_SPIN(cond, bar) do { unsigned _sp = 0; while (cond) { __builtin_amdgcn_s_sleep(1); \
    if ((++_sp & 255u) == 0u) { if (xb_ld(&(bar)[XB_TMO])) break; if (_sp > XB_SPIN_CAP) { atomicAdd(&(bar)[XB_TMO], 1u); break; } } } } while (0)

struct XcdBarrier {
    unsigned* bar; unsigned x;
    volatile LAS unsigned* st;
};

__device__ __forceinline__ XcdBarrier xcd_barrier_post(unsigned* bar, volatile LAS unsigned* st) {
    XcdBarrier b; b.bar = bar; b.x = xb_xcc_id(); b.st = st;
    if (threadIdx.x == 0) (void)xb_add(&bar[XB_XCNT(b.x)], 1u);
    return b;
}
__device__ __forceinline__ void xcd_barrier_complete(unsigned* bar, unsigned x, unsigned& nloc, unsigned& nx) {
    const unsigned GG = gridDim.x * gridDim.y * gridDim.z;
    unsigned sum, cnt, mine, sp = 0u;
    for (;;) {
        sum = 0u; cnt = 0u; mine = 0u;
#pragma unroll
        for (unsigned j = 0; j < 16; ++j) { const unsigned c = xb_ld(&bar[XB_XCNT(j)]); sum += c; cnt += (c > 0u) ? 1u : 0u; mine = (j == x) ? c : mine; }
        if (sum == GG) break;
        __builtin_amdgcn_s_sleep(1);
        if ((++sp & 255u) == 0u) { if (xb_ld(&bar[XB_TMO])) break; if (sp > XB_SPIN_CAP) { atomicAdd(&bar[XB_TMO], 1u); break; } }
    }
    nloc = mine > 0u ? mine : 1u; nx = cnt > 0u ? cnt : 1u;
}

__device__ __forceinline__ void xcd_barrier(const XcdBarrier& b) {
    asm volatile("s_waitcnt vmcnt(0)" ::: "memory");
    __syncthreads();
    if (threadIdx.x == 0) {
        unsigned* bar = b.bar;
        __builtin_amdgcn_s_waitcnt(0);
        unsigned nloc = b.st[0], nx = b.st[1];
        if (nloc == 0u) { xcd_barrier_complete(bar, b.x, nloc, nx); b.st[0] = nloc; b.st[1] = nx; }
        const unsigned old = xb_add(&bar[XB_XSUB(b.x)], 1u);
        const unsigned gen = old / nloc;
        if (old + 1u == (gen + 1u) * nloc) {
            __builtin_amdgcn_fence(__ATOMIC_RELEASE, "agent");
            asm volatile("s_waitcnt vmcnt(0)" ::: "memory");
            const unsigned og = xb_add(&bar[XB_TOP], 1u);
            const unsigned tg = og / nx;
            if (og + 1u == (tg + 1u) * nx) xb_add(&bar[XB_TOPGEN], 1u);
            else XB_SPIN(xb_ld(&bar[XB_TOPGEN]) == tg, bar);
            __builtin_amdgcn_fence(__ATOMIC_ACQUIRE, "agent");
            xb_add(&bar[XB_XGEN(b.x)], 1u);
            asm volatile("s_waitcnt vmcnt(0)" ::: "memory");
        } else {
            XB_SPIN(xb_ld(&bar[XB_XGEN(b.x)]) == gen, bar);
            __builtin_amdgcn_fence(__ATOMIC_ACQUIRE, "agent");
            asm volatile("s_waitcnt vmcnt(0)" ::: "memory");
        }
    }
    __syncthreads();
}
DI bf16x8 pack8(const float (&w)[8]) { u32x4 o; o.x = pk2(w[0], w[1]); o.y = pk2(w[2], w[3]); o.z = pk2(w[4], w[5]); o.w = pk2(w[6], w[7]); return __builtin_bit_cast(bf16x8, o); }
DI bf16x8 pack8v(f32x4 a, f32x4 b) { u32x4 o; o.x = pk2(a.x, a.y); o.y = pk2(a.z, a.w); o.z = pk2(b.x, b.y); o.w = pk2(b.z, b.w); return __builtin_bit_cast(bf16x8, o); }
#define MFMA16(a, b, c) __builtin_amdgcn_mfma_f32_16x16x32_bf16((a), (b), (c), 0, 0, 0)
#define MFMA32(a, b, c) __builtin_amdgcn_mfma_f32_32x32x16_bf16((a), (b), (c), 0, 0, 0)

DI void phaseA(const P& p, LAS unsigned char* lds, int tid, int wave, int lane) {
    const int gw = blockIdx.x * 8 + wave, NGW = G * 8;
    { float* ssq = (float*)(p.ws + WS_SSQ); for (int i = blockIdx.x * 512 + tid; i < 2 * M; i += G * 512) ssq[i] = 0.f; }
    { float* rc = (float*)(p.ws + WS_ROPE);
      for (int i = blockIdx.x * 512 + tid; i < 2048 * 32 + 32; i += G * 512) {
          const int pos = i < 2048 * 32 ? (i >> 5) : PAST, j = i & 31;
          const float inv = exp2f(-(float)j * (13.287712379549449f / 32.0f));
          const float ang = (float)pos * inv; float sn, cs; sincosf(ang, &sn, &cs);
          if (i < 2048 * 32) { rc[i] = cs; rc[2048 * 32 + i] = sn; } else { rc[2 * 2048 * 32 + j] = cs; rc[2 * 2048 * 32 + 32 + j] = sn; }
      } }
    for (int item = blockIdx.x; item < 2 * 384; item += G) {
        const int l = item / 384, cs = item % 384, h = lane >> 5, r = lane & 31;
        const float* W = p.wada + (size_t)l * D * 6 * D + cs * 32 + r;
        const float* c0 = (r < 4) ? p.cp + r * D : p.cs + (r - 4) * D;
        const float* c1 = p.cs + (28 + (r & 3)) * D;
        f32x16 acc0, acc1;
#pragma unroll
        for (int q = 0; q < 16; ++q) { acc0[q] = 0.f; acc1[q] = 0.f; }
#pragma unroll 4
        for (int ks = 0; ks < 16; ++ks) {
            const int k = wave * 256 + ks * 16 + h * 8;
            float w[8];
#pragma unroll
            for (int j = 0; j < 8; ++j) w[j] = W[(size_t)(k + j) * (6 * D)];
            const bf16x8 bfr = pack8(w);
            f32x4 a0 = *(const f32x4*)(c0 + k), a1 = *(const f32x4*)(c0 + k + 4);
            f32x4 e0 = {0.f, 0.f, 0.f, 0.f}, e1 = e0;
            if (r < 4) { e0 = *(const f32x4*)(c1 + k); e1 = *(const f32x4*)(c1 + k + 4); }
#pragma unroll
            for (int q = 0; q < 4; ++q) { a0[q] = silu_f(a0[q]); a1[q] = silu_f(a1[q]); e0[q] = silu_f(e0[q]); e1[q] = silu_f(e1[q]); }
            acc0 = MFMA32(pack8v(a0, a1), bfr, acc0);
            acc1 = MFMA32(pack8v(e0, e1), bfr, acc1);
        }
        LAS float* red = (LAS float*)lds;
#pragma unroll
        for (int q = 0; q < 16; ++q) { red[((wave * 2 + 0) * 16 + q) * 64 + lane] = acc0[q]; red[((wave * 2 + 1) * 16 + q) * 64 + lane] = acc1[q]; }
        __syncthreads();
        for (int idx = tid; idx < NMODROWS * 32; idx += 512) {
            const int row = idx >> 5, col = idx & 31, mt = row >> 5, rr = row & 31, q = (rr >> 3) * 4 + (rr & 3), ln = ((rr >> 2) & 1) * 32 + col;
            float s = 0.f;
#pragma unroll
            for (int w8 = 0; w8 < 8; ++w8) s += red[((w8 * 2 + mt) * 16 + q) * 64 + ln];
            ((float*)(p.ws + WS_MOD))[((size_t)l * NMODROWS + row) * (6 * D) + cs * 32 + col] = s + p.bada[l * 6 * D + cs * 32 + col];
        }
        __syncthreads();
    }
    LAS float* scr = (LAS float*)(lds + wave * 8448);
    constexpr int I_IN = 32 * 112, I_OUT = 32 * 64, I_G = 32 * 176, I_DN = 88 * 64, I_L = I_IN + I_OUT + 2 * I_G + I_DN;
    auto decode = [&](int it) { ConvDesc d; const int l = it / I_L; int r = it % I_L;
        if (r < I_IN) { d.W = p.win + (size_t)l * D * INC; d.WT = (bf16_t*)(p.ws + WS_WIN + l * SZ_WIN); d.K = D; d.N = INC; d.type = 0; d.item = r; return d; } r -= I_IN;
        if (r < I_OUT) { d.W = p.wout + (size_t)l * D * D; d.WT = (bf16_t*)(p.ws + WS_WOUT + l * SZ_WOUT); d.K = D; d.N = D; d.type = 1; d.item = r; return d; } r -= I_OUT;
        if (r < I_G) { d.W = p.wgate + (size_t)l * D * DFF; d.WT = (bf16_t*)(p.ws + WS_WGU + l * SZ_WGU); d.K = D; d.N = DFF; d.type = 2; d.item = r; return d; } r -= I_G;
        if (r < I_G) { d.W = p.wup + (size_t)l * D * DFF; d.WT = (bf16_t*)(p.ws + WS_WGU + l * SZ_WGU); d.K = D; d.N = DFF; d.type = 3; d.item = r; return d; } r -= I_G;
        d.W = p.wdown + (size_t)l * DFF * D; d.WT = (bf16_t*)(p.ws + WS_WDN + l * SZ_WDN); d.K = DFF; d.N = D; d.type = 1; d.item = r; return d; };
    { int it = gw; ConvDesc d = decode(it < 2 * I_L ? it : 0); f32x4 v[8];
      if (it < 2 * I_L) conv_load(d, lane, v);
      while (it < 2 * I_L) {
          const int nit = it + NGW; ConvDesc nd = decode(nit < 2 * I_L ? nit : 0); f32x4 nv[8];
          if (nit < 2 * I_L) conv_load(nd, lane, nv);
          conv_store(d, lane, v, scr);
          it = nit; d = nd;
#pragma unroll
          for (int i = 0; i < 8; ++i) v[i] = nv[i];
      } }
}

DI void phase_norm(const P& p, int l, int which, int wave, int lane) {
    const int gw = blockIdx.x * 8 + wave, NGW = G * 8;
    const float* mod = (const float*)(p.ws + WS_MOD) + (size_t)l * NMODROWS * 6 * D;
    const float* gvec = which == 0 ? p.g1 + l * D : which == 1 ? p.g2 + l * D : p.gfinal;
    const bool first = (l == 0 && which == 0);
    for (int row = gw; row < M + NS; row += NGW) {
        const float* x; bf16_t* o; float* of; int mrow;
        if (row < M) { x = (first ? p.xp : (const float*)(p.ws + WS_XR)) + (size_t)row * D; o = (bf16_t*)(p.ws + WS_XN) + (size_t)row * LDD; of = p.out + O_YP + (size_t)row * D; mrow = row >> 11; }
        else { const int s = row - M; x = (first ? p.xs : (const float*)(p.ws + WS_SMP + SM_XS)) + (size_t)s * D; o = (bf16_t*)(p.ws + WS_SMP + SM_HS) + (size_t)s * D; of = p.out + O_YS + (size_t)s * D; mrow = NB + s; }
        f32x4 v[8]; float ss = 0.f;
#pragma unroll
        for (int j = 0; j < 8; ++j) { v[j] = ((const f32x4*)x)[lane + 64 * j]; ss += (v[j].x * v[j].x + v[j].y * v[j].y) + (v[j].z * v[j].z + v[j].w * v[j].w); }
        const float rstd = rsqrtf(wave_sum(ss) * (1.0f / D) + EPS);
        if (which == 2) {
#pragma unroll
            for (int j = 0; j < 8; ++j) { const f32x4 g = ((const f32x4*)gvec)[lane + 64 * j]; ((f32x4*)of)[lane + 64 * j] = v[j] * rstd * g; }
        } else {
            const float* sh = mod + (size_t)mrow * 6 * D + (which == 0 ? 0 : 3) * D; const float* sc = sh + D;
#pragma unroll
            for (int j = 0; j < 8; ++j) { const f32x4 g = ((const f32x4*)gvec)[lane + 64 * j], c = ((const f32x4*)sc)[lane + 64 * j], h = ((const f32x4*)sh)[lane + 64 * j];
                const f32x4 y = v[j] * rstd * g * (c + 1.0f) + h; u32x2 w; w.x = pk2(y.x, y.y); w.y = pk2(y.z, y.w); ((u32x2*)o)[lane + 64 * j] = w; }
        }
    }
}

struct EpiIn {
    static constexpr bool PERM = false, AFTER_DRAIN = false;
    bf16_t *Q, *K, *V, *U, *GT; float* ssq; const float* rope; float *kwin, *vwin, *gmv; LAS unsigned char* tbuf;
    DI void operator()(const f32x4 (&acc)[2][2][4][2], const pg8::Unit& u, int wr, int wc, int fr, int fq) const {
        const int pn = u.pn, b = u.pm >> 3;
#pragma unroll
        for (int ai = 0; ai < 2; ++ai)
#pragma unroll
            for (int m = 0; m < 4; ++m) {
                const int row = u.pm * 256 + ai * 128 + wr * 64 + m * 16 + fr, t = row & 2047;
                if (pn <= 4) {
                    const int dh = 16 * (wc & 1) + 4 * fq;
                    const f32x4 cs = *(const f32x4*)(rope + t * 32 + dh), sn = *(const f32x4*)(rope + 65536 + t * 32 + dh);
#pragma unroll
                    for (int bj = 0; bj < 2; ++bj) {
                        const f32x4 x1 = acc[ai][bj][m][0], x2 = acc[ai][bj][m][1];
                        const f32x4 o1 = x1 * cs - x2 * sn, o2 = x2 * cs + x1 * sn;
                        const int hc = (2 * bj + (wc >> 1)) * 64 + dh;
                        u32x2 w1, w2; w1.x = pk2(o1.x, o1.y); w1.y = pk2(o1.z, o1.w); w2.x = pk2(o2.x, o2.y); w2.y = pk2(o2.z, o2.w);
                        if (pn < 4) { bf16_t* dst = Q + (size_t)row * 1024 + pn * 256 + hc; *(u32x2*)dst = w1; *(u32x2*)(dst + 32) = w2; }
                        else { bf16_t* dst = K + (size_t)row * 256 + hc; *(u32x2*)dst = w1; *(u32x2*)(dst + 32) = w2;
                            if (t >= 1920) { float* w = kwin + ((size_t)(b * 128 + t - 1920) * 256 + hc); *(f32x4*)w = o1; *(f32x4*)(w + 32) = o2; } }
                    }
                } else if (pn == 5) {
#pragma unroll
                    for (int bj = 0; bj < 2; ++bj) {
                        const int col = 128 * bj + 32 * wc + 8 * fq; const f32x4 v0 = acc[ai][bj][m][0], v1 = acc[ai][bj][m][1];
                        u32x4 w; w.x = pk2(v0.x, v0.y); w.y = pk2(v0.z, v0.w); w.z = pk2(v1.x, v1.y); w.w = pk2(v1.z, v1.w);
                        *(u32x4*)(V + (size_t)row * 256 + col) = w;
                        if (t >= 1920) { float* o = vwin + ((size_t)(b * 128 + t - 1920) * 256 + col); *(f32x4*)o = v0; *(f32x4*)(o + 4) = v1; }
                    }
                } else if (pn < 10) {
#pragma unroll
                    for (int bj = 0; bj < 2; ++bj) {
                        const int col = 256 * (pn - 6) + 128 * bj + 32 * wc + 8 * fq; f32x4 v0 = acc[ai][bj][m][0], v1 = acc[ai][bj][m][1];
#pragma unroll
                        for (int e = 0; e < 4; ++e) { v0[e] = gelu_tanh(v0[e]); v1[e] = gelu_tanh(v1[e]); }
                        u32x4 w; w.x = pk2(v0.x, v0.y); w.y = pk2(v0.z, v0.w); w.z = pk2(v1.x, v1.y); w.w = pk2(v1.z, v1.w);
                        *(u32x4*)(U + (size_t)row * 1024 + col) = w;
                    }
                } else {
                    float s = 0.f; LAS unsigned char* tb = tbuf + (wr * 4 + wc) * 2048;
#pragma unroll
                    for (int bj = 0; bj < 2; ++bj)
#pragma unroll
                        for (int n = 0; n < 2; ++n) {
                            const int col = 256 * (pn - 10) + 128 * bj + 32 * wc + 16 * n + 4 * fq; f32x4 g = acc[ai][bj][m][n];
#pragma unroll
                            for (int e = 0; e < 4; ++e) { g[e] = gelu_tanh(g[e]); s += g[e] * g[e]; *(LAS unsigned short*)(tb + (32 * bj + 16 * n + 4 * fq + e) * 32 + fr * 2) = (unsigned short)f2bf(g[e]); }
                            if (t >= 1920) *(f32x4*)(gmv + ((size_t)(b * 128 + t - 1920) * 1024 + col)) = g;
                        }
                    asm volatile("s_waitcnt lgkmcnt(0)" ::: "memory");
                    { const int lane = fq * 16 + fr, t0 = (u.pm * 256 + ai * 128 + wr * 64 + m * 16) & 2047;
#pragma unroll
                      for (int q = 0; q < 2; ++q) { const int id = lane + 64 * q, lc = id & 63, half = id >> 6;
                          const u32x4 v = *(const LAS u32x4*)(tb + lc * 32 + half * 16);
                          const int col = 256 * (pn - 10) + 128 * (lc >> 5) + 32 * wc + (lc & 31);
                          *(u32x4*)(GT + ((((size_t)b * 256 + (t0 >> 3) + half) * 1024 + col) << 3)) = v; }
                    }
                    asm volatile("s_waitcnt lgkmcnt(0)" ::: "memory");
                    s += __shfl_xor(s, 16); s += __shfl_xor(s, 32);
                    if (fq == 0) __hip_atomic_fetch_add(ssq + row, s, __ATOMIC_RELAXED, __HIP_MEMORY_SCOPE_AGENT);
                }
            }
    }
};
struct EpiRes {
    static constexpr bool PERM = false, AFTER_DRAIN = false;
    const float* base; float* out; const float* gate;
    DI void operator()(const f32x4 (&acc)[2][2][4][2], const pg8::Unit& u, int wr, int wc, int fr, int fq) const {
        const int b = u.pm >> 3; const int col0 = u.pn * 256 + wc * 32 + 4 * fq;
        f32x4 gv[2][2];
#pragma unroll
        for (int bj = 0; bj < 2; ++bj)
#pragma unroll
            for (int n = 0; n < 2; ++n) gv[bj][n] = *(const f32x4*)(gate + (size_t)b * 6 * D + col0 + bj * 128 + n * 16);
#pragma unroll
        for (int ai = 0; ai < 2; ++ai) {
            f32x4 bs[4][2][2];
#pragma unroll
            for (int m = 0; m < 4; ++m) { const size_t off = (size_t)(u.pm * 256 + ai * 128 + wr * 64 + m * 16 + fr) * D + col0;
#pragma unroll
                for (int bj = 0; bj < 2; ++bj)
#pragma unroll
                    for (int n = 0; n < 2; ++n) bs[m][bj][n] = *(const f32x4*)(base + off + bj * 128 + n * 16); }
#pragma unroll
            for (int m = 0; m < 4; ++m) { const size_t off = (size_t)(u.pm * 256 + ai * 128 + wr * 64 + m * 16 + fr) * D + col0;
#pragma unroll
                for (int bj = 0; bj < 2; ++bj)
#pragma unroll
                    for (int n = 0; n < 2; ++n) *(f32x4*)(out + off + bj * 128 + n * 16) = bs[m][bj][n] + gv[bj][n] * acc[ai][bj][m][n]; }
            asm volatile("" ::: "memory"); }
    }
};
DI float dpp_ror1(float v) { return __builtin_bit_cast(float, __builtin_amdgcn_update_dpp(0, __builtin_bit_cast(int, v), 0x121, 0xf, 0xf, false)); }
DI float dpp_ror2(float v) { return __builtin_bit_cast(float, __builtin_amdgcn_update_dpp(0, __builtin_bit_cast(int, v), 0x122, 0xf, 0xf, false)); }
struct EpiGU {
    static constexpr bool PERM = false, AFTER_DRAIN = false;
    bf16_t* ACT; float* SA; float* SU; float* cvp; const float* cw; const float* cb;
    DI void operator()(const f32x4 (&acc)[2][2][4][2], const pg8::Unit& u, int wr, int wc, int fr, int fq) const {
        const int b = u.pm >> 3, f0 = u.pn * 128 + wc * 32 + 8 * fq;
        float w0[8], w1[8], w2[8], bb[8];
#pragma unroll
        for (int q = 0; q < 2; ++q) { const f32x4 x0 = *(const f32x4*)(cw + f0 + 4 * q), x1 = *(const f32x4*)(cw + DFF + f0 + 4 * q), x2 = *(const f32x4*)(cw + 2 * DFF + f0 + 4 * q), x3 = *(const f32x4*)(cb + f0 + 4 * q);
#pragma unroll
            for (int e = 0; e < 4; ++e) { w0[4 * q + e] = x0[e]; w1[4 * q + e] = x1[e]; w2[4 * q + e] = x2[e]; bb[4 * q + e] = x3[e]; } }
#pragma unroll
        for (int ai = 0; ai < 2; ++ai) {
            const int blk = u.pm * 4 + ai * 2 + wr;
#pragma unroll
            for (int m = 0; m < 4; ++m) { const int row = u.pm * 256 + ai * 128 + wr * 64 + m * 16 + fr, t = row & 2047;
                float o[8];
#pragma unroll
                for (int n = 0; n < 2; ++n)
#pragma unroll
                    for (int e = 0; e < 4; ++e) { const float a = acc[ai][0][m][n][e], ap = acc[ai][0][m > 0 ? m - 1 : 0][n][e];
                        const float r1a = dpp_ror1(a), r1b = dpp_ror1(ap), r2a = dpp_ror2(a), r2b = dpp_ror2(ap);
                        const float p1 = fr >= 1 ? r1a : r1b, p2 = fr >= 2 ? r2a : r2b;
                        const int c = 4 * n + e; const float cv = bb[c] + w0[c] * p2 + w1[c] * p1 + w2[c] * a;
                        o[c] = silu_f(cv) * acc[ai][1][m][n][e]; }
                const f32x4 g0 = acc[ai][0][m][0], g1 = acc[ai][0][m][1];
                if (m == 0 && fr < 2) {
                    float* sa = SA + ((size_t)(blk * 4 + 2 + fr)) * DFF + f0; *(f32x4*)sa = g0; *(f32x4*)(sa + 4) = g1;
                    float* su = SU + ((size_t)(blk * 2 + fr)) * DFF + f0; *(f32x4*)su = acc[ai][1][m][0]; *(f32x4*)(su + 4) = acc[ai][1][m][1];
                } else {
                    u32x4 w; w.x = pk2(o[0], o[1]); w.y = pk2(o[2], o[3]); w.z = pk2(o[4], o[5]); w.w = pk2(o[6], o[7]);
                    *(u32x4*)(ACT + (size_t)row * LDF + f0) = w;
                }
                if (m == 3 && fr >= 14) { float* sa = SA + ((size_t)(blk * 4 + fr - 14)) * DFF + f0; *(f32x4*)sa = g0; *(f32x4*)(sa + 4) = g1; }
                if (t >= 2046) { float* oo = cvp + ((size_t)(b * 2 + t - 2046) * DFF + f0); *(f32x4*)oo = g0; *(f32x4*)(oo + 4) = g1; }
            }
        }
    }
};

struct EpiNull {
    static constexpr bool PERM = false, AFTER_DRAIN = false;
    float* sink;
    DI void operator()(const f32x4 (&acc)[2][2][4][2], const pg8::Unit& u, int wr, int wc, int fr, int fq) const {
        f32x4 s = {0.f, 0.f, 0.f, 0.f};
#pragma unroll
        for (int ai = 0; ai < 2; ++ai)
#pragma unroll
            for (int bj = 0; bj < 2; ++bj)
#pragma unroll
                for (int m = 0; m < 4; ++m)
#pragma unroll
                    for (int n = 0; n < 2; ++n) s += acc[ai][bj][m][n];
        if (s.x + s.y + s.z + s.w == 1234567.0f) sink[8191] = s.x;
    }
};
DI void attn_unit(const P& p, int l, int unit, LAS unsigned char* lds, int tid, int wave, int lane) {
    const int b = unit >> 6, n = (unit >> 2) & 15, kvh = unit & 3;
    const bf16_t* Kb = (const bf16_t*)(p.ws + WS_K); const bf16_t* Vb = (const bf16_t*)(p.ws + WS_V); const bf16_t* Qb = (const bf16_t*)(p.ws + WS_Q);
    bf16_t* MIX = (bf16_t*)(p.ws + WS_MIX);
    LAS unsigned char* Ks = lds;
    LAS unsigned char* Vt = lds + 256 * 144;
    const int tok0 = b * 2048 + (n - 1) * 128;
#pragma unroll
    for (int i = 0; i < 4; ++i) { const int id = i * 512 + tid, key = id >> 3, part = id & 7;
        u32x4 v = {0u, 0u, 0u, 0u}; if (n > 0 || key >= 128) v = *(const u32x4*)(Kb + (size_t)(tok0 + key) * 256 + kvh * 64 + part * 8);
        *(LAS u32x4*)(Ks + key * 144 + part * 16) = v; }
#pragma unroll
    for (int i = 0; i < 4; ++i) { const int id = i * 512 + tid, key = id & 255, part = id >> 8;
        u32x4 v = {0u, 0u, 0u, 0u}; if (n > 0 || key >= 128) v = *(const u32x4*)(Vb + (size_t)(tok0 + key) * 256 + kvh * 64 + part * 8);
        LAS unsigned short* d = (LAS unsigned short*)(Vt + (part * 8) * 528 + key * 2);
        d[0 * 264] = (unsigned short)(v.x & 0xffffu); d[1 * 264] = (unsigned short)(v.x >> 16); d[2 * 264] = (unsigned short)(v.y & 0xffffu); d[3 * 264] = (unsigned short)(v.y >> 16);
        d[4 * 264] = (unsigned short)(v.z & 0xffffu); d[5 * 264] = (unsigned short)(v.z >> 16); d[6 * 264] = (unsigned short)(v.w & 0xffffu); d[7 * 264] = (unsigned short)(v.w >> 16); }
    __syncthreads();
    const int q16 = lane & 15, g4 = lane >> 4;
    for (int it = 0; it < 4; ++it) {
        const int qg = wave * 4 + it, g = qg >> 3, i0 = (qg & 7) * 16, head = kvh * 4 + g, nt0 = i0 >> 4;
        const size_t qtok = (size_t)b * 2048 + n * 128 + i0 + q16;
        const bf16x8 q0 = *(const bf16x8*)(Qb + qtok * 1024 + head * 64 + g4 * 8), q1 = *(const bf16x8*)(Qb + qtok * 1024 + head * 64 + 32 + g4 * 8);
        f32x4 s[9];
#pragma unroll
        for (int tt = 0; tt < 9; ++tt) { const LAS unsigned char* kp = Ks + ((nt0 + tt) * 16 + q16) * 144 + g4 * 16;
            const bf16x8 a0 = *(const LAS bf16x8*)kp, a1 = *(const LAS bf16x8*)(kp + 64);
            f32x4 z = {0.f, 0.f, 0.f, 0.f}; z = MFMA16(a0, q0, z); s[tt] = MFMA16(a1, q1, z); }
        const int iq = i0 + q16; float mx = -1e30f;
#pragma unroll
        for (int tt = 0; tt < 9; ++tt)
#pragma unroll
            for (int r = 0; r < 4; ++r) { const int j = (nt0 + tt) * 16 + g4 * 4 + r; const bool ok = (j >= iq) && (j <= iq + 128) && (n > 0 || j >= 128);
                const float v = ok ? s[tt][r] * 0.125f : -1e30f; s[tt][r] = v; mx = fmaxf(mx, v); }
        mx = fmaxf(mx, __shfl_xor(mx, 16)); mx = fmaxf(mx, __shfl_xor(mx, 32));
        const float sink = p.sinks[l * NH + head]; const float mm = fmaxf(mx, sink);
        float sum = 0.f;
#pragma unroll
        for (int tt = 0; tt < 9; ++tt)
#pragma unroll
            for (int r = 0; r < 4; ++r) { const float e = __expf(s[tt][r] - mm); s[tt][r] = e; sum += e; }
        sum += __shfl_xor(sum, 16); sum += __shfl_xor(sum, 32);
        const float inv = 1.0f / (sum + __expf(sink - mm));
        f32x4 o[4];
#pragma unroll
        for (int dt = 0; dt < 4; ++dt) o[dt] = (f32x4){0.f, 0.f, 0.f, 0.f};
#pragma unroll
        for (int i = 0; i < 5; ++i) {
            const f32x4 pl = s[2 * i], ph = (2 * i + 1 < 9) ? s[(2 * i + 1 < 9) ? 2 * i + 1 : 8] : (f32x4){0.f, 0.f, 0.f, 0.f};
            const bf16x8 pb = pack8v(pl, ph);
#pragma unroll
            for (int dt = 0; dt < 4; ++dt) { const LAS unsigned char* vp = Vt + (16 * dt + q16) * 528 + ((nt0 + 2 * i) * 16 + g4 * 4) * 2;
                u32x4 va; const u32x2 lo = *(const LAS u32x2*)vp; va.x = lo.x; va.y = lo.y;
                if (2 * i + 1 < 9) { const u32x2 hi = *(const LAS u32x2*)(vp + 32); va.z = hi.x; va.w = hi.y; } else { va.z = 0u; va.w = 0u; }
                o[dt] = MFMA16(__builtin_bit_cast(bf16x8, va), pb, o[dt]); }
        }
#pragma unroll
        for (int dt = 0; dt < 4; ++dt) { u32x2 w; w.x = pk2(o[dt].x * inv, o[dt].y * inv); w.y = pk2(o[dt].z * inv, o[dt].w * inv);
            *(u32x2*)(MIX + qtok * LDD + head * 64 + 16 * dt + 4 * g4) = w; }
    }
    __syncthreads();
}

DI void gmlp_unit(const P& p, int l, int unit, int wave, int lane) {
    const int b = unit >> 7, c = (unit >> 3) & 15, h = unit & 7;
    const int q16 = lane & 15, g4 = lane >> 4, i = 16 * wave + q16;
    const float* Wrow = p.gmws + (((size_t)l * 8 + h) * 128 + i) * 128;
    const float* ssq = (const float*)(p.ws + WS_SSQ) + l * M + b * 2048 + c * 128;
    const bf16_t* GT = (const bf16_t*)(p.ws + WS_GT) + (((size_t)(b * 16 + c) * 16) * 1024 + h * 128) * 8;
    const bf16_t* U = (const bf16_t*)(p.ws + WS_U); bf16_t* MIX = (bf16_t*)(p.ws + WS_MIX);
    f32x4 acc[8];
#pragma unroll
    for (int dt = 0; dt < 8; ++dt) acc[dt] = (f32x4){0.f, 0.f, 0.f, 0.f};
    const int ksmax = wave >> 1;
    for (int ks = 0; ks <= ksmax; ++ks) {
        const int j0 = 32 * ks + 8 * g4;
        const f32x4 w0 = *(const f32x4*)(Wrow + j0), w1 = *(const f32x4*)(Wrow + j0 + 4), s0 = *(const f32x4*)(ssq + j0), s1 = *(const f32x4*)(ssq + j0 + 4);
        float wv[8];
#pragma unroll
        for (int jj = 0; jj < 4; ++jj) { wv[jj] = (j0 + jj <= i) ? w0[jj] * rsqrtf(s0[jj] * (1.0f / GMW) + EPS) : 0.f; wv[4 + jj] = (j0 + 4 + jj <= i) ? w1[jj] * rsqrtf(s1[jj] * (1.0f / GMW) + EPS) : 0.f; }
        const bf16x8 bw = pack8(wv);
#pragma unroll
        for (int dt = 0; dt < 8; ++dt) { const bf16x8 a = *(const bf16x8*)(GT + ((size_t)(4 * ks + g4) * 1024 + 16 * dt + q16) * 8); acc[dt] = MFMA16(a, bw, acc[dt]); }
    }
    const size_t tok = (size_t)b * 2048 + c * 128 + i;
    const float bias = p.gmbs[(l * 8 + h) * 128 + i];
#pragma unroll
    for (int dt = 0; dt < 8; ++dt) { const int col = h * 128 + 16 * dt + 4 * g4;
        const f32x4 gain = *(const f32x4*)(p.gmgain + l * GMW + col); const u32x2 uu = *(const u32x2*)(U + tok * 1024 + col);
        const float o0 = bflo(uu.x) * (gain.x * acc[dt].x + bias), o1 = bfhi(uu.x) * (gain.y * acc[dt].y + bias), o2 = bflo(uu.y) * (gain.z * acc[dt].z + bias), o3 = bfhi(uu.y) * (gain.w * acc[dt].w + bias);
        u32x2 w; w.x = pk2(o0, o1); w.y = pk2(o2, o3); *(u32x2*)(MIX + tok * LDD + 1024 + col) = w; }
}

DI void sample_part(const P& p, int l, int s, int hp, LAS unsigned char* lds, int tid, int wave, int lane) {
    const float* qS = (const float*)(p.ws + WS_SMP + SM_Q) + s * 1024; const float* kS = (const float*)(p.ws + WS_SMP + SM_KK) + s * 256; const float* vS = (const float*)(p.ws + WS_SMP + SM_VV) + s * 256;
    const float* uS = (const float*)(p.ws + WS_SMP + SM_UU) + s * 1024; const float* gS = (const float*)(p.ws + WS_SMP + SM_GG) + s * 1024;
    bf16_t* mix = (bf16_t*)(p.ws + WS_SMP + SM_MIX) + s * 2048;
    const float* ck = p.ck + ((size_t)l * NS + s) * WIN * KVW; const float* cv = p.cv + ((size_t)l * NS + s) * WIN * KVW;
    LAS float* red = (LAS float*)lds;
    LAS float* ql = (LAS float*)(lds + 128);
    LAS float* pl = (LAS float*)(lds + 128 + 512);
    LAS float* po = (LAS float*)(lds + 128 + 512 + 1056);
    const int kvh = hp >> 1, hh = tid >> 8, j = tid & 255, head = 2 * hp + hh;
    const float g0 = gS[tid], g1 = gS[tid + 512];
    if (tid < 128) ql[tid] = qS[2 * hp * 64 + tid];
    f32x4 kk[16];
    { const float* kr = (j < 128) ? ck + (size_t)j * KVW + kvh * 64 : kS + kvh * 64;
#pragma unroll
      for (int e = 0; e < 16; ++e) kk[e] = (j < 129) ? ((const f32x4*)kr)[e] : (f32x4){0.f, 0.f, 0.f, 0.f}; }
    { float* ko = p.out + O_KWS + ((size_t)l * NS + s) * WIN * KVW; float* vo = p.out + O_VWS + ((size_t)l * NS + s) * WIN * KVW;
#pragma unroll
      for (int q = 0; q < 2; ++q) { const int i = hp * 1024 + tid + 512 * q, jj = i >> 6, c4 = i & 63;
          const f32x4 kv = (jj < 127) ? ((const f32x4*)ck)[(jj + 1) * 64 + c4] : ((const f32x4*)kS)[c4];
          const f32x4 vv = (jj < 127) ? ((const f32x4*)cv)[(jj + 1) * 64 + c4] : ((const f32x4*)vS)[c4];
          ((f32x4*)ko)[i] = kv; ((f32x4*)vo)[i] = vv; } }
    float ss = wave_sum(g0 * g0 + g1 * g1);
    if (lane == 0) red[wave] = ss;
    __syncthreads();
    if (tid < 128) { float tot = 0.f;
#pragma unroll
        for (int w = 0; w < 8; ++w) tot += red[w];
        const float rstd = rsqrtf(tot * (1.0f / GMW) + EPS); const int c = 128 * hp + tid;
        const float gvn = gS[c] * rstd * p.gmgain[l * GMW + c];
        p.out[O_GMS + ((size_t)l * NS + s) * GMW + c] = gvn;
        const float sv = p.gmws[((size_t)l * 8 + hp) * 128 * 128] * gvn + p.gmbs[(l * 8 + hp) * 128];
        mix[1024 + c] = (bf16_t)f2bf(uS[c] * sv); }
    float sc = -1e30f;
    if (j < 129) { float d = 0.f;
#pragma unroll
        for (int e = 0; e < 16; ++e) { const LAS float* qq = ql + hh * 64 + 4 * e; d += kk[e].x * qq[0] + kk[e].y * qq[1] + kk[e].z * qq[2] + kk[e].w * qq[3]; }
        sc = d * 0.125f; }
    float mx = sc;
#pragma unroll
    for (int o = 1; o < 64; o <<= 1) mx = fmaxf(mx, __shfl_xor(mx, o));
    if (lane == 0) red[8 + wave] = mx;
    __syncthreads();
    mx = fmaxf(fmaxf(red[8 + 4 * hh], red[9 + 4 * hh]), fmaxf(red[10 + 4 * hh], red[11 + 4 * hh]));
    const float sink = p.sinks[l * NH + head], mm = fmaxf(mx, sink);
    const float pe = (j < 129) ? __expf(sc - mm) : 0.f;
    const float sm = wave_sum(pe);
    if (lane == 0) red[16 + wave] = sm;
    __syncthreads();
    const float inv = 1.0f / ((red[16 + 4 * hh] + red[17 + 4 * hh]) + (red[18 + 4 * hh] + red[19 + 4 * hh]) + __expf(sink - mm));
    if (j < 129) pl[hh * 132 + j] = pe * inv;
    __syncthreads();
    { const int part = (tid >> 5) & 7, d2 = (tid & 31) * 2; float o0 = 0.f, o1 = 0.f; f32x2 vv[16];
#pragma unroll
      for (int q = 0; q < 16; ++q) vv[q] = *(const f32x2*)(cv + (size_t)(part * 16 + q) * KVW + kvh * 64 + d2);
#pragma unroll
      for (int q = 0; q < 16; ++q) { const float pj = pl[hh * 132 + part * 16 + q]; o0 += pj * vv[q].x; o1 += pj * vv[q].y; }
      if (part == 0) { const float pj = pl[hh * 132 + 128]; const f32x2 v2 = *(const f32x2*)(vS + kvh * 64 + d2); o0 += pj * v2.x; o1 += pj * v2.y; }
      po[(hh * 8 + part) * 64 + d2] = o0; po[(hh * 8 + part) * 64 + d2 + 1] = o1; }
    __syncthreads();
    if (tid < 128) { const int h2 = tid >> 6, d = tid & 63; float o = 0.f;
#pragma unroll
        for (int q = 0; q < 8; ++q) o += po[(h2 * 8 + q) * 64 + d];
        mix[(2 * hp + h2) * 64 + d] = (bf16_t)f2bf(o); }
    __syncthreads();
}

DI void gmv_fix(const P& p, int l, int tid) {
    float* gmv = p.out + O_GMP + (size_t)l * NB * 128 * GMW; const float* ssq = (const float*)(p.ws + WS_SSQ) + l * M;
    for (int i = blockIdx.x * 512 + tid; i < NB * 128 * GMW / 4; i += G * 512) { const int c4 = i & 255, r = i >> 8, b = r >> 7, tt = r & 127;
        const float rs = rsqrtf(ssq[b * 2048 + 1920 + tt] * (1.0f / GMW) + EPS); const f32x4 g = ((const f32x4*)(p.gmgain + l * GMW))[c4];
        f32x4 v = ((f32x4*)gmv)[i]; v = v * rs * g; ((f32x4*)gmv)[i] = v; }
}

DI void phase_fix(const P& p, int l, int tid) {
    const float* SA = (const float*)(p.ws + WS_GA); const float* SU = SA + (size_t)128 * 4 * DFF; bf16_t* ACT = (bf16_t*)(p.ws + WS_UP);
    const float* cw = p.convw + (size_t)l * 3 * DFF; const float* cb = p.convb + (size_t)l * DFF;
    constexpr int NC4 = DFF / 4;
    for (int task = blockIdx.x * 512 + tid; task < 128 * 2 * NC4; task += G * 512) {
        const int c4 = task % NC4, rr = task / NC4, blk = rr >> 1, r = rr & 1, f = c4 * 4; const bool first = (blk & 31) == 0;
        const f32x4 z = {0.f, 0.f, 0.f, 0.f};
        const float* cur = SA + (size_t)blk * 4 * DFF + f; const float* prv = SA + (size_t)(blk - 1) * 4 * DFF + f;
        const f32x4 a2 = *(const f32x4*)(cur + (2 + r) * DFF);
        const f32x4 a1 = r ? *(const f32x4*)(cur + 2 * DFF) : (first ? z : *(const f32x4*)(prv + DFF));
        const f32x4 a0 = r ? (first ? z : *(const f32x4*)(prv + DFF)) : (first ? z : *(const f32x4*)prv);
        const f32x4 uu = *(const f32x4*)(SU + ((size_t)(blk * 2 + r)) * DFF + f);
        const f32x4 x0 = *(const f32x4*)(cw + f), x1 = *(const f32x4*)(cw + DFF + f), x2 = *(const f32x4*)(cw + 2 * DFF + f), x3 = *(const f32x4*)(cb + f);
        float o[4];
#pragma unroll
        for (int e = 0; e < 4; ++e) o[e] = silu_f(x3[e] + x0[e] * a0[e] + x1[e] * a1[e] + x2[e] * a2[e]) * uu[e];
        u32x2 w; w.x = pk2(o[0], o[1]); w.y = pk2(o[2], o[3]);
        *(u32x2*)(ACT + (size_t)(blk * 64 + r) * LDF + f) = w;
    }
}
template <int NBLK, int K, class Epi>
#ifndef SK_REPEAT
#define SK_REPEAT 1
#endif
DI void skinny(LAS unsigned char* lds, const bf16_t* A, const bf16_t* B0, const bf16_t* B1, int wave, int lane, const Epi& epi) {
  for (int rep = 0; rep < SK_REPEAT; ++rep) {
    asm volatile("" ::: "memory");
    const int r = lane & 31, h = lane >> 5; constexpr int kw = K / 8;
    const bf16_t* ap = A + (size_t)r * K + wave * kw + h * 8;
    const bf16_t* b0 = B0 + (size_t)r * (K + 64) + wave * kw + h * 8;
    const bf16_t* b1 = (NBLK == 2 ? B1 : B0) + (size_t)r * (K + 64) + wave * kw + h * 8;
    f32x16 acc0, acc1;
#pragma unroll
    for (int q = 0; q < 16; ++q) { acc0[q] = 0.f; acc1[q] = 0.f; }
#pragma unroll (K == 2048 ? 16 : 11)
    for (int k = 0; k < kw; k += 16) { const bf16x8 a = *(const bf16x8*)(ap + k);
        acc0 = MFMA32(*(const bf16x8*)(b0 + k), a, acc0);
        if (NBLK == 2) acc1 = MFMA32(*(const bf16x8*)(b1 + k), a, acc1); }
    LAS float* red = (LAS float*)lds;
#pragma unroll
    for (int q = 0; q < 16; ++q) { red[((wave * 2 + 0) * 16 + q) * 64 + lane] = acc0[q]; if (NBLK == 2) red[((wave * 2 + 1) * 16 + q) * 64 + lane] = acc1[q]; }
    __syncthreads();
    if (wave == 0) {
#pragma unroll
        for (int q = 0; q < 16; ++q) { float s0 = 0.f, s1 = 0.f;
#pragma unroll
            for (int w = 0; w < 8; ++w) { s0 += red[((w * 2 + 0) * 16 + q) * 64 + lane]; if (NBLK == 2) s1 += red[((w * 2 + 1) * 16 + q) * 64 + lane]; }
            acc0[q] = s0; acc1[q] = s1; }
        if (rep == SK_REPEAT - 1) epi(acc0, acc1, lane);
    }
    __syncthreads();
  }
}
struct SkIn {
    int item; float *qS, *kS, *vS, *uS, *gS; const float* ropeS;
    DI void operator()(const f32x16& acc, const f32x16&, int lane) const {
        const int s = lane & 31, h = lane >> 5, p0 = item * 32, pn = p0 >> 8, bj = (p0 >> 7) & 1, wc = (p0 >> 5) & 3;
        if (pn <= 4) {
#pragma unroll
            for (int q = 0; q < 8; ++q) { const int fq = 2 * ((q >> 2) & 1) + h, e = q & 3, dh = 16 * (wc & 1) + 4 * fq + e;
                const float cs = ropeS[dh], sn = ropeS[32 + dh], x1 = acc[q], x2 = acc[q + 8], o1 = x1 * cs - x2 * sn, o2 = x2 * cs + x1 * sn;
                const int hc = 128 * bj + 64 * (wc >> 1) + dh;
                if (pn < 4) { qS[s * 1024 + pn * 256 + hc] = o1; qS[s * 1024 + pn * 256 + hc + 32] = o2; } else { kS[s * 256 + hc] = o1; kS[s * 256 + hc + 32] = o2; } }
        } else if (pn < 10) {
#pragma unroll
            for (int q = 0; q < 16; ++q) { const int n = q >> 3, fq = 2 * ((q >> 2) & 1) + h, e = q & 3, L = p0 + 8 * fq + 4 * n + e;
                if (pn == 5) vS[s * 256 + L - 1280] = acc[q]; else uS[s * 1024 + L - 1536] = gelu_tanh(acc[q]); }
        } else {
#pragma unroll
            for (int q = 0; q < 16; ++q) { const int L = p0 + (q & 3) + 8 * (q >> 2) + 4 * h; gS[s * 1024 + L - 2560] = gelu_tanh(acc[q]); }
        }
    }
};
struct SkRes {
    int item; const float* base; float* out; const float* gate;
    DI void operator()(const f32x16& acc, const f32x16&, int lane) const {
        const int s = lane & 31, h = lane >> 5;
#pragma unroll
        for (int q = 0; q < 16; ++q) { const int col = item * 32 + (q & 3) + 8 * (q >> 2) + 4 * h;
            out[s * D + col] = base[s * D + col] + gate[(size_t)(NB + s) * 6 * D + col] * acc[q]; }
    }
};
struct SkGU {
    int item, l; const float *sconv, *cw, *cb; bf16_t* act; float* cvs;
    DI void operator()(const f32x16& ga, const f32x16& up, int lane) const {
        const int s = lane & 31, h = lane >> 5, pn = item >> 2, wc = item & 3;
#pragma unroll
        for (int q = 0; q < 16; ++q) { const int n = q >> 3, fq = 2 * ((q >> 2) & 1) + h, e = q & 3, f = 128 * pn + 32 * wc + 8 * fq + 4 * n + e;
            const float p0 = sconv[((size_t)(l * NS + s) * 2 + 0) * DFF + f], p1 = sconv[((size_t)(l * NS + s) * 2 + 1) * DFF + f], a = ga[q];
            const float cv = cb[l * DFF + f] + cw[((size_t)l * 3 + 0) * DFF + f] * p0 + cw[((size_t)l * 3 + 1) * DFF + f] * p1 + cw[((size_t)l * 3 + 2) * DFF + f] * a;
            act[s * DFF + f] = (bf16_t)f2bf(silu_f(cv) * up[q]);
            cvs[((size_t)(l * NS + s) * 2 + 0) * DFF + f] = p1; cvs[((size_t)(l * NS + s) * 2 + 1) * DFF + f] = a; }
    }
};

#ifndef MULTI
#define MULTI 0
#endif
constexpr int NPHASE = 18;
__global__ void __launch_bounds__(512, 2) fwd(Args a) {
    extern __shared__ __attribute__((aligned(16))) unsigned char lds_raw[];
    LAS unsigned char* lds = (LAS unsigned char*)lds_raw;
    cg::grid_group grid = cg::this_grid();
    const int wave0 = __builtin_amdgcn_readfirstlane(threadIdx.x >> 6);
    P p;
    p.xp = a.in[0]; p.xs = a.in[1]; p.ck = a.in[2]; p.cv = a.in[3]; p.sconv = a.in[4]; p.cp = a.in[5]; p.cs = a.in[6]; p.wada = a.in[7]; p.bada = a.in[8];
    p.g1 = a.in[9]; p.g2 = a.in[10]; p.win = a.in[11]; p.gmgain = a.in[12]; p.gmws = a.in[13]; p.gmbs = a.in[14]; p.sinks = a.in[15]; p.wout = a.in[16];
    p.wgate = a.in[17]; p.wup = a.in[18]; p.convw = a.in[19]; p.convb = a.in[20]; p.wdown = a.in[21]; p.gfinal = a.in[22]; p.out = a.out; p.ws = a.ws;
    const int lo = a.ph_lo, hi = a.ph_hi;
    volatile LAS unsigned* xst = (volatile LAS unsigned*)(lds + 147456);
    if (threadIdx.x < 2) xst[threadIdx.x] = 0u;
    __syncthreads();
    const XcdBarrier xbar = xcd_barrier_post((unsigned*)(a.ws + WS_BAR), xst);
#define IN(k) (lo <= (k) && (k) < hi)
#define FRESH() int wv_f = wave0; asm volatile("" : "+s"(wv_f)); int tid_f = wv_f * 64 + (int)__builtin_amdgcn_mbcnt_hi(~0u, __builtin_amdgcn_mbcnt_lo(~0u, 0u)); asm volatile("" : "+v"(tid_f)); const int tid = tid_f, lane = tid & 63, wave = __builtin_amdgcn_readfirstlane(tid >> 6); (void)lane; (void)wave
#ifndef PROBE_MASK
#define PROBE_MASK 0
#endif
#ifndef PROBE_CLK
#define PROBE_CLK 0
#endif
#ifndef PROBE_MUL
#define PROBE_MUL 2
#endif
    unsigned long long pr_acc = 0, pr_t0 = 0, pr_c0 = 0, pr_cacc = 0; (void)pr_c0; (void)pr_cacc;
#define PR_BEGIN(k) do { if (PROBE_MASK & (1u << (k))) { pr_t0 = __builtin_amdgcn_s_memrealtime(); pr_c0 = __builtin_readcyclecounter(); } } while (0)
#define SEAM(k) do { if (IN(k) && IN((k) + 1)) { if ((k) == 0) grid.sync(); else xcd_barrier(xbar); } if (PROBE_MASK & (1u << (k))) { pr_acc += __builtin_amdgcn_s_memrealtime() - pr_t0; pr_cacc += __builtin_readcyclecounter() - pr_c0; } } while (0)
    unsigned char* ws = a.ws;
    bf16_t* XN = (bf16_t*)(ws + WS_XN); float* XR = (float*)(ws + WS_XR); float* XS = (float*)(ws + WS_SMP + SM_XS);
    bf16_t* HS = (bf16_t*)(ws + WS_SMP + SM_HS); bf16_t* MIXS = (bf16_t*)(ws + WS_SMP + SM_MIX); bf16_t* ACTS = (bf16_t*)(ws + WS_SMP + SM_ACT);
    const float* MOD = (const float*)(ws + WS_MOD);

    PR_BEGIN(0);
    if (IN(0)) { FRESH(); phaseA(p, lds, tid, wave, lane); }
    SEAM(0);
    for (int l = 0; l < DEPTH; ++l) {
        const int pb = 1 + 8 * l;
        const bf16_t* Win = (const bf16_t*)(ws + WS_WIN + l * SZ_WIN); const bf16_t* Wout = (const bf16_t*)(ws + WS_WOUT + l * SZ_WOUT);
        const bf16_t* Wgu = (const bf16_t*)(ws + WS_WGU + l * SZ_WGU); const bf16_t* Wdn = (const bf16_t*)(ws + WS_WDN + l * SZ_WDN);
        const float* modl = MOD + (size_t)l * NMODROWS * 6 * D;
        PR_BEGIN(pb + 0);
        if (IN(pb + 0)) { FRESH(); phase_norm(p, l, 0, wave, lane); }
        SEAM(pb + 0);
        PR_BEGIN(pb + 1);
        if (IN(pb + 1)) {
            pg8::Gemm g{XN, Win, M, INC, D}; pg8::StaticOrder S; S.init(M, INC, gridDim.x, blockIdx.x);
            EpiIn E{(bf16_t*)(ws + WS_Q), (bf16_t*)(ws + WS_K), (bf16_t*)(ws + WS_V), (bf16_t*)(ws + WS_U), (bf16_t*)(ws + WS_GT), (float*)(ws + WS_SSQ) + l * M, (const float*)(ws + WS_ROPE),
                    p.out + O_KWP + (size_t)l * NB * WIN * KVW, p.out + O_VWP + (size_t)l * NB * WIN * KVW, p.out + O_GMP + (size_t)l * NB * 128 * GMW, lds + 131072};
            pg8::gemm_phase<EpiIn, pg8::StaticOrder>(lds, g, S, E, nullptr, wave0); FRESH();
            for (int item = (int)gridDim.x - 1 - (int)blockIdx.x; item < INC / 32; item += gridDim.x) {
                SkIn e{item, (float*)(ws + WS_SMP + SM_Q), (float*)(ws + WS_SMP + SM_KK), (float*)(ws + WS_SMP + SM_VV), (float*)(ws + WS_SMP + SM_UU), (float*)(ws + WS_SMP + SM_GG), (const float*)(ws + WS_ROPE) + 2 * 2048 * 32};
                skinny<1, D>(lds, HS, Win + (size_t)item * 32 * LDD, nullptr, wave, lane, e); }
        }
        SEAM(pb + 1);
        PR_BEGIN(pb + 2);
        if (IN(pb + 2)) { FRESH();
#ifndef REP_ATT
#define REP_ATT 1
#endif
#ifndef REP_GM
#define REP_GM 1
#endif
            for (int rep = 0; rep < REP_ATT; ++rep) { asm volatile("" ::: "memory"); for (int u = blockIdx.x; u < NB * 16 * NKV; u += gridDim.x) attn_unit(p, l, u, lds, tid, wave, lane); }
            for (int rep = 0; rep < REP_GM; ++rep) { asm volatile("" ::: "memory"); for (int u = blockIdx.x; u < NB * 16 * 8; u += gridDim.x) gmlp_unit(p, l, u, wave, lane); }
            for (int it = (int)gridDim.x - 1 - (int)blockIdx.x; it < NS * 8; it += gridDim.x) sample_part(p, l, it >> 3, it & 7, lds, tid, wave, lane);
            gmv_fix(p, l, tid);
        }
        SEAM(pb + 2);
        PR_BEGIN(pb + 3);
        if (IN(pb + 3)) {
            pg8::Gemm g{(const bf16_t*)(ws + WS_MIX), Wout, M, D, D}; pg8::StaticOrder S; S.init(M, D, gridDim.x, blockIdx.x);
            EpiRes E{l == 0 ? p.xp : XR, XR, modl + 2 * D};
            pg8::gemm_phase<EpiRes, pg8::StaticOrder>(lds, g, S, E, nullptr, wave0); FRESH();
            for (int item = (int)gridDim.x - 1 - (int)blockIdx.x; item < D / 32; item += gridDim.x) {
                SkRes e{item, l == 0 ? p.xs : XS, XS, modl + 2 * D};
                skinny<1, D>(lds, MIXS, Wout + (size_t)item * 32 * LDD, nullptr, wave, lane, e); }
        }
        SEAM(pb + 3);
        PR_BEGIN(pb + 4);
        if (IN(pb + 4)) { FRESH(); phase_norm(p, l, 1, wave, lane); }
        SEAM(pb + 4);
        PR_BEGIN(pb + 5);
        if (IN(pb + 5)) {
            pg8::Gemm g{XN, Wgu, M, 2 * DFF, D}; pg8::StaticOrder S; S.init(M, 2 * DFF, gridDim.x, blockIdx.x);
            EpiGU E{(bf16_t*)(ws + WS_UP), (float*)(ws + WS_GA), (float*)(ws + WS_GA) + (size_t)128 * 4 * DFF, p.out + O_CVP + (size_t)l * NB * 2 * DFF, p.convw + (size_t)l * 3 * DFF, p.convb + (size_t)l * DFF};
            pg8::gemm_phase<EpiGU, pg8::StaticOrder>(lds, g, S, E, nullptr, wave0);
#if defined(PROBE_GU_EXTRA)
            if (l == 1) { for (int rep = 0; rep < PROBE_GU_EXTRA; ++rep) { grid.sync(); EpiNull EN{(float*)(ws + WS_SSQ)}; pg8::gemm_phase<EpiNull, pg8::StaticOrder>(lds, g, S, EN, nullptr, wave0); } }
#endif
            FRESH();
            for (int item = (int)gridDim.x - 1 - (int)blockIdx.x; item < DFF / 32; item += gridDim.x) {
                SkGU e{item, l, p.sconv, p.convw, p.convb, ACTS, p.out + O_CVS};
                const bf16_t* b0 = Wgu + (size_t)(256 * (item >> 2) + 32 * (item & 3)) * LDD;
                skinny<2, D>(lds, HS, b0, b0 + (size_t)128 * LDD, wave, lane, e); }
        }
        SEAM(pb + 5);
        PR_BEGIN(pb + 6);
        if (IN(pb + 6)) { FRESH(); phase_fix(p, l, tid); }
        SEAM(pb + 6);
        PR_BEGIN(pb + 7);
        if (IN(pb + 7)) {
            pg8::Gemm g{(const bf16_t*)(ws + WS_UP), Wdn, M, D, DFF}; pg8::StaticOrder S; S.init(M, D, gridDim.x, blockIdx.x);
            EpiRes E{XR, XR, modl + 5 * D};
            pg8::gemm_phase<EpiRes, pg8::StaticOrder>(lds, g, S, E, nullptr, wave0); FRESH();
            for (int item = (int)gridDim.x - 1 - (int)blockIdx.x; item < D / 32; item += gridDim.x) {
                SkRes e{item, XS, XS, modl + 5 * D};
                skinny<1, DFF>(lds, ACTS, Wdn + (size_t)item * 32 * LDF, nullptr, wave, lane, e); }
        }
        SEAM(pb + 7);
    }
    if (IN(17)) { FRESH(); phase_norm(p, 0, 2, wave, lane); }
    if (PROBE_MASK) { grid.sync(); if (blockIdx.x == 0) { const unsigned long long t0 = __builtin_amdgcn_s_memrealtime(); const unsigned long long spin = PROBE_CLK ? (pr_cacc * 1000ull / (pr_acc ? pr_acc : 1ull)) : (unsigned long long)PROBE_MUL * pr_acc;
        while (__builtin_amdgcn_s_memrealtime() - t0 < spin) __builtin_amdgcn_s_sleep(8); } }
}

extern "C" void kernel_launch(void* const* d_in, const int* in_sizes, int n_in, void* d_out, int out_size, void* d_ws, size_t ws_size, hipStream_t stream) {
    static int grid = 0;
    if (grid == 0) {
        if (n_in != 23 || (size_t)out_size != O_END || ws_size < WS_END) { fprintf(stderr, "kernel_launch: unexpected shapes: n_in %d out %d (want %zu) ws %zu (want %zu)\n", n_in, out_size, (size_t)O_END, ws_size, (size_t)WS_END); grid = -1; return; }
        int dev = 0, cus = 0, per = 0;
        (void)hipGetDevice(&dev); (void)hipDeviceGetAttribute(&cus, hipDeviceAttributeMultiprocessorCount, dev);
        if (hipFuncSetAttribute((const void*)fwd, hipFuncAttributeMaxDynamicSharedMemorySize, LDS_BYTES) != hipSuccess) { fprintf(stderr, "kernel_launch: hipFuncSetAttribute failed\n"); grid = -1; return; }
        (void)hipOccupancyMaxActiveBlocksPerMultiprocessor(&per, (const void*)fwd, 512, LDS_BYTES);
        if (per < 1) { fprintf(stderr, "kernel_launch: occupancy query says %d blocks per CU\n", per); per = 1; }
        grid = cus * 1;
        fprintf(stderr, "kernel_launch: grid %d (cus %d, per-cu %d)\n", grid, cus, per);
    }
    if (grid < 0) return;
    Args a{};
    for (int i = 0; i < 23; ++i) a.in[i] = (const float*)d_in[i];
    a.out = (float*)d_out; a.ws = (unsigned char*)d_ws;
    if (hipMemsetAsync((char*)d_ws + WS_BAR, 0, 65536, stream) != hipSuccess) { fprintf(stderr, "kernel_launch: memset of barrier words failed\n"); return; }
#if MULTI
    for (int k = 0; k < NPHASE; ++k) { a.ph_lo = k; a.ph_hi = k + 1; hipLaunchKernelGGL(fwd, dim3(grid), dim3(512), LDS_BYTES, stream, a); }
#else
    a.ph_lo = 0; a.ph_hi = NPHASE;
    void* args[] = {&a};
    hipError_t e = hipLaunchCooperativeKernel((void*)fwd, dim3(grid), dim3(512), args, LDS_BYTES, stream);
    if (e != hipSuccess) fprintf(stderr, "kernel_launch: cooperative launch failed: %s (grid %d)\n", hipGetErrorString(e), grid);
#endif
}
```

```cpp
#include <hip/hip_runtime.h>
#include <hip/hip_cooperative_groups.h>
#include <cstdio>
namespace cg = cooperative_groups;
namespace pg8 {
#define PG8_LAS __attribute__((address_space(3)))
typedef unsigned short bf16_t;
typedef short bf16x8 __attribute__((ext_vector_type(8)));
typedef float f32x4 __attribute__((ext_vector_type(4)));
typedef unsigned u32x4 __attribute__((ext_vector_type(4)));
constexpr int BM = 256, BK = 64, HALF = 128, HTB = HALF * BK * 2  , STAGE_BYTES = 8 * HTB, NXCD = 8, WGM = 8;

__host__ __device__ __forceinline__ int lds_byte(int r, int c) { const int st = (r >> 4) * 2 + (c >> 5), rr = r & 15, cc = c & 31, ob = rr * 64 + cc * 2; return st * 1024 + (ob ^ (((ob >> 9) & 1) << 5)); }
__host__ __device__ __forceinline__ void stage_rc(int b, int& R, int& C) { const int st = b / 1024, sb = b % 1024, swz = sb ^ (((sb >> 9) & 1) << 5); R = (st >> 1) * 16 + swz / 64; C = (st & 1) * 32 + (swz % 64) / 2; }
__host__ __device__ __forceinline__ int perm32(int rho) { const int n = rho >> 4, i = rho & 15; return 8 * (i >> 2) + 4 * n + (i & 3); }

struct Unit { int pm, pn; };
struct Gemm { const bf16_t* A; const bf16_t* Bt; int M, N, K; };

struct StaticOrder {
    int nM, nN, nwg, G, c;
    __host__ __device__ void init(int M, int N, int G_, int c_) { nM = M / BM; nN = N / BM; nwg = nM * nN; G = G_; c = c_; }
    __host__ __device__ bool next(int i, Unit& u) const {
        const long L = (long)i * G + c; if (L >= nwg) return false;
        int wgid = (int)L; { const int q = nwg / NXCD, r = nwg % NXCD, xcd = wgid % NXCD, off = wgid / NXCD; wgid = (xcd < r ? xcd * (q + 1) : r * (q + 1) + (xcd - r) * q) + off; }
        const int nig = WGM * nN, gid = wgid / nig, fm = gid * WGM, gsz = (nM - fm) < WGM ? (nM - fm) : WGM;
        u.pm = fm + ((wgid % nig) % gsz); u.pn = (wgid % nig) / gsz; return true;
    }
    __device__ __forceinline__ void a_ready(const Unit&) const {}
    __device__ __forceinline__ void done(const Unit&) const {}
};
__device__ __forceinline__ unsigned cvt_pk_bf16(float lo, float hi) { unsigned r; asm volatile("v_cvt_pk_bf16_f32 %0, %1, %2" : "=v"(r) : "v"(lo), "v"(hi)); return r; }
template <class Epi, class Sched, bool STAMP = false>
__device__ __forceinline__ void gemm_phase(PG8_LAS unsigned char* lds, const Gemm g, const Sched& S, const Epi& E, unsigned long long* stamps, int wave_in) {
    int wv_l = wave_in; asm volatile("" : "+s"(wv_l)); int tid_l = wv_l * 64 + (int)__builtin_amdgcn_mbcnt_hi(~0u, __builtin_amdgcn_mbcnt_lo(~0u, 0u)); asm volatile("" : "+v"(tid_l)); const int tid = tid_l, wid = __builtin_amdgcn_readfirstlane(tid >> 6), lane = tid & 63, wr = wid >> 2, wc = wid & 3, fr = lane & 15, fq = lane >> 4;
    const int K = g.K, nt = K / BK, LD = K + 64;
    int ts_lo = 0, ts_hi = 0, nts = 0; const unsigned long long rt_entry = STAMP ? (unsigned long long)wall_clock64() : 0ull;
#define PG8_STAMP() do { if (STAMP && wid == 0 && nts < 64) { const unsigned long long _c = (unsigned long long)clock64(); \
        ts_lo = (lane == nts) ? (int)(unsigned)_c : ts_lo; ts_hi = (lane == nts) ? (int)(unsigned)(_c >> 32) : ts_hi; ++nts; } } while (0)
    PG8_STAMP();
    unsigned voffA[2], voffB[2];
#pragma unroll
    for (int i = 0; i < 2; ++i) { int R, C; stage_rc(tid * 16 + i * 8192, R, C); const int Rb = Epi::PERM ? ((R & ~31) + perm32(R & 31)) : R;
        voffA[i] = (unsigned)(R * LD + C) * 2u; voffB[i] = (unsigned)(Rb * LD + C) * 2u; }
    const size_t kstep = (size_t)(BK * 2);
    const size_t hstep = (size_t)HALF * LD * 2;
    const size_t tstep = 2 * hstep;
    const unsigned ldsw = (unsigned)wid * 1024u;
    const int aoff = lds_byte(wr * 64 + fr, fq * 8), boff = lds_byte(wc * 32 + fr, fq * 8);
#define PG8_SA(b, h) (((b) * 2 + (h)) * HTB)
#define PG8_SB(b, h) ((4 + (b) * 2 + (h)) * HTB)
#define PG8_STAGE(bufoff, gbase, voff) do { _Pragma("unroll") for (int _i = 0; _i < 2; ++_i) \
        __builtin_amdgcn_global_load_lds((const unsigned*)((const char*)(gbase) + (voff)[_i]), (PG8_LAS unsigned*)(lds + (bufoff) + ldsw + _i * 8192), 16, 0, 0); } while (0)
#define PG8_LDA(dst, b, h) do { _Pragma("unroll") for (int m = 0; m < 4; ++m) _Pragma("unroll") for (int k = 0; k < 2; ++k) dst[m][k] = *(const PG8_LAS bf16x8*)(lds + PG8_SA(b, h) + aoff + m * 2048 + k * 1024); } while (0)
#define PG8_LDB(dst, b, h) do { _Pragma("unroll") for (int n = 0; n < 2; ++n) _Pragma("unroll") for (int k = 0; k < 2; ++k) dst[n][k] = *(const PG8_LAS bf16x8*)(lds + PG8_SB(b, h) + boff + n * 2048 + k * 1024); } while (0)
#define PG8_MMA(ai, bj, At, Bt) do { __builtin_amdgcn_s_setprio(1); _Pragma("unroll") for (int m = 0; m < 4; ++m) _Pragma("unroll") for (int n = 0; n < 2; ++n) _Pragma("unroll") for (int k = 0; k < 2; ++k) \
        acc[ai][bj][m][n] = __builtin_amdgcn_mfma_f32_16x16x32_bf16(Bt[n][k], At[m][k], acc[ai][bj][m][n], 0, 0, 0); __builtin_amdgcn_s_setprio(0); } while (0)
#define PG8_WAIT_V(n) asm volatile("s_waitcnt vmcnt(" #n ")" ::: "memory")
#define PG8_WAIT_L(n) asm volatile("s_waitcnt lgkmcnt(" #n ")" ::: "memory")
#define PG8_BAR __builtin_amdgcn_s_barrier()
#define PG8_SCHED __builtin_amdgcn_sched_barrier(0)
    Unit cur, nxt; int ui = 0;
    if (!S.next(0, cur)) return;
    f32x4 acc[2][2][4][2];
#pragma unroll
    for (int a = 0; a < 2; ++a)
#pragma unroll
        for (int b = 0; b < 2; ++b)
#pragma unroll
            for (int m = 0; m < 4; ++m)
#pragma unroll
                for (int n = 0; n < 2; ++n) acc[a][b][m][n] = (f32x4){0.f, 0.f, 0.f, 0.f};
    bf16x8 At[4][2], B0[2][2], B1[2][2];
    const char* cA = (const char*)g.A + (size_t)cur.pm * tstep; const char* cB = (const char*)g.Bt + (size_t)cur.pn * tstep;
    S.a_ready(cur);
    PG8_STAGE(PG8_SB(0, 0), cB, voffB); PG8_STAGE(PG8_SA(0, 0), cA, voffA); PG8_STAGE(PG8_SB(0, 1), cB + hstep, voffB); PG8_STAGE(PG8_SA(0, 1), cA + hstep, voffA);
    if (wr == 1) PG8_BAR;
    PG8_WAIT_V(4); PG8_BAR;
    PG8_STAGE(PG8_SB(1, 0), cB + kstep, voffB); PG8_STAGE(PG8_SA(1, 0), cA + kstep, voffA); PG8_STAGE(PG8_SB(1, 1), cB + hstep + kstep, voffB);
    PG8_WAIT_V(6); PG8_BAR;
    PG8_STAMP();
    for (;;) {
        const bool has_next = S.next(ui + 1, nxt);
        const char* nA = has_next ? (const char*)g.A + (size_t)nxt.pm * tstep : cA; const char* nB = has_next ? (const char*)g.Bt + (size_t)nxt.pn * tstep : cB;
        for (int t = 0; t < nt; t += 2) {
            const bool last = (t == nt - 2);
            const char* a1 = cA + (size_t)(t + 1) * kstep;
            const char* a2 = last ? nA : cA + (size_t)(t + 2) * kstep; const char* b2 = last ? nB : cB + (size_t)(t + 2) * kstep;
            const char* a3 = a2 + kstep; const char* b3 = b2 + kstep;
            if (last && has_next) S.a_ready(nxt);
            PG8_LDB(B0, 0, 0); PG8_SCHED; PG8_LDA(At, 0, 0); PG8_STAGE(PG8_SA(1, 1), a1 + hstep, voffA);
            PG8_WAIT_L(8); PG8_BAR; PG8_WAIT_L(0); PG8_MMA(0, 0, At, B0); PG8_BAR; PG8_SCHED;
            PG8_LDB(B1, 0, 1); PG8_STAGE(PG8_SB(0, 0), b2, voffB);
            PG8_BAR; PG8_WAIT_L(0); PG8_MMA(0, 1, At, B1); PG8_BAR;
            PG8_LDA(At, 0, 1); PG8_STAGE(PG8_SA(0, 0), a2, voffA);
            PG8_BAR; PG8_WAIT_L(0); PG8_MMA(1, 0, At, B0); PG8_BAR; PG8_SCHED;
            PG8_STAGE(PG8_SB(0, 1), b2 + hstep, voffB);
            PG8_WAIT_V(6); PG8_BAR; PG8_MMA(1, 1, At, B1); PG8_BAR;
            PG8_LDB(B0, 1, 0); PG8_SCHED; PG8_LDA(At, 1, 0); PG8_STAGE(PG8_SA(0, 1), a2 + hstep, voffA);
            PG8_WAIT_L(8); PG8_BAR; PG8_WAIT_L(0); PG8_MMA(0, 0, At, B0); PG8_BAR; PG8_SCHED;
            PG8_LDB(B1, 1, 1); PG8_STAGE(PG8_SB(1, 0), b3, voffB);
            PG8_BAR; PG8_WAIT_L(0); PG8_MMA(0, 1, At, B1); PG8_BAR;
            PG8_LDA(At, 1, 1); PG8_STAGE(PG8_SA(1, 0), a3, voffA);
            PG8_BAR; PG8_WAIT_L(0); PG8_MMA(1, 0, At, B0); PG8_BAR; PG8_SCHED;
            PG8_STAGE(PG8_SB(1, 1), b3 + hstep, voffB);
            PG8_WAIT_V(6); PG8_BAR; PG8_MMA(1, 1, At, B1); PG8_BAR;
        }
        PG8_STAMP();
        if constexpr (!Epi::AFTER_DRAIN) { E(acc, cur, wr, wc, fr, fq); S.done(cur); }
        PG8_STAMP();
        if (!has_next) break;
#pragma unroll
        for (int a = 0; a < 2; ++a)
#pragma unroll
            for (int b = 0; b < 2; ++b)
#pragma unroll
                for (int m = 0; m < 4; ++m)
#pragma unroll
                    for (int n = 0; n < 2; ++n) acc[a][b][m][n] = (f32x4){0.f, 0.f, 0.f, 0.f};
        cur = nxt; cA = nA; cB = nB; ++ui;
    }
    PG8_WAIT_V(0);
    if (wr == 0) PG8_BAR;
    PG8_BAR;
    if constexpr (Epi::AFTER_DRAIN) { E.fused(acc, cur, wr, wc, fr, fq, lds, wid, lane); S.done(cur); }
    PG8_STAMP();
    if (STAMP && wid == 0) { stamps[lane] = lane < nts ? (((unsigned long long)(unsigned)ts_hi << 32) | (unsigned)ts_lo) : 0ull;
        if (lane == 62) stamps[62] = rt_entry; if (lane == 63) stamps[63] = (unsigned long long)wall_clock64(); }
#undef PG8_STAMP
#undef PG8_SA
#undef PG8_SB
#undef PG8_STAGE
#undef PG8_LDA
#undef PG8_LDB
#undef PG8_MMA
#undef PG8_WAIT_V
#undef PG8_WAIT_L
#undef PG8_BAR
#undef PG8_SCHED
}
}
using pg8::bf16_t; using pg8::bf16x8; using pg8::f32x4; using pg8::u32x4;
typedef float f32x16 __attribute__((ext_vector_type(16)));
typedef float f32x2 __attribute__((ext_vector_type(2)));
typedef unsigned u32x2 __attribute__((ext_vector_type(2)));
#define LAS __attribute__((address_space(3)))
#define DI __device__ __forceinline__

constexpr int D = 2048, SEQ = 2048, NB = 4, M = NB * SEQ, NS = 32, DEPTH = 2;
constexpr int INC = 3584, DFF = 5632, WIN = 128, NH = 16, NKV = 4, HD = 64, GMW = 1024, KVW = 256, AW = 1024;
constexpr int PAST = 16384;
constexpr float EPS = 1e-6f;
constexpr int NMODROWS = NB + NS;
#define G ((int)gridDim.x)

constexpr size_t O_YP = 0;
constexpr size_t O_YS = O_YP + (size_t)M * D;
constexpr size_t O_KWP = O_YS + (size_t)NS * D;
constexpr size_t O_VWP = O_KWP + (size_t)DEPTH * NB * WIN * KVW;
constexpr size_t O_GMP = O_VWP + (size_t)DEPTH * NB * WIN * KVW;
constexpr size_t O_CVP = O_GMP + (size_t)DEPTH * NB * 128 * GMW;
constexpr size_t O_KWS = O_CVP + (size_t)DEPTH * NB * 2 * DFF;
constexpr size_t O_VWS = O_KWS + (size_t)DEPTH * NS * WIN * KVW;
constexpr size_t O_GMS = O_VWS + (size_t)DEPTH * NS * WIN * KVW;
constexpr size_t O_CVS = O_GMS + (size_t)DEPTH * NS * GMW;
constexpr size_t O_END = O_CVS + (size_t)DEPTH * NS * 2 * DFF;

constexpr size_t MiB = 1u << 20;
constexpr int LDD = D + 64, LDF = DFF + 64;
constexpr size_t SZ_WIN = 15 * MiB, SZ_WOUT = 9 * MiB, SZ_WGU = 46 * MiB, SZ_WDN = 23 * MiB;
constexpr size_t WS_WIN = 0;
constexpr size_t WS_WOUT = WS_WIN + 2 * SZ_WIN;
constexpr size_t WS_WGU = WS_WOUT + 2 * SZ_WOUT;
constexpr size_t WS_WDN = WS_WGU + 2 * SZ_WGU;
constexpr size_t WS_XN = WS_WDN + 2 * SZ_WDN;
constexpr size_t WS_Q = WS_XN + 34 * MiB;
constexpr size_t WS_K = WS_Q + 16 * MiB;
constexpr size_t WS_V = WS_K + 4 * MiB;
constexpr size_t WS_U = WS_V + 4 * MiB;
constexpr size_t WS_GT = WS_U + 16 * MiB;
constexpr size_t WS_MIX = WS_GT + 16 * MiB;
constexpr size_t WS_XR = WS_MIX + 34 * MiB;
constexpr size_t WS_GA = WS_XR + 64 * MiB;
constexpr size_t WS_UP = WS_GA + 88 * MiB;
constexpr size_t WS_MOD = WS_UP + 90 * MiB;
constexpr size_t WS_ROPE = WS_MOD + 4 * MiB;
constexpr size_t WS_SSQ = WS_ROPE + 1 * MiB;
constexpr size_t WS_SMP = WS_SSQ + 1 * MiB;
constexpr size_t WS_BAR = WS_SMP + 4 * MiB;
constexpr size_t WS_END = WS_BAR + 1 * MiB;
constexpr size_t SM_XS = 0;
constexpr size_t SM_HS = SM_XS + 32 * 2048 * 4;
constexpr size_t SM_Q = SM_HS + 32 * 2048 * 2;
constexpr size_t SM_KK = SM_Q + 32 * 1024 * 4;
constexpr size_t SM_VV = SM_KK + 32 * 256 * 4;
constexpr size_t SM_UU = SM_VV + 32 * 256 * 4;
constexpr size_t SM_GG = SM_UU + 32 * 1024 * 4;
constexpr size_t SM_MIX = SM_GG + 32 * 1024 * 4;
constexpr size_t SM_ACT = SM_MIX + 32 * 2048 * 2;
constexpr size_t SM_END = SM_ACT + 32 * 5632 * 2;
static_assert(SM_END <= 4 * MiB, "sample buffers");

constexpr int LDS_BYTES = 148480;

struct Args {
    const float* in[23];
    float* out;
    unsigned char* ws;
    int ph_lo, ph_hi;
};

DI unsigned f2bf(float f) { unsigned u = __builtin_bit_cast(unsigned, f); return (u + 0x7fffu + ((u >> 16) & 1u)) >> 16; }
DI unsigned pk2(float lo, float hi) { return pg8::cvt_pk_bf16(lo, hi); }
DI float bf2f(unsigned short b) { return __builtin_bit_cast(float, ((unsigned)b) << 16); }
DI float bflo(unsigned w) { return __builtin_bit_cast(float, w << 16); }
DI float bfhi(unsigned w) { return __builtin_bit_cast(float, w & 0xffff0000u); }
DI float wave_sum(float v) {
#pragma unroll
    for (int o = 1; o < 64; o <<= 1) v += __shfl_xor(v, o);
    return v;
}
DI float gelu_tanh(float x) {
    const float u = 0.7978845608028654f * (x + 0.044715f * x * x * x);
    return x * __builtin_amdgcn_rcpf(1.0f + __expf(-2.0f * u));
}
DI float silu_f(float x) { return x * __builtin_amdgcn_rcpf(1.0f + __expf(-x)); }

DI int pair8_phys(int r32) { const int fq = r32 >> 3, n = (r32 >> 2) & 1, e = r32 & 3; return 16 * n + 4 * fq + e; }
DI int win_phys(int L) {
    if (L < 1280) { const int h2 = L >> 7, r = L & 127, hd = r >> 6, d = r & 63, n = d >> 5, d5 = d & 31, wcl = d5 >> 4, fq = (d5 >> 2) & 3, e = d5 & 3;
        return 128 * h2 + 32 * (2 * hd + wcl) + 16 * n + 4 * fq + e; }
    if (L < 2560) return (L & ~31) + pair8_phys(L & 31);
    return L;
}

struct ConvDesc { const float* W; bf16_t* WT; int K, N, type, item; };
DI int conv_phys(int type, int L) {
    if (type == 0) return win_phys(L);
    if (type == 1) return (L & ~31) + pair8_phys(L & 31);
    return 256 * (L >> 7) + (type == 3 ? 128 : 0) + (L & 96) + pair8_phys(L & 31);
}
DI void conv_load(const ConvDesc& d, int lane, f32x4 (&v)[8]) {
    const int nblk = d.N / 32, kb = d.item / nblk, nb = d.item % nblk, k0 = 64 * kb, n0 = 32 * nb;
#pragma unroll
    for (int i = 0; i < 8; ++i) { const int kk = 8 * i + (lane >> 3); v[i] = *(const f32x4*)(d.W + (size_t)(k0 + kk) * d.N + n0 + 4 * (lane & 7)); }
}
DI void conv_store(const ConvDesc& d, int lane, const f32x4 (&v)[8], LAS float* scr) {
    const int nblk = d.N / 32, kb = d.item / nblk, nb = d.item % nblk, k0 = 64 * kb, n0 = 32 * nb;
#pragma unroll
    for (int i = 0; i < 8; ++i) { const int kk = 8 * i + (lane >> 3); LAS float* s = scr + kk * 33 + 4 * (lane & 7); s[0] = v[i].x; s[1] = v[i].y; s[2] = v[i].z; s[3] = v[i].w; }
    asm volatile("s_waitcnt lgkmcnt(0)" ::: "memory");
    const int c = lane & 7;
#pragma unroll
    for (int j = 0; j < 4; ++j) { const int n = (lane >> 3) + 8 * j; const LAS float* s = scr + (8 * c) * 33 + n;
        u32x4 o; o.x = pk2(s[0 * 33], s[1 * 33]); o.y = pk2(s[2 * 33], s[3 * 33]); o.z = pk2(s[4 * 33], s[5 * 33]); o.w = pk2(s[6 * 33], s[7 * 33]);
        *(u32x4*)(d.WT + (size_t)conv_phys(d.type, n0 + n) * (d.K + 64) + k0 + 8 * c) = o; }
    asm volatile("s_waitcnt lgkmcnt(0)" ::: "memory");
}

struct P {
    const float *xp, *xs, *ck, *cv, *sconv, *cp, *cs, *wada, *bada, *g1, *g2, *win, *gmgain, *gmws, *gmbs, *sinks, *wout, *wgate, *wup, *convw, *convb, *wdown, *gfinal;
    float* out; unsigned char* ws;
};
#define RLX_AGENT __ATOMIC_RELAXED, __HIP_MEMORY_SCOPE_AGENT
#define XB_TMO      128
#define XB_XCNT(j)  (256  + 64 * (j))
#define XB_XSUB(j)  (1280 + 64 * (j))
#define XB_XGEN(j)  (2304 + 64 * (j))
#define XB_TOP      3328
#define XB_TOPGEN   3392
#define XCD_BAR_WORDS 3456
#define XB_SPIN_CAP (1u << 18)

__device__ __forceinline__ unsigned xb_ld(unsigned* p)              { return __hip_atomic_load(p, __ATOMIC_RELAXED, __HIP_MEMORY_SCOPE_AGENT); }
__device__ __forceinline__ unsigned xb_add(unsigned* p, unsigned v) { return __hip_atomic_fetch_add(p, v, __ATOMIC_RELAXED, __HIP_MEMORY_SCOPE_AGENT); }
__device__ __forceinline__ unsigned xb_xcc_id() { return (unsigned)__builtin_amdgcn_s_getreg((3 << 11) | 20) & 0xFu; }
#define XB_SPIN(cond, bar) do { unsigned _sp = 0; while (cond) { __builtin_amdgcn_s_sleep(1); \
    if ((++_sp & 255u) == 0u) { if (xb_ld(&(bar)[XB_TMO])) break; if (_sp > XB_SPIN_CAP) { atomicAdd(&(bar)[XB_TMO], 1u); break; } } } } while (0)

struct XcdBarrier {
    unsigned* bar; unsigned x;
    volatile LAS unsigned* st;
};

__device__ __forceinline__ XcdBarrier xcd_barrier_post(unsigned* bar, volatile LAS unsigned* st) {
    XcdBarrier b; b.bar = bar; b.x = xb_xcc_id(); b.st = st;
    if (threadIdx.x == 0) (void)xb_add(&bar[XB_XCNT(b.x)], 1u);
    return b;
}
__device__ __forceinline__ void xcd_barrier_complete(unsigned* bar, unsigned x, unsigned& nloc, unsigned& nx) {
    const unsigned GG = gridDim.x * gridDim.y * gridDim.z;
    unsigned sum, cnt, mine, sp = 0u;
    for (;;) {
        sum = 0u; cnt = 0u; mine = 0u;
#pragma unroll
        for (unsigned j = 0; j < 16; ++j) { const unsigned c = xb_ld(&bar[XB_XCNT(j)]); sum += c; cnt += (c > 0u) ? 1u : 0u; mine = (j == x) ? c : mine; }
        if (sum == GG) break;
        __builtin_amdgcn_s_sleep(1);
        if ((++sp & 255u) == 0u) { if (xb_ld(&bar[XB_TMO])) break; if (sp > XB_SPIN_CAP) { atomicAdd(&bar[XB_TMO], 1u); break; } }
    }
    nloc = mine > 0u ? mine : 1u; nx = cnt > 0u ? cnt : 1u;
}

__device__ __forceinline__ void xcd_barrier(const XcdBarrier& b) {
    asm volatile("s_waitcnt vmcnt(0)" ::: "memory");
    __syncthreads();
    if (threadIdx.x == 0) {
        unsigned* bar = b.bar;
        __builtin_amdgcn_s_waitcnt(0);
        unsigned nloc = b.st[0], nx = b.st[1];
        if (nloc == 0u) { xcd_barrier_complete(bar, b.x, nloc, nx); b.st[0] = nloc; b.st[1] = nx; }
        const unsigned old = xb_add(&bar[XB_XSUB(b.x)], 1u);
        const unsigned gen = old / nloc;
        if (old + 1u == (gen + 1u) * nloc) {
            __builtin_amdgcn_fence(__ATOMIC_RELEASE, "agent");
            asm volatile("s_waitcnt vmcnt(0)" ::: "memory");
            const unsigned og = xb_add(&bar[XB_TOP], 1u);
            const unsigned tg = og / nx;
            if (og + 1u == (tg + 1u) * nx) xb_add(&bar[XB_TOPGEN], 1u);
            else XB_SPIN(xb_ld(&bar[XB_TOPGEN]) == tg, bar);
            __builtin_amdgcn_fence(__ATOMIC_ACQUIRE, "agent");
            xb_add(&bar[XB_XGEN(b.x)], 1u);
            asm volatile("s_waitcnt vmcnt(0)" ::: "memory");
        } else {
            XB_SPIN(xb_ld(&bar[XB_XGEN(b.x)]) == gen, bar);
            __builtin_amdgcn_fence(__ATOMIC_ACQUIRE, "agent");
            asm volatile("s_waitcnt vmcnt(0)" ::: "memory");
        }
    }
    __syncthreads();
}
DI bf16x8 pack8(const float (&w)[8]) { u32x4 o; o.x = pk2(w[0], w[1]); o.y = pk2(w[2], w[3]); o.z = pk2(w[4], w[5]); o.w = pk2(w[6], w[7]); return __builtin_bit_cast(bf16x8, o); }
DI bf16x8 pack8v(f32x4 a, f32x4 b) { u32x4 o; o.x = pk2(a.x, a.y); o.y = pk2(a.z, a.w); o.z = pk2(b.x, b.y); o.w = pk2(b.z, b.w); return __builtin_bit_cast(bf16x8, o); }
#define MFMA16(a, b, c) __builtin_amdgcn_mfma_f32_16x16x32_bf16((a), (b), (c), 0, 0, 0)
#define MFMA32(a, b, c) __builtin_amdgcn_mfma_f32_32x32x16_bf16((a), (b), (c), 0, 0, 0)

DI void phaseA(const P& p, LAS unsigned char* lds, int tid, int wave, int lane) {
    const int gw = blockIdx.x * 8 + wave, NGW = G * 8;
    { float* ssq = (float*)(p.ws + WS_SSQ); for (int i = blockIdx.x * 512 + tid; i < 2 * M; i += G * 512) ssq[i] = 0.f; }
    { float* rc = (float*)(p.ws + WS_ROPE);
      for (int i = blockIdx.x * 512 + tid; i < 2048 * 32 + 32; i += G * 512) {
          const int pos = i < 2048 * 32 ? (i >> 5) : PAST, j = i & 31;
          const float inv = exp2f(-(float)j * (13.287712379549449f / 32.0f));
          const float ang = (float)pos * inv; float sn, cs; sincosf(ang, &sn, &cs);
          if (i < 2048 * 32) { rc[i] = cs; rc[2048 * 32 + i] = sn; } else { rc[2 * 2048 * 32 + j] = cs; rc[2 * 2048 * 32 + 32 + j] = sn; }
      } }
    for (int item = blockIdx.x; item < 2 * 384; item += G) {
        const int l = item / 384, cs = item % 384, h = lane >> 5, r = lane & 31;
        const float* W = p.wada + (size_t)l * D * 6 * D + cs * 32 + r;
        const float* c0 = (r < 4) ? p.cp + r * D : p.cs + (r - 4) * D;
        const float* c1 = p.cs + (28 + (r & 3)) * D;
        f32x16 acc0, acc1;
#pragma unroll
        for (int q = 0; q < 16; ++q) { acc0[q] = 0.f; acc1[q] = 0.f; }
#pragma unroll 4
        for (int ks = 0; ks < 16; ++ks) {
            const int k = wave * 256 + ks * 16 + h * 8;
            float w[8];
#pragma unroll
            for (int j = 0; j < 8; ++j) w[j] = W[(size_t)(k + j) * (6 * D)];
            const bf16x8 bfr = pack8(w);
            f32x4 a0 = *(const f32x4*)(c0 + k), a1 = *(const f32x4*)(c0 + k + 4);
            f32x4 e0 = {0.f, 0.f, 0.f, 0.f}, e1 = e0;
            if (r < 4) { e0 = *(const f32x4*)(c1 + k); e1 = *(const f32x4*)(c1 + k + 4); }
#pragma unroll
            for (int q = 0; q < 4; ++q) { a0[q] = silu_f(a0[q]); a1[q] = silu_f(a1[q]); e0[q] = silu_f(e0[q]); e1[q] = silu_f(e1[q]); }
            acc0 = MFMA32(pack8v(a0, a1), bfr, acc0);
            acc1 = MFMA32(pack8v(e0, e1), bfr, acc1);
        }
        LAS float* red = (LAS float*)lds;
#pragma unroll
        for (int q = 0; q < 16; ++q) { red[((wave * 2 + 0) * 16 + q) * 64 + lane] = acc0[q]; red[((wave * 2 + 1) * 16 + q) * 64 + lane] = acc1[q]; }
        __syncthreads();
        for (int idx = tid; idx < NMODROWS * 32; idx += 512) {
            const int row = idx >> 5, col = idx & 31, mt = row >> 5, rr = row & 31, q = (rr >> 3) * 4 + (rr & 3), ln = ((rr >> 2) & 1) * 32 + col;
            float s = 0.f;
#pragma unroll
            for (int w8 = 0; w8 < 8; ++w8) s += red[((w8 * 2 + mt) * 16 + q) * 64 + ln];
            ((float*)(p.ws + WS_MOD))[((size_t)l * NMODROWS + row) * (6 * D) + cs * 32 + col] = s + p.bada[l * 6 * D + cs * 32 + col];
        }
        __syncthreads();
    }
    LAS float* scr = (LAS float*)(lds + wave * 8448);
    constexpr int I_IN = 32 * 112, I_OUT = 32 * 64, I_G = 32 * 176, I_DN = 88 * 64, I_L = I_IN + I_OUT + 2 * I_G + I_DN;
    auto decode = [&](int it) { ConvDesc d; const int l = it / I_L; int r = it % I_L;
        if (r < I_IN) { d.W = p.win + (size_t)l * D * INC; d.WT = (bf16_t*)(p.ws + WS_WIN + l * SZ_WIN); d.K = D; d.N = INC; d.type = 0; d.item = r; return d; } r -= I_IN;
        if (r < I_OUT) { d.W = p.wout + (size_t)l * D * D; d.WT = (bf16_t*)(p.ws + WS_WOUT + l * SZ_WOUT); d.K = D; d.N = D; d.type = 1; d.item = r; return d; } r -= I_OUT;
        if (r < I_G) { d.W = p.wgate + (size_t)l * D * DFF; d.WT = (bf16_t*)(p.ws + WS_WGU + l * SZ_WGU); d.K = D; d.N = DFF; d.type = 2; d.item = r; return d; } r -= I_G;
        if (r < I_G) { d.W = p.wup + (size_t)l * D * DFF; d.WT = (bf16_t*)(p.ws + WS_WGU + l * SZ_WGU); d.K = D; d.N = DFF; d.type = 3; d.item = r; return d; } r -= I_G;
        d.W = p.wdown + (size_t)l * DFF * D; d.WT = (bf16_t*)(p.ws + WS_WDN + l * SZ_WDN); d.K = DFF; d.N = D; d.type = 1; d.item = r; return d; };
    { int it = gw; ConvDesc d = decode(it < 2 * I_L ? it : 0); f32x4 v[8];
      if (it < 2 * I_L) conv_load(d, lane, v);
      while (it < 2 * I_L) {
          const int nit = it + NGW; ConvDesc nd = decode(nit < 2 * I_L ? nit : 0); f32x4 nv[8];
          if (nit < 2 * I_L) conv_load(nd, lane, nv);
          conv_store(d, lane, v, scr);
          it = nit; d = nd;
#pragma unroll
          for (int i = 0; i < 8; ++i) v[i] = nv[i];
      } }
}

DI void phase_norm(const P& p, int l, int which, int wave, int lane) {
    const int gw = blockIdx.x * 8 + wave, NGW = G * 8;
    const float* mod = (const float*)(p.ws + WS_MOD) + (size_t)l * NMODROWS * 6 * D;
    const float* gvec = which == 0 ? p.g1 + l * D : which == 1 ? p.g2 + l * D : p.gfinal;
    const bool first = (l == 0 && which == 0);
    for (int row = gw; row < M + NS; row += NGW) {
        const float* x; bf16_t* o; float* of; int mrow;
        if (row < M) { x = (first ? p.xp : (const float*)(p.ws + WS_XR)) + (size_t)row * D; o = (bf16_t*)(p.ws + WS_XN) + (size_t)row * LDD; of = p.out + O_YP + (size_t)row * D; mrow = row >> 11; }
        else { const int s = row - M; x = (first ? p.xs : (const float*)(p.ws + WS_SMP + SM_XS)) + (size_t)s * D; o = (bf16_t*)(p.ws + WS_SMP + SM_HS) + (size_t)s * D; of = p.out + O_YS + (size_t)s * D; mrow = NB + s; }
        f32x4 v[8]; float ss = 0.f;
        if (row < M && !first) {
#pragma unroll
            for (int j = 0; j < 8; ++j) { const u32x2 w = ((const u32x2*)((const bf16_t*)(p.ws + WS_XR) + (size_t)row * D))[lane + 64 * j]; v[j] = (f32x4){bflo(w.x), bfhi(w.x), bflo(w.y), bfhi(w.y)}; }
        } else {
#pragma unroll
            for (int j = 0; j < 8; ++j) v[j] = ((const f32x4*)x)[lane + 64 * j];
        }
#pragma unroll
        for (int j = 0; j < 8; ++j) ss += (v[j].x * v[j].x + v[j].y * v[j].y) + (v[j].z * v[j].z + v[j].w * v[j].w);
        const float rstd = rsqrtf(wave_sum(ss) * (1.0f / D) + EPS);
        if (which == 2) {
#pragma unroll
            for (int j = 0; j < 8; ++j) { const f32x4 g = ((const f32x4*)gvec)[lane + 64 * j]; ((f32x4*)of)[lane + 64 * j] = v[j] * rstd * g; }
        } else {
            const float* sh = mod + (size_t)mrow * 6 * D + (which == 0 ? 0 : 3) * D; const float* sc = sh + D;
#pragma unroll
            for (int j = 0; j < 8; ++j) { const f32x4 g = ((const f32x4*)gvec)[lane + 64 * j], c = ((const f32x4*)sc)[lane + 64 * j], h = ((const f32x4*)sh)[lane + 64 * j];
                const f32x4 y = v[j] * rstd * g * (c + 1.0f) + h; u32x2 w; w.x = pk2(y.x, y.y); w.y = pk2(y.z, y.w); ((u32x2*)o)[lane + 64 * j] = w; }
        }
    }
}

struct EpiIn {
    static constexpr bool PERM = false, AFTER_DRAIN = false;
    bf16_t *Q, *K, *V, *U, *GT; float* ssq; const float* rope; float *kwin, *vwin, *gmv; LAS unsigned char* tbuf;
    DI void operator()(const f32x4 (&acc)[2][2][4][2], const pg8::Unit& u, int wr, int wc, int fr, int fq) const {
        const int pn = u.pn, b = u.pm >> 3;
#pragma unroll
        for (int ai = 0; ai < 2; ++ai)
#pragma unroll
            for (int m = 0; m < 4; ++m) {
                const int row = u.pm * 256 + ai * 128 + wr * 64 + m * 16 + fr, t = row & 2047;
                if (pn <= 4) {
                    const int dh = 16 * (wc & 1) + 4 * fq;
                    const f32x4 cs = *(const f32x4*)(rope + t * 32 + dh), sn = *(const f32x4*)(rope + 65536 + t * 32 + dh);
#pragma unroll
                    for (int bj = 0; bj < 2; ++bj) {
                        const f32x4 x1 = acc[ai][bj][m][0], x2 = acc[ai][bj][m][1];
                        const f32x4 o1 = x1 * cs - x2 * sn, o2 = x2 * cs + x1 * sn;
                        const int hc = (2 * bj + (wc >> 1)) * 64 + dh;
                        u32x2 w1, w2; w1.x = pk2(o1.x, o1.y); w1.y = pk2(o1.z, o1.w); w2.x = pk2(o2.x, o2.y); w2.y = pk2(o2.z, o2.w);
                        if (pn < 4) { bf16_t* dst = Q + (size_t)row * 1024 + pn * 256 + hc; *(u32x2*)dst = w1; *(u32x2*)(dst + 32) = w2; }
                        else { bf16_t* dst = K + (size_t)row * 256 + hc; *(u32x2*)dst = w1; *(u32x2*)(dst + 32) = w2;
                            if (t >= 1920) { float* w = kwin + ((size_t)(b * 128 + t - 1920) * 256 + hc); *(f32x4*)w = o1; *(f32x4*)(w + 32) = o2; } }
                    }
                } else if (pn == 5) {
#pragma unroll
                    for (int bj = 0; bj < 2; ++bj) {
                        const int col = 128 * bj + 32 * wc + 8 * fq; const f32x4 v0 = acc[ai][bj][m][0], v1 = acc[ai][bj][m][1];
                        u32x4 w; w.x = pk2(v0.x, v0.y); w.y = pk2(v0.z, v0.w); w.z = pk2(v1.x, v1.y); w.w = pk2(v1.z, v1.w);
                        *(u32x4*)(V + (size_t)row * 256 + col) = w;
                        if (t >= 1920) { float* o = vwin + ((size_t)(b * 128 + t - 1920) * 256 + col); *(f32x4*)o = v0; *(f32x4*)(o + 4) = v1; }
                    }
                } else if (pn < 10) {
#pragma unroll
                    for (int bj = 0; bj < 2; ++bj) {
                        const int col = 256 * (pn - 6) + 128 * bj + 32 * wc + 8 * fq; f32x4 v0 = acc[ai][bj][m][0], v1 = acc[ai][bj][m][1];
#pragma unroll
                        for (int e = 0; e < 4; ++e) { v0[e] = gelu_tanh(v0[e]); v1[e] = gelu_tanh(v1[e]); }
                        u32x4 w; w.x = pk2(v0.x, v0.y); w.y = pk2(v0.z, v0.w); w.z = pk2(v1.x, v1.y); w.w = pk2(v1.z, v1.w);
                        *(u32x4*)(U + (size_t)row * 1024 + col) = w;
                    }
                } else {
                    float s = 0.f; LAS unsigned char* tb = tbuf + (wr * 4 + wc) * 2048;
#pragma unroll
                    for (int bj = 0; bj < 2; ++bj)
#pragma unroll
                        for (int n = 0; n < 2; ++n) {
                            const int col = 256 * (pn - 10) + 128 * bj + 32 * wc + 16 * n + 4 * fq; f32x4 g = acc[ai][bj][m][n];
#pragma unroll
                            for (int e = 0; e < 4; ++e) { g[e] = gelu_tanh(g[e]); s += g[e] * g[e]; *(LAS unsigned short*)(tb + (32 * bj + 16 * n + 4 * fq + e) * 32 + fr * 2) = (unsigned short)f2bf(g[e]); }
                            if (t >= 1920) *(f32x4*)(gmv + ((size_t)(b * 128 + t - 1920) * 1024 + col)) = g;
                        }
                    asm volatile("s_waitcnt lgkmcnt(0)" ::: "memory");
                    { const int lane = fq * 16 + fr, t0 = (u.pm * 256 + ai * 128 + wr * 64 + m * 16) & 2047;
#pragma unroll
                      for (int q = 0; q < 2; ++q) { const int id = lane + 64 * q, lc = id & 63, half = id >> 6;
                          const u32x4 v = *(const LAS u32x4*)(tb + lc * 32 + half * 16);
                          const int col = 256 * (pn - 10) + 128 * (lc >> 5) + 32 * wc + (lc & 31);
                          *(u32x4*)(GT + ((((size_t)b * 256 + (t0 >> 3) + half) * 1024 + col) << 3)) = v; }
                    }
                    asm volatile("s_waitcnt lgkmcnt(0)" ::: "memory");
                    s += __shfl_xor(s, 16); s += __shfl_xor(s, 32);
                    if (fq == 0) __hip_atomic_fetch_add(ssq + row, s, __ATOMIC_RELAXED, __HIP_MEMORY_SCOPE_AGENT);
                }
            }
    }
};
template <bool BASE_F32>
struct EpiRes {
    static constexpr bool PERM = false, AFTER_DRAIN = false;
    const float* basef; bf16_t* xr; const float* gate;
    DI void operator()(const f32x4 (&acc)[2][2][4][2], const pg8::Unit& u, int wr, int wc, int fr, int fq) const {
        const int b = u.pm >> 3; const int col0 = u.pn * 256 + wc * 32 + 8 * fq;
        f32x4 gv[2][2];
#pragma unroll
        for (int bj = 0; bj < 2; ++bj)
#pragma unroll
            for (int n = 0; n < 2; ++n) gv[bj][n] = *(const f32x4*)(gate + (size_t)b * 6 * D + col0 + bj * 128 + n * 4);
#pragma unroll
        for (int ai = 0; ai < 2; ++ai) {
            f32x4 bs[4][2][2];
#pragma unroll
            for (int m = 0; m < 4; ++m) { const size_t off = (size_t)(u.pm * 256 + ai * 128 + wr * 64 + m * 16 + fr) * D + col0;
#pragma unroll
                for (int bj = 0; bj < 2; ++bj) {
                    if (BASE_F32) { bs[m][bj][0] = *(const f32x4*)(basef + off + bj * 128); bs[m][bj][1] = *(const f32x4*)(basef + off + bj * 128 + 4); }
                    else { const u32x4 w = *(const u32x4*)(xr + off + bj * 128); bs[m][bj][0] = (f32x4){bflo(w.x), bfhi(w.x), bflo(w.y), bfhi(w.y)}; bs[m][bj][1] = (f32x4){bflo(w.z), bfhi(w.z), bflo(w.w), bfhi(w.w)}; } } }
#pragma unroll
            for (int m = 0; m < 4; ++m) { const size_t off = (size_t)(u.pm * 256 + ai * 128 + wr * 64 + m * 16 + fr) * D + col0;
#pragma unroll
                for (int bj = 0; bj < 2; ++bj) { const f32x4 o0 = bs[m][bj][0] + gv[bj][0] * acc[ai][bj][m][0], o1 = bs[m][bj][1] + gv[bj][1] * acc[ai][bj][m][1];
                    u32x4 w; w.x = pk2(o0.x, o0.y); w.y = pk2(o0.z, o0.w); w.z = pk2(o1.x, o1.y); w.w = pk2(o1.z, o1.w);
                    *(u32x4*)(xr + off + bj * 128) = w; } }
            asm volatile("" ::: "memory"); }
    }
};
DI float dpp_ror1(float v) { return __builtin_bit_cast(float, __builtin_amdgcn_update_dpp(0, __builtin_bit_cast(int, v), 0x121, 0xf, 0xf, false)); }
DI float dpp_ror2(float v) { return __builtin_bit_cast(float, __builtin_amdgcn_update_dpp(0, __builtin_bit_cast(int, v), 0x122, 0xf, 0xf, false)); }
struct EpiGU {
    static constexpr bool PERM = false, AFTER_DRAIN = false;
    bf16_t* ACT; float* SA; float* SU; float* cvp; const float* cw; const float* cb;
    DI void operator()(const f32x4 (&acc)[2][2][4][2], const pg8::Unit& u, int wr, int wc, int fr, int fq) const {
        const int b = u.pm >> 3, f0 = u.pn * 128 + wc * 32 + 8 * fq;
        float w0[8], w1[8], w2[8], bb[8];
#pragma unroll
        for (int q = 0; q < 2; ++q) { const f32x4 x0 = *(const f32x4*)(cw + f0 + 4 * q), x1 = *(const f32x4*)(cw + DFF + f0 + 4 * q), x2 = *(const f32x4*)(cw + 2 * DFF + f0 + 4 * q), x3 = *(const f32x4*)(cb + f0 + 4 * q);
#pragma unroll
            for (int e = 0; e < 4; ++e) { w0[4 * q + e] = x0[e]; w1[4 * q + e] = x1[e]; w2[4 * q + e] = x2[e]; bb[4 * q + e] = x3[e]; } }
#pragma unroll
        for (int ai = 0; ai < 2; ++ai) {
            const int blk = u.pm * 4 + ai * 2 + wr;
#pragma unroll
            for (int m = 0; m < 4; ++m) { const int row = u.pm * 256 + ai * 128 + wr * 64 + m * 16 + fr, t = row & 2047;
                float o[8];
#pragma unroll
                for (int n = 0; n < 2; ++n)
#pragma unroll
                    for (int e = 0; e < 4; ++e) { const float a = acc[ai][0][m][n][e], ap = acc[ai][0][m > 0 ? m - 1 : 0][n][e];
                        const float r1a = dpp_ror1(a), r1b = dpp_ror1(ap), r2a = dpp_ror2(a), r2b = dpp_ror2(ap);
                        const float p1 = fr >= 1 ? r1a : r1b, p2 = fr >= 2 ? r2a : r2b;
                        const int c = 4 * n + e; const float cv = bb[c] + w0[c] * p2 + w1[c] * p1 + w2[c] * a;
                        o[c] = silu_f(cv) * acc[ai][1][m][n][e]; }
                const f32x4 g0 = acc[ai][0][m][0], g1 = acc[ai][0][m][1];
                if (m == 0 && fr < 2) {
                    float* sa = SA + ((size_t)(blk * 4 + 2 + fr)) * DFF + f0; *(f32x4*)sa = g0; *(f32x4*)(sa + 4) = g1;
                    float* su = SU + ((size_t)(blk * 2 + fr)) * DFF + f0; *(f32x4*)su = acc[ai][1][m][0]; *(f32x4*)(su + 4) = acc[ai][1][m][1];
                } else {
                    u32x4 w; w.x = pk2(o[0], o[1]); w.y = pk2(o[2], o[3]); w.z = pk2(o[4], o[5]); w.w = pk2(o[6], o[7]);
                    *(u32x4*)(ACT + (size_t)row * LDF + f0) = w;
                }
                if (m == 3 && fr >= 14) { float* sa = SA + ((size_t)(blk * 4 + fr - 14)) * DFF + f0; *(f32x4*)sa = g0; *(f32x4*)(sa + 4) = g1; }
                if (t >= 2046) { float* oo = cvp + ((size_t)(b * 2 + t - 2046) * DFF + f0); *(f32x4*)oo = g0; *(f32x4*)(oo + 4) = g1; }
            }
        }
    }
};

struct EpiNull {
    static constexpr bool PERM = false, AFTER_DRAIN = false;
    float* sink;
    DI void operator()(const f32x4 (&acc)[2][2][4][2], const pg8::Unit& u, int wr, int wc, int fr, int fq) const {
        f32x4 s = {0.f, 0.f, 0.f, 0.f};
#pragma unroll
        for (int ai = 0; ai < 2; ++ai)
#pragma unroll
            for (int bj = 0; bj < 2; ++bj)
#pragma unroll
                for (int m = 0; m < 4; ++m)
#pragma unroll
                    for (int n = 0; n < 2; ++n) s += acc[ai][bj][m][n];
        if (s.x + s.y + s.z + s.w == 1234567.0f) sink[8191] = s.x;
    }
};
DI void attn_unit(const P& p, int l, int unit, LAS unsigned char* lds, int tid, int wave, int lane) {
    const int b = unit >> 6, n = (unit >> 2) & 15, kvh = unit & 3;
    const bf16_t* Kb = (const bf16_t*)(p.ws + WS_K); const bf16_t* Vb = (const bf16_t*)(p.ws + WS_V); const bf16_t* Qb = (const bf16_t*)(p.ws + WS_Q);
    bf16_t* MIX = (bf16_t*)(p.ws + WS_MIX);
    LAS unsigned char* Ks = lds;
    LAS unsigned char* Vt = lds + 256 * 144;
    const int tok0 = b * 2048 + (n - 1) * 128;
#pragma unroll
    for (int i = 0; i < 4; ++i) { const int id = i * 512 + tid, key = id >> 3, part = id & 7;
        u32x4 v = {0u, 0u, 0u, 0u}; if (n > 0 || key >= 128) v = *(const u32x4*)(Kb + (size_t)(tok0 + key) * 256 + kvh * 64 + part * 8);
        *(LAS u32x4*)(Ks + key * 144 + part * 16) = v; }
#pragma unroll
    for (int i = 0; i < 4; ++i) { const int id = i * 512 + tid, key = id & 255, part = id >> 8;
        u32x4 v = {0u, 0u, 0u, 0u}; if (n > 0 || key >= 128) v = *(const u32x4*)(Vb + (size_t)(tok0 + key) * 256 + kvh * 64 + part * 8);
        LAS unsigned short* d = (LAS unsigned short*)(Vt + (part * 8) * 528 + key * 2);
        d[0 * 264] = (unsigned short)(v.x & 0xffffu); d[1 * 264] = (unsigned short)(v.x >> 16); d[2 * 264] = (unsigned short)(v.y & 0xffffu); d[3 * 264] = (unsigned short)(v.y >> 16);
        d[4 * 264] = (unsigned short)(v.z & 0xffffu); d[5 * 264] = (unsigned short)(v.z >> 16); d[6 * 264] = (unsigned short)(v.w & 0xffffu); d[7 * 264] = (unsigned short)(v.w >> 16); }
    __syncthreads();
    const int q16 = lane & 15, g4 = lane >> 4;
    for (int it = 0; it < 4; ++it) {
        const int qg = wave * 4 + it, g = qg >> 3, i0 = (qg & 7) * 16, head = kvh * 4 + g, nt0 = i0 >> 4;
        const size_t qtok = (size_t)b * 2048 + n * 128 + i0 + q16;
        const bf16x8 q0 = *(const bf16x8*)(Qb + qtok * 1024 + head * 64 + g4 * 8), q1 = *(const bf16x8*)(Qb + qtok * 1024 + head * 64 + 32 + g4 * 8);
        f32x4 s[9];
#pragma unroll
        for (int tt = 0; tt < 9; ++tt) { const LAS unsigned char* kp = Ks + ((nt0 + tt) * 16 + q16) * 144 + g4 * 16;
            const bf16x8 a0 = *(const LAS bf16x8*)kp, a1 = *(const LAS bf16x8*)(kp + 64);
            f32x4 z = {0.f, 0.f, 0.f, 0.f}; z = MFMA16(a0, q0, z); s[tt] = MFMA16(a1, q1, z); }
        const int iq = i0 + q16; float mx = -1e30f;
#pragma unroll
        for (int tt = 0; tt < 9; ++tt)
#pragma unroll
            for (int r = 0; r < 4; ++r) { const int j = (nt0 + tt) * 16 + g4 * 4 + r; const bool ok = (j >= iq) && (j <= iq + 128) && (n > 0 || j >= 128);
                const float v = ok ? s[tt][r] * 0.125f : -1e30f; s[tt][r] = v; mx = fmaxf(mx, v); }
        mx = fmaxf(mx, __shfl_xor(mx, 16)); mx = fmaxf(mx, __shfl_xor(mx, 32));
        const float sink = p.sinks[l * NH + head]; const float mm = fmaxf(mx, sink);
        float sum = 0.f;
#pragma unroll
        for (int tt = 0; tt < 9; ++tt)
#pragma unroll
            for (int r = 0; r < 4; ++r) { const float e = __expf(s[tt][r] - mm); s[tt][r] = e; sum += e; }
        sum += __shfl_xor(sum, 16); sum += __shfl_xor(sum, 32);
        const float inv = 1.0f / (sum + __expf(sink - mm));
        f32x4 o[4];
#pragma unroll
        for (int dt = 0; dt < 4; ++dt) o[dt] = (f32x4){0.f, 0.f, 0.f, 0.f};
#pragma unroll
        for (int i = 0; i < 5; ++i) {
            const f32x4 pl = s[2 * i], ph = (2 * i + 1 < 9) ? s[(2 * i + 1 < 9) ? 2 * i + 1 : 8] : (f32x4){0.f, 0.f, 0.f, 0.f};
            const bf16x8 pb = pack8v(pl, ph);
#pragma unroll
            for (int dt = 0; dt < 4; ++dt) { const LAS unsigned char* vp = Vt + (16 * dt + q16) * 528 + ((nt0 + 2 * i) * 16 + g4 * 4) * 2;
                u32x4 va; const u32x2 lo = *(const LAS u32x2*)vp; va.x = lo.x; va.y = lo.y;
                if (2 * i + 1 < 9) { const u32x2 hi = *(const LAS u32x2*)(vp + 32); va.z = hi.x; va.w = hi.y; } else { va.z = 0u; va.w = 0u; }
                o[dt] = MFMA16(__builtin_bit_cast(bf16x8, va), pb, o[dt]); }
        }
#pragma unroll
        for (int dt = 0; dt < 4; ++dt) { u32x2 w; w.x = pk2(o[dt].x * inv, o[dt].y * inv); w.y = pk2(o[dt].z * inv, o[dt].w * inv);
            *(u32x2*)(MIX + qtok * LDD + head * 64 + 16 * dt + 4 * g4) = w; }
    }
    __syncthreads();
}

DI void gmlp_unit(const P& p, int l, int unit, int wave, int lane) {
    const int b = unit >> 7, c = (unit >> 3) & 15, h = unit & 7;
    const int q16 = lane & 15, g4 = lane >> 4, i = 16 * wave + q16;
    const float* Wrow = p.gmws + (((size_t)l * 8 + h) * 128 + i) * 128;
    const float* ssq = (const float*)(p.ws + WS_SSQ) + l * M + b * 2048 + c * 128;
    const bf16_t* GT = (const bf16_t*)(p.ws + WS_GT) + (((size_t)(b * 16 + c) * 16) * 1024 + h * 128) * 8;
    const bf16_t* U = (const bf16_t*)(p.ws + WS_U); bf16_t* MIX = (bf16_t*)(p.ws + WS_MIX);
    f32x4 acc[8];
#pragma unroll
    for (int dt = 0; dt < 8; ++dt) acc[dt] = (f32x4){0.f, 0.f, 0.f, 0.f};
    const int ksmax = wave >> 1;
    for (int ks = 0; ks <= ksmax; ++ks) {
        const int j0 = 32 * ks + 8 * g4;
        const f32x4 w0 = *(const f32x4*)(Wrow + j0), w1 = *(const f32x4*)(Wrow + j0 + 4), s0 = *(const f32x4*)(ssq + j0), s1 = *(const f32x4*)(ssq + j0 + 4);
        float wv[8];
#pragma unroll
        for (int jj = 0; jj < 4; ++jj) { wv[jj] = (j0 + jj <= i) ? w0[jj] * rsqrtf(s0[jj] * (1.0f / GMW) + EPS) : 0.f; wv[4 + jj] = (j0 + 4 + jj <= i) ? w1[jj] * rsqrtf(s1[jj] * (1.0f / GMW) + EPS) : 0.f; }
        const bf16x8 bw = pack8(wv);
#pragma unroll
        for (int dt = 0; dt < 8; ++dt) { const bf16x8 a = *(const bf16x8*)(GT + ((size_t)(4 * ks + g4) * 1024 + 16 * dt + q16) * 8); acc[dt] = MFMA16(a, bw, acc[dt]); }
    }
    const size_t tok = (size_t)b * 2048 + c * 128 + i;
    const float bias = p.gmbs[(l * 8 + h) * 128 + i];
#pragma unroll
    for (int dt = 0; dt < 8; ++dt) { const int col = h * 128 + 16 * dt + 4 * g4;
        const f32x4 gain = *(const f32x4*)(p.gmgain + l * GMW + col); const u32x2 uu = *(const u32x2*)(U + tok * 1024 + col);
        const float o0 = bflo(uu.x) * (gain.x * acc[dt].x + bias), o1 = bfhi(uu.x) * (gain.y * acc[dt].y + bias), o2 = bflo(uu.y) * (gain.z * acc[dt].z + bias), o3 = bfhi(uu.y) * (gain.w * acc[dt].w + bias);
        u32x2 w; w.x = pk2(o0, o1); w.y = pk2(o2, o3); *(u32x2*)(MIX + tok * LDD + 1024 + col) = w; }
}

DI void sample_part(const P& p, int l, int s, int hp, LAS unsigned char* lds, int tid, int wave, int lane) {
    const float* qS = (const float*)(p.ws + WS_SMP + SM_Q) + s * 1024; const float* kS = (const float*)(p.ws + WS_SMP + SM_KK) + s * 256; const float* vS = (const float*)(p.ws + WS_SMP + SM_VV) + s * 256;
    const float* uS = (const float*)(p.ws + WS_SMP + SM_UU) + s * 1024; const float* gS = (const float*)(p.ws + WS_SMP + SM_GG) + s * 1024;
    bf16_t* mix = (bf16_t*)(p.ws + WS_SMP + SM_MIX) + s * 2048;
    const float* ck = p.ck + ((size_t)l * NS + s) * WIN * KVW; const float* cv = p.cv + ((size_t)l * NS + s) * WIN * KVW;
    LAS float* red = (LAS float*)lds;
    LAS float* ql = (LAS float*)(lds + 128);
    LAS float* pl = (LAS float*)(lds + 128 + 512);
    LAS float* po = (LAS float*)(lds + 128 + 512 + 1056);
    const int kvh = hp >> 1, hh = tid >> 8, j = tid & 255, head = 2 * hp + hh;
    const float g0 = gS[tid], g1 = gS[tid + 512];
    if (tid < 128) ql[tid] = qS[2 * hp * 64 + tid];
    f32x4 kk[16];
    { const float* kr = (j < 128) ? ck + (size_t)j * KVW + kvh * 64 : kS + kvh * 64;
#pragma unroll
      for (int e = 0; e < 16; ++e) kk[e] = (j < 129) ? ((const f32x4*)kr)[e] : (f32x4){0.f, 0.f, 0.f, 0.f}; }
    { float* ko = p.out + O_KWS + ((size_t)l * NS + s) * WIN * KVW; float* vo = p.out + O_VWS + ((size_t)l * NS + s) * WIN * KVW;
#pragma unroll
      for (int q = 0; q < 2; ++q) { const int i = hp * 1024 + tid + 512 * q, jj = i >> 6, c4 = i & 63;
          const f32x4 kv = (jj < 127) ? ((const f32x4*)ck)[(jj + 1) * 64 + c4] : ((const f32x4*)kS)[c4];
          const f32x4 vv = (jj < 127) ? ((const f32x4*)cv)[(jj + 1) * 64 + c4] : ((const f32x4*)vS)[c4];
          ((f32x4*)ko)[i] = kv; ((f32x4*)vo)[i] = vv; } }
    float ss = wave_sum(g0 * g0 + g1 * g1);
    if (lane == 0) red[wave] = ss;
    __syncthreads();
    if (tid < 128) { float tot = 0.f;
#pragma unroll
        for (int w = 0; w < 8; ++w) tot += red[w];
        const float rstd = rsqrtf(tot * (1.0f / GMW) + EPS); const int c = 128 * hp + tid;
        const float gvn = gS[c] * rstd * p.gmgain[l * GMW + c];
        p.out[O_GMS + ((size_t)l * NS + s) * GMW + c] = gvn;
        const float sv = p.gmws[((size_t)l * 8 + hp) * 128 * 128] * gvn + p.gmbs[(l * 8 + hp) * 128];
        mix[1024 + c] = (bf16_t)f2bf(uS[c] * sv); }
    float sc = -1e30f;
    if (j < 129) { float d = 0.f;
#pragma unroll
        for (int e = 0; e < 16; ++e) { const LAS float* qq = ql + hh * 64 + 4 * e; d += kk[e].x * qq[0] + kk[e].y * qq[1] + kk[e].z * qq[2] + kk[e].w * qq[3]; }
        sc = d * 0.125f; }
    float mx = sc;
#pragma unroll
    for (int o = 1; o < 64; o <<= 1) mx = fmaxf(mx, __shfl_xor(mx, o));
    if (lane == 0) red[8 + wave] = mx;
    __syncthreads();
    mx = fmaxf(fmaxf(red[8 + 4 * hh], red[9 + 4 * hh]), fmaxf(red[10 + 4 * hh], red[11 + 4 * hh]));
    const float sink = p.sinks[l * NH + head], mm = fmaxf(mx, sink);
    const float pe = (j < 129) ? __expf(sc - mm) : 0.f;
    const float sm = wave_sum(pe);
    if (lane == 0) red[16 + wave] = sm;
    __syncthreads();
    const float inv = 1.0f / ((red[16 + 4 * hh] + red[17 + 4 * hh]) + (red[18 + 4 * hh] + red[19 + 4 * hh]) + __expf(sink - mm));
    if (j < 129) pl[hh * 132 + j] = pe * inv;
    __syncthreads();
    { const int part = (tid >> 5) & 7, d2 = (tid & 31) * 2; float o0 = 0.f, o1 = 0.f; f32x2 vv[16];
#pragma unroll
      for (int q = 0; q < 16; ++q) vv[q] = *(const f32x2*)(cv + (size_t)(part * 16 + q) * KVW + kvh * 64 + d2);
#pragma unroll
      for (int q = 0; q < 16; ++q) { const float pj = pl[hh * 132 + part * 16 + q]; o0 += pj * vv[q].x; o1 += pj * vv[q].y; }
      if (part == 0) { const float pj = pl[hh * 132 + 128]; const f32x2 v2 = *(const f32x2*)(vS + kvh * 64 + d2); o0 += pj * v2.x; o1 += pj * v2.y; }
      po[(hh * 8 + part) * 64 + d2] = o0; po[(hh * 8 + part) * 64 + d2 + 1] = o1; }
    __syncthreads();
    if (tid < 128) { const int h2 = tid >> 6, d = tid & 63; float o = 0.f;
#pragma unroll
        for (int q = 0; q < 8; ++q) o += po[(h2 * 8 + q) * 64 + d];
        mix[(2 * hp + h2) * 64 + d] = (bf16_t)f2bf(o); }
    __syncthreads();
}

DI void gmv_fix(const P& p, int l, int tid) {
    float* gmv = p.out + O_GMP + (size_t)l * NB * 128 * GMW; const float* ssq = (const float*)(p.ws + WS_SSQ) + l * M;
    for (int i = blockIdx.x * 512 + tid; i < NB * 128 * GMW / 4; i += G * 512) { const int c4 = i & 255, r = i >> 8, b = r >> 7, tt = r & 127;
        const float rs = rsqrtf(ssq[b * 2048 + 1920 + tt] * (1.0f / GMW) + EPS); const f32x4 g = ((const f32x4*)(p.gmgain + l * GMW))[c4];
        f32x4 v = ((f32x4*)gmv)[i]; v = v * rs * g; ((f32x4*)gmv)[i] = v; }
}

DI void phase_fix(const P& p, int l, int tid) {
    const float* SA = (const float*)(p.ws + WS_GA); const float* SU = SA + (size_t)128 * 4 * DFF; bf16_t* ACT = (bf16_t*)(p.ws + WS_UP);
    const float* cw = p.convw + (size_t)l * 3 * DFF; const float* cb = p.convb + (size_t)l * DFF;
    constexpr int NC4 = DFF / 4;
    for (int task = blockIdx.x * 512 + tid; task < 128 * 2 * NC4; task += G * 512) {
        const int c4 = task % NC4, rr = task / NC4, blk = rr >> 1, r = rr & 1, f = c4 * 4; const bool first = (blk & 31) == 0;
        const f32x4 z = {0.f, 0.f, 0.f, 0.f};
        const float* cur = SA + (size_t)blk * 4 * DFF + f; const float* prv = SA + (size_t)(blk - 1) * 4 * DFF + f;
        const f32x4 a2 = *(const f32x4*)(cur + (2 + r) * DFF);
        const f32x4 a1 = r ? *(const f32x4*)(cur + 2 * DFF) : (first ? z : *(const f32x4*)(prv + DFF));
        const f32x4 a0 = r ? (first ? z : *(const f32x4*)(prv + DFF)) : (first ? z : *(const f32x4*)prv);
        const f32x4 uu = *(const f32x4*)(SU + ((size_t)(blk * 2 + r)) * DFF + f);
        const f32x4 x0 = *(const f32x4*)(cw + f), x1 = *(const f32x4*)(cw + DFF + f), x2 = *(const f32x4*)(cw + 2 * DFF + f), x3 = *(const f32x4*)(cb + f);
        float o[4];
#pragma unroll
        for (int e = 0; e < 4; ++e) o[e] = silu_f(x3[e] + x0[e] * a0[e] + x1[e] * a1[e] + x2[e] * a2[e]) * uu[e];
        u32x2 w; w.x = pk2(o[0], o[1]); w.y = pk2(o[2], o[3]);
        *(u32x2*)(ACT + (size_t)(blk * 64 + r) * LDF + f) = w;
    }
}
template <int NBLK, int K, class Epi>
#ifndef SK_REPEAT
#define SK_REPEAT 1
#endif
DI void skinny(LAS unsigned char* lds, const bf16_t* A, const bf16_t* B0, const bf16_t* B1, int wave, int lane, const Epi& epi) {
  for (int rep = 0; rep < SK_REPEAT; ++rep) {
    asm volatile("" ::: "memory");
    const int r = lane & 31, h = lane >> 5; constexpr int kw = K / 8;
    const bf16_t* ap = A + (size_t)r * K + wave * kw + h * 8;
    const bf16_t* b0 = B0 + (size_t)r * (K + 64) + wave * kw + h * 8;
    const bf16_t* b1 = (NBLK == 2 ? B1 : B0) + (size_t)r * (K + 64) + wave * kw + h * 8;
    f32x16 acc0, acc1;
#pragma unroll
    for (int q = 0; q < 16; ++q) { acc0[q] = 0.f; acc1[q] = 0.f; }
#pragma unroll (K == 2048 ? 16 : 11)
    for (int k = 0; k < kw; k += 16) { const bf16x8 a = *(const bf16x8*)(ap + k);
        acc0 = MFMA32(*(const bf16x8*)(b0 + k), a, acc0);
        if (NBLK == 2) acc1 = MFMA32(*(const bf16x8*)(b1 + k), a, acc1); }
    LAS float* red = (LAS float*)lds;
#pragma unroll
    for (int q = 0; q < 16; ++q) { red[((wave * 2 + 0) * 16 + q) * 64 + lane] = acc0[q]; if (NBLK == 2) red[((wave * 2 + 1) * 16 + q) * 64 + lane] = acc1[q]; }
    __syncthreads();
    if (wave == 0) {
#pragma unroll
        for (int q = 0; q < 16; ++q) { float s0 = 0.f, s1 = 0.f;
#pragma unroll
            for (int w = 0; w < 8; ++w) { s0 += red[((w * 2 + 0) * 16 + q) * 64 + lane]; if (NBLK == 2) s1 += red[((w * 2 + 1) * 16 + q) * 64 + lane]; }
            acc0[q] = s0; acc1[q] = s1; }
        if (rep == SK_REPEAT - 1) epi(acc0, acc1, lane);
    }
    __syncthreads();
  }
}
struct SkIn {
    int item; float *qS, *kS, *vS, *uS, *gS; const float* ropeS;
    DI void operator()(const f32x16& acc, const f32x16&, int lane) const {
        const int s = lane & 31, h = lane >> 5, p0 = item * 32, pn = p0 >> 8, bj = (p0 >> 7) & 1, wc = (p0 >> 5) & 3;
        if (pn <= 4) {
#pragma unroll
            for (int q = 0; q < 8; ++q) { const int fq = 2 * ((q >> 2) & 1) + h, e = q & 3, dh = 16 * (wc & 1) + 4 * fq + e;
                const float cs = ropeS[dh], sn = ropeS[32 + dh], x1 = acc[q], x2 = acc[q + 8], o1 = x1 * cs - x2 * sn, o2 = x2 * cs + x1 * sn;
                const int hc = 128 * bj + 64 * (wc >> 1) + dh;
                if (pn < 4) { qS[s * 1024 + pn * 256 + hc] = o1; qS[s * 1024 + pn * 256 + hc + 32] = o2; } else { kS[s * 256 + hc] = o1; kS[s * 256 + hc + 32] = o2; } }
        } else if (pn < 10) {
#pragma unroll
            for (int q = 0; q < 16; ++q) { const int n = q >> 3, fq = 2 * ((q >> 2) & 1) + h, e = q & 3, L = p0 + 8 * fq + 4 * n + e;
                if (pn == 5) vS[s * 256 + L - 1280] = acc[q]; else uS[s * 1024 + L - 1536] = gelu_tanh(acc[q]); }
        } else {
#pragma unroll
            for (int q = 0; q < 16; ++q) { const int L = p0 + (q & 3) + 8 * (q >> 2) + 4 * h; gS[s * 1024 + L - 2560] = gelu_tanh(acc[q]); }
        }
    }
};
struct SkRes {
    int item; const float* base; float* out; const float* gate;
    DI void operator()(const f32x16& acc, const f32x16&, int lane) const {
        const int s = lane & 31, h = lane >> 5;
#pragma unroll
        for (int q = 0; q < 16; ++q) { const int n = q >> 3, fq = 2 * ((q >> 2) & 1) + h, e = q & 3, col = item * 32 + 8 * fq + 4 * n + e;
            out[s * D + col] = base[s * D + col] + gate[(size_t)(NB + s) * 6 * D + col] * acc[q]; }
    }
};
struct SkGU {
    int item, l; const float *sconv, *cw, *cb; bf16_t* act; float* cvs;
    DI void operator()(const f32x16& ga, const f32x16& up, int lane) const {
        const int s = lane & 31, h = lane >> 5, pn = item >> 2, wc = item & 3;
#pragma unroll
        for (int q = 0; q < 16; ++q) { const int n = q >> 3, fq = 2 * ((q >> 2) & 1) + h, e = q & 3, f = 128 * pn + 32 * wc + 8 * fq + 4 * n + e;
            const float p0 = sconv[((size_t)(l * NS + s) * 2 + 0) * DFF + f], p1 = sconv[((size_t)(l * NS + s) * 2 + 1) * DFF + f], a = ga[q];
            const float cv = cb[l * DFF + f] + cw[((size_t)l * 3 + 0) * DFF + f] * p0 + cw[((size_t)l * 3 + 1) * DFF + f] * p1 + cw[((size_t)l * 3 + 2) * DFF + f] * a;
            act[s * DFF + f] = (bf16_t)f2bf(silu_f(cv) * up[q]);
            cvs[((size_t)(l * NS + s) * 2 + 0) * DFF + f] = p1; cvs[((size_t)(l * NS + s) * 2 + 1) * DFF + f] = a; }
    }
};

#ifndef MULTI
#define MULTI 0
#endif
constexpr int NPHASE = 18;
__global__ void __launch_bounds__(512, 2) fwd(Args a) {
    extern __shared__ __attribute__((aligned(16))) unsigned char lds_raw[];
    LAS unsigned char* lds = (LAS unsigned char*)lds_raw;
    cg::grid_group grid = cg::this_grid();
    const int wave0 = __builtin_amdgcn_readfirstlane(threadIdx.x >> 6);
    P p;
    p.xp = a.in[0]; p.xs = a.in[1]; p.ck = a.in[2]; p.cv = a.in[3]; p.sconv = a.in[4]; p.cp = a.in[5]; p.cs = a.in[6]; p.wada = a.in[7]; p.bada = a.in[8];
    p.g1 = a.in[9]; p.g2 = a.in[10]; p.win = a.in[11]; p.gmgain = a.in[12]; p.gmws = a.in[13]; p.gmbs = a.in[14]; p.sinks = a.in[15]; p.wout = a.in[16];
    p.wgate = a.in[17]; p.wup = a.in[18]; p.convw = a.in[19]; p.convb = a.in[20]; p.wdown = a.in[21]; p.gfinal = a.in[22]; p.out = a.out; p.ws = a.ws;
    const int lo = a.ph_lo, hi = a.ph_hi;
    volatile LAS unsigned* xst = (volatile LAS unsigned*)(lds + 147456);
    if (threadIdx.x < 2) xst[threadIdx.x] = 0u;
    __syncthreads();
    const XcdBarrier xbar = xcd_barrier_post((unsigned*)(a.ws + WS_BAR), xst);
#define IN(k) (lo <= (k) && (k) < hi)
#define FRESH() int wv_f = wave0; asm volatile("" : "+s"(wv_f)); int tid_f = wv_f * 64 + (int)__builtin_amdgcn_mbcnt_hi(~0u, __builtin_amdgcn_mbcnt_lo(~0u, 0u)); asm volatile("" : "+v"(tid_f)); const int tid = tid_f, lane = tid & 63, wave = __builtin_amdgcn_readfirstlane(tid >> 6); (void)lane; (void)wave
#ifndef PROBE_MASK
#define PROBE_MASK 0
#endif
#ifndef PROBE_CLK
#define PROBE_CLK 0
#endif
#ifndef PROBE_MUL
#define PROBE_MUL 2
#endif
    unsigned long long pr_acc = 0, pr_t0 = 0, pr_c0 = 0, pr_cacc = 0; (void)pr_c0; (void)pr_cacc;
#define PR_BEGIN(k) do { if (PROBE_MASK & (1u << (k))) { pr_t0 = __builtin_amdgcn_s_memrealtime(); pr_c0 = __builtin_readcyclecounter(); } } while (0)
#define SEAM(k) do { if (IN(k) && IN((k) + 1)) { if (hi > 1000) grid.sync(); else xcd_barrier(xbar); } if (PROBE_MASK & (1u << (k))) { pr_acc += __builtin_amdgcn_s_memrealtime() - pr_t0; pr_cacc += __builtin_readcyclecounter() - pr_c0; } } while (0)
    unsigned char* ws = a.ws;
    bf16_t* XN = (bf16_t*)(ws + WS_XN); bf16_t* XR = (bf16_t*)(ws + WS_XR); float* XS = (float*)(ws + WS_SMP + SM_XS);
    bf16_t* HS = (bf16_t*)(ws + WS_SMP + SM_HS); bf16_t* MIXS = (bf16_t*)(ws + WS_SMP + SM_MIX); bf16_t* ACTS = (bf16_t*)(ws + WS_SMP + SM_ACT);
    const float* MOD = (const float*)(ws + WS_MOD);

    PR_BEGIN(0);
    if (IN(0)) { FRESH(); phaseA(p, lds, tid, wave, lane); }
    SEAM(0);
    for (int l = 0; l < DEPTH; ++l) {
        const int pb = 1 + 8 * l;
        const bf16_t* Win = (const bf16_t*)(ws + WS_WIN + l * SZ_WIN); const bf16_t* Wout = (const bf16_t*)(ws + WS_WOUT + l * SZ_WOUT);
        const bf16_t* Wgu = (const bf16_t*)(ws + WS_WGU + l * SZ_WGU); const bf16_t* Wdn = (const bf16_t*)(ws + WS_WDN + l * SZ_WDN);
        const float* modl = MOD + (size_t)l * NMODROWS * 6 * D;
        PR_BEGIN(pb + 0);
        if (IN(pb + 0)) { FRESH(); phase_norm(p, l, 0, wave, lane); }
        SEAM(pb + 0);
        PR_BEGIN(pb + 1);
        if (IN(pb + 1)) {
            pg8::Gemm g{XN, Win, M, INC, D}; pg8::StaticOrder S; S.init(M, INC, gridDim.x, blockIdx.x);
            EpiIn E{(bf16_t*)(ws + WS_Q), (bf16_t*)(ws + WS_K), (bf16_t*)(ws + WS_V), (bf16_t*)(ws + WS_U), (bf16_t*)(ws + WS_GT), (float*)(ws + WS_SSQ) + l * M, (const float*)(ws + WS_ROPE),
                    p.out + O_KWP + (size_t)l * NB * WIN * KVW, p.out + O_VWP + (size_t)l * NB * WIN * KVW, p.out + O_GMP + (size_t)l * NB * 128 * GMW, lds + 131072};
            pg8::gemm_phase<EpiIn, pg8::StaticOrder>(lds, g, S, E, nullptr, wave0); FRESH();
            for (int item = (int)gridDim.x - 1 - (int)blockIdx.x; item < INC / 32; item += gridDim.x) {
                SkIn e{item, (float*)(ws + WS_SMP + SM_Q), (float*)(ws + WS_SMP + SM_KK), (float*)(ws + WS_SMP + SM_VV), (float*)(ws + WS_SMP + SM_UU), (float*)(ws + WS_SMP + SM_GG), (const float*)(ws + WS_ROPE) + 2 * 2048 * 32};
                skinny<1, D>(lds, HS, Win + (size_t)item * 32 * LDD, nullptr, wave, lane, e); }
        }
        SEAM(pb + 1);
        PR_BEGIN(pb + 2);
        if (IN(pb + 2)) { FRESH();
#ifndef REP_ATT
#define REP_ATT 1
#endif
#ifndef REP_GM
#define REP_GM 1
#endif
            for (int rep = 0; rep < REP_ATT; ++rep) { asm volatile("" ::: "memory"); for (int u = blockIdx.x; u < NB * 16 * NKV; u += gridDim.x) attn_unit(p, l, u, lds, tid, wave, lane); }
            for (int rep = 0; rep < REP_GM; ++rep) { asm volatile("" ::: "memory"); for (int u = blockIdx.x; u < NB * 16 * 8; u += gridDim.x) gmlp_unit(p, l, u, wave, lane); }
            for (int it = (int)gridDim.x - 1 - (int)blockIdx.x; it < NS * 8; it += gridDim.x) sample_part(p, l, it >> 3, it & 7, lds, tid, wave, lane);
            gmv_fix(p, l, tid);
        }
        SEAM(pb + 2);
        PR_BEGIN(pb + 3);
        if (IN(pb + 3)) {
            pg8::Gemm g{(const bf16_t*)(ws + WS_MIX), Wout, M, D, D}; pg8::StaticOrder S; S.init(M, D, gridDim.x, blockIdx.x);
            if (l == 0) { EpiRes<true> E{p.xp, XR, modl + 2 * D}; pg8::gemm_phase<EpiRes<true>, pg8::StaticOrder>(lds, g, S, E, nullptr, wave0); }
            else { EpiRes<false> E{nullptr, XR, modl + 2 * D}; pg8::gemm_phase<EpiRes<false>, pg8::StaticOrder>(lds, g, S, E, nullptr, wave0); }
            FRESH();
            for (int item = (int)gridDim.x - 1 - (int)blockIdx.x; item < D / 32; item += gridDim.x) {
                SkRes e{item, l == 0 ? p.xs : XS, XS, modl + 2 * D};
                skinny<1, D>(lds, MIXS, Wout + (size_t)item * 32 * LDD, nullptr, wave, lane, e); }
        }
        SEAM(pb + 3);
        PR_BEGIN(pb + 4);
        if (IN(pb + 4)) { FRESH(); phase_norm(p, l, 1, wave, lane); }
        SEAM(pb + 4);
        PR_BEGIN(pb + 5);
        if (IN(pb + 5)) {
            pg8::Gemm g{XN, Wgu, M, 2 * DFF, D}; pg8::StaticOrder S; S.init(M, 2 * DFF, gridDim.x, blockIdx.x);
            EpiGU E{(bf16_t*)(ws + WS_UP), (float*)(ws + WS_GA), (float*)(ws + WS_GA) + (size_t)128 * 4 * DFF, p.out + O_CVP + (size_t)l * NB * 2 * DFF, p.convw + (size_t)l * 3 * DFF, p.convb + (size_t)l * DFF};
            pg8::gemm_phase<EpiGU, pg8::StaticOrder>(lds, g, S, E, nullptr, wave0);
#if defined(PROBE_GU_EXTRA)
            if (l == 1) { for (int rep = 0; rep < PROBE_GU_EXTRA; ++rep) { grid.sync(); EpiNull EN{(float*)(ws + WS_SSQ)}; pg8::gemm_phase<EpiNull, pg8::StaticOrder>(lds, g, S, EN, nullptr, wave0); } }
#endif
            FRESH();
            for (int item = (int)gridDim.x - 1 - (int)blockIdx.x; item < DFF / 32; item += gridDim.x) {
                SkGU e{item, l, p.sconv, p.convw, p.convb, ACTS, p.out + O_CVS};
                const bf16_t* b0 = Wgu + (size_t)(256 * (item >> 2) + 32 * (item & 3)) * LDD;
                skinny<2, D>(lds, HS, b0, b0 + (size_t)128 * LDD, wave, lane, e); }
        }
        SEAM(pb + 5);
        PR_BEGIN(pb + 6);
        if (IN(pb + 6)) { FRESH(); phase_fix(p, l, tid); }
        SEAM(pb + 6);
        PR_BEGIN(pb + 7);
        if (IN(pb + 7)) {
            pg8::Gemm g{(const bf16_t*)(ws + WS_UP), Wdn, M, D, DFF}; pg8::StaticOrder S; S.init(M, D, gridDim.x, blockIdx.x);
            EpiRes<false> E{nullptr, XR, modl + 5 * D};
            pg8::gemm_phase<EpiRes<false>, pg8::StaticOrder>(lds, g, S, E, nullptr, wave0); FRESH();
            for (int item = (int)gridDim.x - 1 - (int)blockIdx.x; item < D / 32; item += gridDim.x) {
                SkRes e{item, XS, XS, modl + 5 * D};
                skinny<1, DFF>(lds, ACTS, Wdn + (size_t)item * 32 * LDF, nullptr, wave, lane, e); }
        }
        SEAM(pb + 7);
    }
    if (IN(17)) { FRESH(); phase_norm(p, 0, 2, wave, lane); }
    if (PROBE_MASK) { grid.sync(); if (blockIdx.x == 0) { const unsigned long long t0 = __builtin_amdgcn_s_memrealtime(); const unsigned long long spin = PROBE_CLK ? (pr_cacc * 1000ull / (pr_acc ? pr_acc : 1ull)) : (unsigned long long)PROBE_MUL * pr_acc;
        while (__builtin_amdgcn_s_memrealtime() - t0 < spin) __builtin_amdgcn_s_sleep(8); } }
}

extern "C" void kernel_launch(void* const* d_in, const int* in_sizes, int n_in, void* d_out, int out_size, void* d_ws, size_t ws_size, hipStream_t stream) {
    static int grid = 0;
    if (grid == 0) {
        if (n_in != 23 || (size_t)out_size != O_END || ws_size < WS_END) { fprintf(stderr, "kernel_launch: unexpected shapes: n_in %d out %d (want %zu) ws %zu (want %zu)\n", n_in, out_size, (size_t)O_END, ws_size, (size_t)WS_END); grid = -1; return; }
        int dev = 0, cus = 0, per = 0;
        (void)hipGetDevice(&dev); (void)hipDeviceGetAttribute(&cus, hipDeviceAttributeMultiprocessorCount, dev);
        if (hipFuncSetAttribute((const void*)fwd, hipFuncAttributeMaxDynamicSharedMemorySize, LDS_BYTES) != hipSuccess) { fprintf(stderr, "kernel_launch: hipFuncSetAttribute failed\n"); grid = -1; return; }
        (void)hipOccupancyMaxActiveBlocksPerMultiprocessor(&per, (const void*)fwd, 512, LDS_BYTES);
        if (per < 1) { fprintf(stderr, "kernel_launch: occupancy query says %d blocks per CU\n", per); per = 1; }
        grid = cus * 1;
        fprintf(stderr, "kernel_launch: grid %d (cus %d, per-cu %d)\n", grid, cus, per);
    }
    if (grid < 0) return;
    Args a{};
    for (int i = 0; i < 23; ++i) a.in[i] = (const float*)d_in[i];
    a.out = (float*)d_out; a.ws = (unsigned char*)d_ws;
    if (hipMemsetAsync((char*)d_ws + WS_BAR, 0, 65536, stream) != hipSuccess) { fprintf(stderr, "kernel_launch: memset of barrier words failed\n"); return; }
#if MULTI
    for (int k = 0; k < NPHASE; ++k) { a.ph_lo = k; a.ph_hi = k + 1; hipLaunchKernelGGL(fwd, dim3(grid), dim3(512), LDS_BYTES, stream, a); }
#else
    a.ph_lo = 0; a.ph_hi = NPHASE;
    void* args[] = {&a};
    hipError_t e = hipLaunchCooperativeKernel((void*)fwd, dim3(grid), dim3(512), args, LDS_BYTES, stream);
    if (e != hipSuccess) fprintf(stderr, "kernel_launch: cooperative launch failed: %s (grid %d)\n", hipGetErrorString(e), grid);
#endif
}
```

```cpp
#include <hip/hip_runtime.h>
#include <hip/hip_cooperative_groups.h>
#include <cstdio>
namespace cg = cooperative_groups;
namespace pg8 {
#define PG8_LAS __attribute__((address_space(3)))
typedef unsigned short bf16_t;
typedef short bf16x8 __attribute__((ext_vector_type(8)));
typedef float f32x4 __attribute__((ext_vector_type(4)));
typedef unsigned u32x4 __attribute__((ext_vector_type(4)));
constexpr int BM = 256, BK = 64, HALF = 128, HTB = HALF * BK * 2  , STAGE_BYTES = 8 * HTB, NXCD = 8, WGM = 8;

__host__ __device__ __forceinline__ int lds_byte(int r, int c) { const int st = (r >> 4) * 2 + (c >> 5), rr = r & 15, cc = c & 31, ob = rr * 64 + cc * 2; return st * 1024 + (ob ^ (((ob >> 9) & 1) << 5)); }
__host__ __device__ __forceinline__ void stage_rc(int b, int& R, int& C) { const int st = b / 1024, sb = b % 1024, swz = sb ^ (((sb >> 9) & 1) << 5); R = (st >> 1) * 16 + swz / 64; C = (st & 1) * 32 + (swz % 64) / 2; }
__host__ __device__ __forceinline__ int perm32(int rho) { const int n = rho >> 4, i = rho & 15; return 8 * (i >> 2) + 4 * n + (i & 3); }

struct Unit { int pm, pn; };
struct Gemm { const bf16_t* A; const bf16_t* Bt; int M, N, K; };

struct StaticOrder {
    int nM, nN, nwg, G, c;
    __host__ __device__ void init(int M, int N, int G_, int c_) { nM = M / BM; nN = N / BM; nwg = nM * nN; G = G_; c = c_; }
    __host__ __device__ bool next(int i, Unit& u) const {
        const long L = (long)i * G + c; if (L >= nwg) return false;
        int wgid = (int)L; { const int q = nwg / NXCD, r = nwg % NXCD, xcd = wgid % NXCD, off = wgid / NXCD; wgid = (xcd < r ? xcd * (q + 1) : r * (q + 1) + (xcd - r) * q) + off; }
        const int nig = WGM * nN, gid = wgid / nig, fm = gid * WGM, gsz = (nM - fm) < WGM ? (nM - fm) : WGM;
        u.pm = fm + ((wgid % nig) % gsz); u.pn = (wgid % nig) / gsz; return true;
    }
    __device__ __forceinline__ void a_ready(const Unit&) const {}
    __device__ __forceinline__ void done(const Unit&) const {}
};
__device__ __forceinline__ unsigned cvt_pk_bf16(float lo, float hi) { unsigned r; asm volatile("v_cvt_pk_bf16_f32 %0, %1, %2" : "=v"(r) : "v"(lo), "v"(hi)); return r; }
template <class Epi, class Sched, bool STAMP = false>
__device__ __forceinline__ void gemm_phase(PG8_LAS unsigned char* lds, const Gemm g, const Sched& S, const Epi& E, unsigned long long* stamps, int wave_in) {
    int wv_l = wave_in; asm volatile("" : "+s"(wv_l)); int tid_l = wv_l * 64 + (int)__builtin_amdgcn_mbcnt_hi(~0u, __builtin_amdgcn_mbcnt_lo(~0u, 0u)); asm volatile("" : "+v"(tid_l)); const int tid = tid_l, wid = __builtin_amdgcn_readfirstlane(tid >> 6), lane = tid & 63, wr = wid >> 2, wc = wid & 3, fr = lane & 15, fq = lane >> 4;
    const int K = g.K, nt = K / BK, LD = K + 64;
    int ts_lo = 0, ts_hi = 0, nts = 0; const unsigned long long rt_entry = STAMP ? (unsigned long long)wall_clock64() : 0ull;
#define PG8_STAMP() do { if (STAMP && wid == 0 && nts < 64) { const unsigned long long _c = (unsigned long long)clock64(); \
        ts_lo = (lane == nts) ? (int)(unsigned)_c : ts_lo; ts_hi = (lane == nts) ? (int)(unsigned)(_c >> 32) : ts_hi; ++nts; } } while (0)
    PG8_STAMP();
    unsigned voffA[2], voffB[2];
#pragma unroll
    for (int i = 0; i < 2; ++i) { int R, C; stage_rc(tid * 16 + i * 8192, R, C); const int Rb = Epi::PERM ? ((R & ~31) + perm32(R & 31)) : R;
        voffA[i] = (unsigned)(R * LD + C) * 2u; voffB[i] = (unsigned)(Rb * LD + C) * 2u; }
    const size_t kstep = (size_t)(BK * 2);
    const size_t hstep = (size_t)HALF * LD * 2;
    const size_t tstep = 2 * hstep;
    const unsigned ldsw = (unsigned)wid * 1024u;
    const int aoff = lds_byte(wr * 64 + fr, fq * 8), boff = lds_byte(wc * 32 + fr, fq * 8);
#define PG8_SA(b, h) (((b) * 2 + (h)) * HTB)
#define PG8_SB(b, h) ((4 + (b) * 2 + (h)) * HTB)
#define PG8_STAGE(bufoff, gbase, voff) do { _Pragma("unroll") for (int _i = 0; _i < 2; ++_i) \
        __builtin_amdgcn_global_load_lds((const unsigned*)((const char*)(gbase) + (voff)[_i]), (PG8_LAS unsigned*)(lds + (bufoff) + ldsw + _i * 8192), 16, 0, 0); } while (0)
#define PG8_LDA(dst, b, h) do { _Pragma("unroll") for (int m = 0; m < 4; ++m) _Pragma("unroll") for (int k = 0; k < 2; ++k) dst[m][k] = *(const PG8_LAS bf16x8*)(lds + PG8_SA(b, h) + aoff + m * 2048 + k * 1024); } while (0)
#define PG8_LDB(dst, b, h) do { _Pragma("unroll") for (int n = 0; n < 2; ++n) _Pragma("unroll") for (int k = 0; k < 2; ++k) dst[n][k] = *(const PG8_LAS bf16x8*)(lds + PG8_SB(b, h) + boff + n * 2048 + k * 1024); } while (0)
#define PG8_MMA(ai, bj, At, Bt) do { __builtin_amdgcn_s_setprio(1); _Pragma("unroll") for (int m = 0; m < 4; ++m) _Pragma("unroll") for (int n = 0; n < 2; ++n) _Pragma("unroll") for (int k = 0; k < 2; ++k) \
        acc[ai][bj][m][n] = __builtin_amdgcn_mfma_f32_16x16x32_bf16(Bt[n][k], At[m][k], acc[ai][bj][m][n], 0, 0, 0); __builtin_amdgcn_s_setprio(0); } while (0)
#define PG8_WAIT_V(n) asm volatile("s_waitcnt vmcnt(" #n ")" ::: "memory")
#define PG8_WAIT_L(n) asm volatile("s_waitcnt lgkmcnt(" #n ")" ::: "memory")
#define PG8_BAR __builtin_amdgcn_s_barrier()
#define PG8_SCHED __builtin_amdgcn_sched_barrier(0)
    Unit cur, nxt; int ui = 0;
    if (!S.next(0, cur)) return;
    f32x4 acc[2][2][4][2];
#pragma unroll
    for (int a = 0; a < 2; ++a)
#pragma unroll
        for (int b = 0; b < 2; ++b)
#pragma unroll
            for (int m = 0; m < 4; ++m)
#pragma unroll
                for (int n = 0; n < 2; ++n) acc[a][b][m][n] = (f32x4){0.f, 0.f, 0.f, 0.f};
    bf16x8 At[4][2], B0[2][2], B1[2][2];
    const char* cA = (const char*)g.A + (size_t)cur.pm * tstep; const char* cB = (const char*)g.Bt + (size_t)cur.pn * tstep;
    S.a_ready(cur);
    PG8_STAGE(PG8_SB(0, 0), cB, voffB); PG8_STAGE(PG8_SA(0, 0), cA, voffA); PG8_STAGE(PG8_SB(0, 1), cB + hstep, voffB); PG8_STAGE(PG8_SA(0, 1), cA + hstep, voffA);
    if (wr == 1) PG8_BAR;
    PG8_WAIT_V(4); PG8_BAR;
    PG8_STAGE(PG8_SB(1, 0), cB + kstep, voffB); PG8_STAGE(PG8_SA(1, 0), cA + kstep, voffA); PG8_STAGE(PG8_SB(1, 1), cB + hstep + kstep, voffB);
    PG8_WAIT_V(6); PG8_BAR;
    PG8_STAMP();
    for (;;) {
        const bool has_next = S.next(ui + 1, nxt);
        const char* nA = has_next ? (const char*)g.A + (size_t)nxt.pm * tstep : cA; const char* nB = has_next ? (const char*)g.Bt + (size_t)nxt.pn * tstep : cB;
        for (int t = 0; t < nt; t += 2) {
            const bool last = (t == nt - 2);
            const char* a1 = cA + (size_t)(t + 1) * kstep;
            const char* a2 = last ? nA : cA + (size_t)(t + 2) * kstep; const char* b2 = last ? nB : cB + (size_t)(t + 2) * kstep;
            const char* a3 = a2 + kstep; const char* b3 = b2 + kstep;
            if (last && has_next) S.a_ready(nxt);
            PG8_LDB(B0, 0, 0); PG8_SCHED; PG8_LDA(At, 0, 0); PG8_STAGE(PG8_SA(1, 1), a1 + hstep, voffA);
            PG8_WAIT_L(8); PG8_BAR; PG8_WAIT_L(0); PG8_MMA(0, 0, At, B0); PG8_BAR; PG8_SCHED;
            PG8_LDB(B1, 0, 1); PG8_STAGE(PG8_SB(0, 0), b2, voffB);
            PG8_BAR; PG8_WAIT_L(0); PG8_MMA(0, 1, At, B1); PG8_BAR;
            PG8_LDA(At, 0, 1); PG8_STAGE(PG8_SA(0, 0), a2, voffA);
            PG8_BAR; PG8_WAIT_L(0); PG8_MMA(1, 0, At, B0); PG8_BAR; PG8_SCHED;
            PG8_STAGE(PG8_SB(0, 1), b2 + hstep, voffB);
            PG8_WAIT_V(6); PG8_BAR; PG8_MMA(1, 1, At, B1); PG8_BAR;
            PG8_LDB(B0, 1, 0); PG8_SCHED; PG8_LDA(At, 1, 0); PG8_STAGE(PG8_SA(0, 1), a2 + hstep, voffA);
            PG8_WAIT_L(8); PG8_BAR; PG8_WAIT_L(0); PG8_MMA(0, 0, At, B0); PG8_BAR; PG8_SCHED;
            PG8_LDB(B1, 1, 1); PG8_STAGE(PG8_SB(1, 0), b3, voffB);
            PG8_BAR; PG8_WAIT_L(0); PG8_MMA(0, 1, At, B1); PG8_BAR;
            PG8_LDA(At, 1, 1); PG8_STAGE(PG8_SA(1, 0), a3, voffA);
            PG8_BAR; PG8_WAIT_L(0); PG8_MMA(1, 0, At, B0); PG8_BAR; PG8_SCHED;
            PG8_STAGE(PG8_SB(1, 1), b3 + hstep, voffB);
            PG8_WAIT_V(6); PG8_BAR; PG8_MMA(1, 1, At, B1); PG8_BAR;
        }
        PG8_STAMP();
        if constexpr (!Epi::AFTER_DRAIN) { E(acc, cur, wr, wc, fr, fq); S.done(cur); }
        PG8_STAMP();
        if (!has_next) break;
#pragma unroll
        for (int a = 0; a < 2; ++a)
#pragma unroll
            for (int b = 0; b < 2; ++b)
#pragma unroll
                for (int m = 0; m < 4; ++m)
#pragma unroll
                    for (int n = 0; n < 2; ++n) acc[a][b][m][n] = (f32x4){0.f, 0.f, 0.f, 0.f};
        cur = nxt; cA = nA; cB = nB; ++ui;
    }
    PG8_WAIT_V(0);
    if (wr == 0) PG8_BAR;
    PG8_BAR;
    if constexpr (Epi::AFTER_DRAIN) { E.fused(acc, cur, wr, wc, fr, fq, lds, wid, lane); S.done(cur); }
    PG8_STAMP();
    if (STAMP && wid == 0) { stamps[lane] = lane < nts ? (((unsigned long long)(unsigned)ts_hi << 32) | (unsigned)ts_lo) : 0ull;
        if (lane == 62) stamps[62] = rt_entry; if (lane == 63) stamps[63] = (unsigned long long)wall_clock64(); }
#undef PG8_STAMP
#undef PG8_SA
#undef PG8_SB
#undef PG8_STAGE
#undef PG8_LDA
#undef PG8_LDB
#undef PG8_MMA
#undef PG8_WAIT_V
#undef PG8_WAIT_L
#undef PG8_BAR
#undef PG8_SCHED
}
}
using pg8::bf16_t; using pg8::bf16x8; using pg8::f32x4; using pg8::u32x4;
typedef float f32x16 __attribute__((ext_vector_type(16)));
typedef float f32x2 __attribute__((ext_vector_type(2)));
typedef unsigned u32x2 __attribute__((ext_vector_type(2)));
#define LAS __attribute__((address_space(3)))
#define DI __device__ __forceinline__

constexpr int D = 2048, SEQ = 2048, NB = 4, M = NB * SEQ, NS = 32, DEPTH = 2;
constexpr int INC = 3584, DFF = 5632, WIN = 128, NH = 16, NKV = 4, HD = 64, GMW = 1024, KVW = 256, AW = 1024;
constexpr int PAST = 16384;
constexpr float EPS = 1e-6f;
constexpr int NMODROWS = NB + NS;
#define G ((int)gridDim.x)

constexpr size_t O_YP = 0;
constexpr size_t O_YS = O_YP + (size_t)M * D;
constexpr size_t O_KWP = O_YS + (size_t)NS * D;
constexpr size_t O_VWP = O_KWP + (size_t)DEPTH * NB * WIN * KVW;
constexpr size_t O_GMP = O_VWP + (size_t)DEPTH * NB * WIN * KVW;
constexpr size_t O_CVP = O_GMP + (size_t)DEPTH * NB * 128 * GMW;
constexpr size_t O_KWS = O_CVP + (size_t)DEPTH * NB * 2 * DFF;
constexpr size_t O_VWS = O_KWS + (size_t)DEPTH * NS * WIN * KVW;
constexpr size_t O_GMS = O_VWS + (size_t)DEPTH * NS * WIN * KVW;
constexpr size_t O_CVS = O_GMS + (size_t)DEPTH * NS * GMW;
constexpr size_t O_END = O_CVS + (size_t)DEPTH * NS * 2 * DFF;

constexpr size_t MiB = 1u << 20;
constexpr int LDD = D + 64, LDF = DFF + 64;
constexpr size_t SZ_WIN = 15 * MiB, SZ_WOUT = 9 * MiB, SZ_WGU = 46 * MiB, SZ_WDN = 23 * MiB;
constexpr size_t WS_WIN = 0;
constexpr size_t WS_WOUT = WS_WIN + 2 * SZ_WIN;
constexpr size_t WS_WGU = WS_WOUT + 2 * SZ_WOUT;
constexpr size_t WS_WDN = WS_WGU + 2 * SZ_WGU;
constexpr size_t WS_XN = WS_WDN + 2 * SZ_WDN;
constexpr size_t WS_Q = WS_XN + 34 * MiB;
constexpr size_t WS_K = WS_Q + 16 * MiB;
constexpr size_t WS_V = WS_K + 4 * MiB;
constexpr size_t WS_U = WS_V + 4 * MiB;
constexpr size_t WS_GT = WS_U + 16 * MiB;
constexpr size_t WS_MIX = WS_GT + 16 * MiB;
constexpr size_t WS_XR = WS_MIX + 34 * MiB;
constexpr size_t WS_GA = WS_XR + 64 * MiB;
constexpr size_t WS_UP = WS_GA + 88 * MiB;
constexpr size_t WS_MOD = WS_UP + 90 * MiB;
constexpr size_t WS_ROPE = WS_MOD + 4 * MiB;
constexpr size_t WS_SSQ = WS_ROPE + 1 * MiB;
constexpr size_t WS_SMP = WS_SSQ + 1 * MiB;
constexpr size_t WS_BAR = WS_SMP + 4 * MiB;
constexpr size_t WS_END = WS_BAR + 1 * MiB;
constexpr size_t SM_XS = 0;
constexpr size_t SM_HS = SM_XS + 32 * 2048 * 4;
constexpr size_t SM_Q = SM_HS + 32 * 2048 * 2;
constexpr size_t SM_KK = SM_Q + 32 * 1024 * 4;
constexpr size_t SM_VV = SM_KK + 32 * 256 * 4;
constexpr size_t SM_UU = SM_VV + 32 * 256 * 4;
constexpr size_t SM_GG = SM_UU + 32 * 1024 * 4;
constexpr size_t SM_MIX = SM_GG + 32 * 1024 * 4;
constexpr size_t SM_ACT = SM_MIX + 32 * 2048 * 2;
constexpr size_t SM_END = SM_ACT + 32 * 5632 * 2;
static_assert(SM_END <= 4 * MiB, "sample buffers");

constexpr int LDS_BYTES = 148480;

struct Args {
    const float* in[23];
    float* out;
    unsigned char* ws;
    int ph_lo, ph_hi;
};

DI unsigned f2bf(float f) { unsigned u = __builtin_bit_cast(unsigned, f); return (u + 0x7fffu + ((u >> 16) & 1u)) >> 16; }
DI unsigned pk2(float lo, float hi) { return pg8::cvt_pk_bf16(lo, hi); }
DI float bf2f(unsigned short b) { return __builtin_bit_cast(float, ((unsigned)b) << 16); }
DI float bflo(unsigned w) { return __builtin_bit_cast(float, w << 16); }
DI float bfhi(unsigned w) { return __builtin_bit_cast(float, w & 0xffff0000u); }
DI float wave_sum(float v) {
#pragma unroll
    for (int o = 1; o < 64; o <<= 1) v += __shfl_xor(v, o);
    return v;
}
DI float gelu_tanh(float x) {
    const float u = 0.7978845608028654f * (x + 0.044715f * x * x * x);
    return x * __builtin_amdgcn_rcpf(1.0f + __expf(-2.0f * u));
}
DI float silu_f(float x) { return x * __builtin_amdgcn_rcpf(1.0f + __expf(-x)); }

DI int pair8_phys(int r32) { const int fq = r32 >> 3, n = (r32 >> 2) & 1, e = r32 & 3; return 16 * n + 4 * fq + e; }
DI int win_phys(int L) {
    if (L < 1280) { const int h2 = L >> 7, r = L & 127, hd = r >> 6, d = r & 63, n = d >> 5, d5 = d & 31, wcl = d5 >> 4, fq = (d5 >> 2) & 3, e = d5 & 3;
        return 128 * h2 + 32 * (2 * hd + wcl) + 16 * n + 4 * fq + e; }
    if (L < 2560) return (L & ~31) + pair8_phys(L & 31);
    return L;
}

struct ConvDesc { const float* W; bf16_t* WT; int K, N, type, item; };
DI int conv_phys(int type, int L) {
    if (type == 0) return win_phys(L);
    if (type == 1) return (L & ~31) + pair8_phys(L & 31);
    return 256 * (L >> 7) + (type == 3 ? 128 : 0) + (L & 96) + pair8_phys(L & 31);
}
DI void conv_load(const ConvDesc& d, int lane, f32x4 (&v)[8]) {
    const int nblk = d.N / 32, kb = d.item / nblk, nb = d.item % nblk, k0 = 64 * kb, n0 = 32 * nb;
#pragma unroll
    for (int i = 0; i < 8; ++i) { const int kk = 8 * i + (lane >> 3); v[i] = *(const f32x4*)(d.W + (size_t)(k0 + kk) * d.N + n0 + 4 * (lane & 7)); }
}
DI void conv_store(const ConvDesc& d, int lane, const f32x4 (&v)[8], LAS float* scr) {
    const int nblk = d.N / 32, kb = d.item / nblk, nb = d.item % nblk, k0 = 64 * kb, n0 = 32 * nb;
#pragma unroll
    for (int i = 0; i < 8; ++i) { const int kk = 8 * i + (lane >> 3); LAS float* s = scr + kk * 33 + 4 * (lane & 7); s[0] = v[i].x; s[1] = v[i].y; s[2] = v[i].z; s[3] = v[i].w; }
    asm volatile("s_waitcnt lgkmcnt(0)" ::: "memory");
    const int c = lane & 7;
#pragma unroll
    for (int j = 0; j < 4; ++j) { const int n = (lane >> 3) + 8 * j; const LAS float* s = scr + (8 * c) * 33 + n;
        u32x4 o; o.x = pk2(s[0 * 33], s[1 * 33]); o.y = pk2(s[2 * 33], s[3 * 33]); o.z = pk2(s[4 * 33], s[5 * 33]); o.w = pk2(s[6 * 33], s[7 * 33]);
        *(u32x4*)(d.WT + (size_t)conv_phys(d.type, n0 + n) * (d.K + 64) + k0 + 8 * c) = o; }
    asm volatile("s_waitcnt lgkmcnt(0)" ::: "memory");
}

struct P {
    const float *xp, *xs, *ck, *cv, *sconv, *cp, *cs, *wada, *bada, *g1, *g2, *win, *gmgain, *gmws, *gmbs, *sinks, *wout, *wgate, *wup, *convw, *convb, *wdown, *gfinal;
    float* out; unsigned char* ws;
};
#define RLX_AGENT __ATOMIC_RELAXED, __HIP_MEMORY_SCOPE_AGENT
#define XB_TMO      128
#define XB_XCNT(j)  (256  + 64 * (j))
#define XB_XSUB(j)  (1280 + 64 * (j))
#define XB_XGEN(j)  (2304 + 64 * (j))
#define XB_TOP      3328
#define XB_TOPGEN   3392
#define XCD_BAR_WORDS 3456
#define XB_SPIN_CAP (1u << 18)

__device__ __forceinline__ unsigned xb_ld(unsigned* p)              { return __hip_atomic_load(p, __ATOMIC_RELAXED, __HIP_MEMORY_SCOPE_AGENT); }
__device__ __forceinline__ unsigned xb_add(unsigned* p, unsigned v) { return __hip_atomic_fetch_add(p, v, __ATOMIC_RELAXED, __HIP_MEMORY_SCOPE_AGENT); }
__device__ __forceinline__ unsigned xb_xcc_id() { return (unsigned)__builtin_amdgcn_s_getreg((3 << 11) | 20) & 0xFu; }
#define XB_SPIN(cond, bar) do { unsigned _sp = 0; while (cond) { __builtin_amdgcn_s_sleep(1); \
    if ((++_sp & 255u) == 0u) { if (xb_ld(&(bar)[XB_TMO])) break; if (_sp > XB_SPIN_CAP) { atomicAdd(&(bar)[XB_TMO], 1u); break; } } } } while (0)

struct XcdBarrier {
    unsigned* bar; unsigned x;
    volatile LAS unsigned* st;
};

__device__ __forceinline__ XcdBarrier xcd_barrier_post(unsigned* bar, volatile LAS unsigned* st) {
    XcdBarrier b; b.bar = bar; b.x = xb_xcc_id(); b.st = st;
    if (threadIdx.x == 0) (void)xb_add(&bar[XB_XCNT(b.x)], 1u);
    return b;
}
__device__ __forceinline__ void xcd_barrier_complete(unsigned* bar, unsigned x, unsigned& nloc, unsigned& nx) {
    const unsigned GG = gridDim.x * gridDim.y * gridDim.z;
    unsigned sum, cnt, mine, sp = 0u;
    for (;;) {
        sum = 0u; cnt = 0u; mine = 0u;
#pragma unroll
        for (unsigned j = 0; j < 16; ++j) { const unsigned c = xb_ld(&bar[XB_XCNT(j)]); sum += c; cnt += (c > 0u) ? 1u : 0u; mine = (j == x) ? c : mine; }
        if (sum == GG) break;
        __builtin_amdgcn_s_sleep(1);
        if ((++sp & 255u) == 0u) { if (xb_ld(&bar[XB_TMO])) break; if (sp > XB_SPIN_CAP) { atomicAdd(&bar[XB_TMO], 1u); break; } }
    }
    nloc = mine > 0u ? mine : 1u; nx = cnt > 0u ? cnt : 1u;
}

__device__ __forceinline__ void xcd_barrier(const XcdBarrier& b) {
    asm volatile("s_waitcnt vmcnt(0)" ::: "memory");
    __syncthreads();
    if (threadIdx.x == 0) {
        unsigned* bar = b.bar;
        __builtin_amdgcn_s_waitcnt(0);
        unsigned nloc = b.st[0], nx = b.st[1];
        if (nloc == 0u) { xcd_barrier_complete(bar, b.x, nloc, nx); b.st[0] = nloc; b.st[1] = nx; }
        const unsigned old = xb_add(&bar[XB_XSUB(b.x)], 1u);
        const unsigned gen = old / nloc;
        if (old + 1u == (gen + 1u) * nloc) {
            __builtin_amdgcn_fence(__ATOMIC_RELEASE, "agent");
            asm volatile("s_waitcnt vmcnt(0)" ::: "memory");
            const unsigned og = xb_add(&bar[XB_TOP], 1u);
            const unsigned tg = og / nx;
            if (og + 1u == (tg + 1u) * nx) xb_add(&bar[XB_TOPGEN], 1u);
            else XB_SPIN(xb_ld(&bar[XB_TOPGEN]) == tg, bar);
            __builtin_amdgcn_fence(__ATOMIC_ACQUIRE, "agent");
            xb_add(&bar[XB_XGEN(b.x)], 1u);
            asm volatile("s_waitcnt vmcnt(0)" ::: "memory");
        } else {
            XB_SPIN(xb_ld(&bar[XB_XGEN(b.x)]) == gen, bar);
            __builtin_amdgcn_fence(__ATOMIC_ACQUIRE, "agent");
            asm volatile("s_waitcnt vmcnt(0)" ::: "memory");
        }
    }
    __syncthreads();
}
DI bf16x8 pack8(const float (&w)[8]) { u32x4 o; o.x = pk2(w[0], w[1]); o.y = pk2(w[2], w[3]); o.z = pk2(w[4], w[5]); o.w = pk2(w[6], w[7]); return __builtin_bit_cast(bf16x8, o); }
DI bf16x8 pack8v(f32x4 a, f32x4 b) { u32x4 o; o.x = pk2(a.x, a.y); o.y = pk2(a.z, a.w); o.z = pk2(b.x, b.y); o.w = pk2(b.z, b.w); return __builtin_bit_cast(bf16x8, o); }
#define MFMA16(a, b, c) __builtin_amdgcn_mfma_f32_16x16x32_bf16((a), (b), (c), 0, 0, 0)
#define MFMA32(a, b, c) __builtin_amdgcn_mfma_f32_32x32x16_bf16((a), (b), (c), 0, 0, 0)

DI void phaseA(const P& p, LAS unsigned char* lds, int tid, int wave, int lane) {
    const int gw = blockIdx.x * 8 + wave, NGW = G * 8;
    { float* ssq = (float*)(p.ws + WS_SSQ); for (int i = blockIdx.x * 512 + tid; i < 2 * M; i += G * 512) ssq[i] = 0.f; }
    { float* rc = (float*)(p.ws + WS_ROPE);
      for (int i = blockIdx.x * 512 + tid; i < 2048 * 32 + 32; i += G * 512) {
          const int pos = i < 2048 * 32 ? (i >> 5) : PAST, j = i & 31;
          const float inv = exp2f(-(float)j * (13.287712379549449f / 32.0f));
          const float ang = (float)pos * inv; float sn, cs; sincosf(ang, &sn, &cs);
          if (i < 2048 * 32) { rc[i] = cs; rc[2048 * 32 + i] = sn; } else { rc[2 * 2048 * 32 + j] = cs; rc[2 * 2048 * 32 + 32 + j] = sn; }
      } }
#ifndef REP_ADA
#define REP_ADA 1
#endif
    for (int rep = 0; rep < REP_ADA; ++rep)
    for (int item = blockIdx.x; item < 2 * 384; item += G) {
        const int l = item / 384, cs = item % 384, h = lane >> 5, r = lane & 31;
        const float* W = p.wada + (size_t)l * D * 6 * D + cs * 32 + r;
        const float* c0 = (r < 4) ? p.cp + r * D : p.cs + (r - 4) * D;
        const float* c1 = p.cs + (28 + (r & 3)) * D;
        f32x16 acc0, acc1;
#pragma unroll
        for (int q = 0; q < 16; ++q) { acc0[q] = 0.f; acc1[q] = 0.f; }
#pragma unroll 4
        for (int ks = 0; ks < 16; ++ks) {
            const int k = wave * 256 + ks * 16 + h * 8;
            float w[8];
#pragma unroll
            for (int j = 0; j < 8; ++j) w[j] = W[(size_t)(k + j) * (6 * D)];
            const bf16x8 bfr = pack8(w);
            f32x4 a0 = *(const f32x4*)(c0 + k), a1 = *(const f32x4*)(c0 + k + 4);
            f32x4 e0 = {0.f, 0.f, 0.f, 0.f}, e1 = e0;
            if (r < 4) { e0 = *(const f32x4*)(c1 + k); e1 = *(const f32x4*)(c1 + k + 4); }
#pragma unroll
            for (int q = 0; q < 4; ++q) { a0[q] = silu_f(a0[q]); a1[q] = silu_f(a1[q]); e0[q] = silu_f(e0[q]); e1[q] = silu_f(e1[q]); }
            acc0 = MFMA32(pack8v(a0, a1), bfr, acc0);
            acc1 = MFMA32(pack8v(e0, e1), bfr, acc1);
        }
        LAS float* red = (LAS float*)lds;
#pragma unroll
        for (int q = 0; q < 16; ++q) { red[((wave * 2 + 0) * 16 + q) * 64 + lane] = acc0[q]; red[((wave * 2 + 1) * 16 + q) * 64 + lane] = acc1[q]; }
        __syncthreads();
        for (int idx = tid; idx < NMODROWS * 32; idx += 512) {
            const int row = idx >> 5, col = idx & 31, mt = row >> 5, rr = row & 31, q = (rr >> 3) * 4 + (rr & 3), ln = ((rr >> 2) & 1) * 32 + col;
            float s = 0.f;
#pragma unroll
            for (int w8 = 0; w8 < 8; ++w8) s += red[((w8 * 2 + mt) * 16 + q) * 64 + ln];
            ((float*)(p.ws + WS_MOD))[((size_t)l * NMODROWS + row) * (6 * D) + cs * 32 + col] = s + p.bada[l * 6 * D + cs * 32 + col];
        }
        __syncthreads();
    }
    LAS float* scr = (LAS float*)(lds + wave * 8448);
    constexpr int I_IN = 32 * 112, I_OUT = 32 * 64, I_G = 32 * 176, I_DN = 88 * 64, I_L = I_IN + I_OUT + 2 * I_G + I_DN;
    auto decode = [&](int it) { ConvDesc d; const int l = it / I_L; int r = it % I_L;
        if (r < I_IN) { d.W = p.win + (size_t)l * D * INC; d.WT = (bf16_t*)(p.ws + WS_WIN + l * SZ_WIN); d.K = D; d.N = INC; d.type = 0; d.item = r; return d; } r -= I_IN;
        if (r < I_OUT) { d.W = p.wout + (size_t)l * D * D; d.WT = (bf16_t*)(p.ws + WS_WOUT + l * SZ_WOUT); d.K = D; d.N = D; d.type = 1; d.item = r; return d; } r -= I_OUT;
        if (r < I_G) { d.W = p.wgate + (size_t)l * D * DFF; d.WT = (bf16_t*)(p.ws + WS_WGU + l * SZ_WGU); d.K = D; d.N = DFF; d.type = 2; d.item = r; return d; } r -= I_G;
        if (r < I_G) { d.W = p.wup + (size_t)l * D * DFF; d.WT = (bf16_t*)(p.ws + WS_WGU + l * SZ_WGU); d.K = D; d.N = DFF; d.type = 3; d.item = r; return d; } r -= I_G;
        d.W = p.wdown + (size_t)l * DFF * D; d.WT = (bf16_t*)(p.ws + WS_WDN + l * SZ_WDN); d.K = DFF; d.N = D; d.type = 1; d.item = r; return d; };
    { int it = gw; ConvDesc d = decode(it < 2 * I_L ? it : 0); f32x4 v[8];
      if (it < 2 * I_L) conv_load(d, lane, v);
      while (it < 2 * I_L) {
          const int nit = it + NGW; ConvDesc nd = decode(nit < 2 * I_L ? nit : 0); f32x4 nv[8];
          if (nit < 2 * I_L) conv_load(nd, lane, nv);
          conv_store(d, lane, v, scr);
          it = nit; d = nd;
#pragma unroll
          for (int i = 0; i < 8; ++i) v[i] = nv[i];
      } }
}

DI void phase_norm(const P& p, int l, int which, int wave, int lane) {
    const int gw = blockIdx.x * 8 + wave, NGW = G * 8;
    const float* mod = (const float*)(p.ws + WS_MOD) + (size_t)l * NMODROWS * 6 * D;
    const float* gvec = which == 0 ? p.g1 + l * D : which == 1 ? p.g2 + l * D : p.gfinal;
    const bool first = (l == 0 && which == 0);
    for (int row = gw; row < M + NS; row += NGW) {
        const float* x; bf16_t* o; float* of; int mrow;
        if (row < M) { x = (first ? p.xp : (const float*)(p.ws + WS_XR)) + (size_t)row * D; o = (bf16_t*)(p.ws + WS_XN) + (size_t)row * LDD; of = p.out + O_YP + (size_t)row * D; mrow = row >> 11; }
        else { const int s = row - M; x = (first ? p.xs : (const float*)(p.ws + WS_SMP + SM_XS)) + (size_t)s * D; o = (bf16_t*)(p.ws + WS_SMP + SM_HS) + (size_t)s * D; of = p.out + O_YS + (size_t)s * D; mrow = NB + s; }
        f32x4 v[8]; float ss = 0.f;
        if (row < M && !first) {
#pragma unroll
            for (int j = 0; j < 8; ++j) { const u32x2 w = ((const u32x2*)((const bf16_t*)(p.ws + WS_XR) + (size_t)row * D))[lane + 64 * j]; v[j] = (f32x4){bflo(w.x), bfhi(w.x), bflo(w.y), bfhi(w.y)}; }
        } else {
#pragma unroll
            for (int j = 0; j < 8; ++j) v[j] = ((const f32x4*)x)[lane + 64 * j];
        }
#pragma unroll
        for (int j = 0; j < 8; ++j) ss += (v[j].x * v[j].x + v[j].y * v[j].y) + (v[j].z * v[j].z + v[j].w * v[j].w);
        const float rstd = rsqrtf(wave_sum(ss) * (1.0f / D) + EPS);
        if (which == 2) {
#pragma unroll
            for (int j = 0; j < 8; ++j) { const f32x4 g = ((const f32x4*)gvec)[lane + 64 * j]; ((f32x4*)of)[lane + 64 * j] = v[j] * rstd * g; }
        } else {
            const float* sh = mod + (size_t)mrow * 6 * D + (which == 0 ? 0 : 3) * D; const float* sc = sh + D;
#pragma unroll
            for (int j = 0; j < 8; ++j) { const f32x4 g = ((const f32x4*)gvec)[lane + 64 * j], c = ((const f32x4*)sc)[lane + 64 * j], h = ((const f32x4*)sh)[lane + 64 * j];
                const f32x4 y = v[j] * rstd * g * (c + 1.0f) + h; u32x2 w; w.x = pk2(y.x, y.y); w.y = pk2(y.z, y.w); ((u32x2*)o)[lane + 64 * j] = w; }
        }
    }
}

struct EpiIn {
    static constexpr bool PERM = false, AFTER_DRAIN = false;
    bf16_t *Q, *K, *V, *U, *GT; float* ssq; const float* rope; float *kwin, *vwin, *gmv; LAS unsigned char* tbuf;
    DI void operator()(const f32x4 (&acc)[2][2][4][2], const pg8::Unit& u, int wr, int wc, int fr, int fq) const {
        const int pn = u.pn, b = u.pm >> 3;
#pragma unroll
        for (int ai = 0; ai < 2; ++ai)
#pragma unroll
            for (int m = 0; m < 4; ++m) {
                const int row = u.pm * 256 + ai * 128 + wr * 64 + m * 16 + fr, t = row & 2047;
                if (pn <= 4) {
                    const int dh = 16 * (wc & 1) + 4 * fq;
                    const f32x4 cs = *(const f32x4*)(rope + t * 32 + dh), sn = *(const f32x4*)(rope + 65536 + t * 32 + dh);
#pragma unroll
                    for (int bj = 0; bj < 2; ++bj) {
                        const f32x4 x1 = acc[ai][bj][m][0], x2 = acc[ai][bj][m][1];
                        const f32x4 o1 = x1 * cs - x2 * sn, o2 = x2 * cs + x1 * sn;
                        const int hc = (2 * bj + (wc >> 1)) * 64 + dh;
                        u32x2 w1, w2; w1.x = pk2(o1.x, o1.y); w1.y = pk2(o1.z, o1.w); w2.x = pk2(o2.x, o2.y); w2.y = pk2(o2.z, o2.w);
                        if (pn < 4) { bf16_t* dst = Q + (size_t)row * 1024 + pn * 256 + hc; *(u32x2*)dst = w1; *(u32x2*)(dst + 32) = w2; }
                        else { bf16_t* dst = K + (size_t)row * 256 + hc; *(u32x2*)dst = w1; *(u32x2*)(dst + 32) = w2;
                            if (t >= 1920) { float* w = kwin + ((size_t)(b * 128 + t - 1920) * 256 + hc); *(f32x4*)w = o1; *(f32x4*)(w + 32) = o2; } }
                    }
                } else if (pn == 5) {
#pragma unroll
                    for (int bj = 0; bj < 2; ++bj) {
                        const int col = 128 * bj + 32 * wc + 8 * fq; const f32x4 v0 = acc[ai][bj][m][0], v1 = acc[ai][bj][m][1];
                        u32x4 w; w.x = pk2(v0.x, v0.y); w.y = pk2(v0.z, v0.w); w.z = pk2(v1.x, v1.y); w.w = pk2(v1.z, v1.w);
                        *(u32x4*)(V + (size_t)row * 256 + col) = w;
                        if (t >= 1920) { float* o = vwin + ((size_t)(b * 128 + t - 1920) * 256 + col); *(f32x4*)o = v0; *(f32x4*)(o + 4) = v1; }
                    }
                } else if (pn < 10) {
#pragma unroll
                    for (int bj = 0; bj < 2; ++bj) {
                        const int col = 256 * (pn - 6) + 128 * bj + 32 * wc + 8 * fq; f32x4 v0 = acc[ai][bj][m][0], v1 = acc[ai][bj][m][1];
#pragma unroll
                        for (int e = 0; e < 4; ++e) { v0[e] = gelu_tanh(v0[e]); v1[e] = gelu_tanh(v1[e]); }
                        u32x4 w; w.x = pk2(v0.x, v0.y); w.y = pk2(v0.z, v0.w); w.z = pk2(v1.x, v1.y); w.w = pk2(v1.z, v1.w);
                        *(u32x4*)(U + (size_t)row * 1024 + col) = w;
                    }
                } else {
                    float s = 0.f; LAS unsigned char* tb = tbuf + (wr * 4 + wc) * 2048;
#pragma unroll
                    for (int bj = 0; bj < 2; ++bj)
#pragma unroll
                        for (int n = 0; n < 2; ++n) {
                            const int col = 256 * (pn - 10) + 128 * bj + 32 * wc + 16 * n + 4 * fq; f32x4 g = acc[ai][bj][m][n];
#pragma unroll
                            for (int e = 0; e < 4; ++e) { g[e] = gelu_tanh(g[e]); s += g[e] * g[e]; *(LAS unsigned short*)(tb + (32 * bj + 16 * n + 4 * fq + e) * 32 + fr * 2) = (unsigned short)f2bf(g[e]); }
                            if (t >= 1920) *(f32x4*)(gmv + ((size_t)(b * 128 + t - 1920) * 1024 + col)) = g;
                        }
                    asm volatile("s_waitcnt lgkmcnt(0)" ::: "memory");
                    { const int lane = fq * 16 + fr, t0 = (u.pm * 256 + ai * 128 + wr * 64 + m * 16) & 2047;
#pragma unroll
                      for (int q = 0; q < 2; ++q) { const int id = lane + 64 * q, lc = id & 63, half = id >> 6;
                          const u32x4 v = *(const LAS u32x4*)(tb + lc * 32 + half * 16);
                          const int col = 256 * (pn - 10) + 128 * (lc >> 5) + 32 * wc + (lc & 31);
                          *(u32x4*)(GT + ((((size_t)b * 256 + (t0 >> 3) + half) * 1024 + col) << 3)) = v; }
                    }
                    asm volatile("s_waitcnt lgkmcnt(0)" ::: "memory");
                    s += __shfl_xor(s, 16); s += __shfl_xor(s, 32);
                    if (fq == 0) __hip_atomic_fetch_add(ssq + row, s, __ATOMIC_RELAXED, __HIP_MEMORY_SCOPE_AGENT);
                }
            }
    }
};
template <bool BASE_F32>
struct EpiRes {
    static constexpr bool PERM = false, AFTER_DRAIN = false;
    const float* basef; bf16_t* xr; const float* gate;
    DI void operator()(const f32x4 (&acc)[2][2][4][2], const pg8::Unit& u, int wr, int wc, int fr, int fq) const {
        const int b = u.pm >> 3; const int col0 = u.pn * 256 + wc * 32 + 8 * fq;
        f32x4 gv[2][2];
#pragma unroll
        for (int bj = 0; bj < 2; ++bj)
#pragma unroll
            for (int n = 0; n < 2; ++n) gv[bj][n] = *(const f32x4*)(gate + (size_t)b * 6 * D + col0 + bj * 128 + n * 4);
#pragma unroll
        for (int ai = 0; ai < 2; ++ai) {
            f32x4 bs[4][2][2];
#pragma unroll
            for (int m = 0; m < 4; ++m) { const size_t off = (size_t)(u.pm * 256 + ai * 128 + wr * 64 + m * 16 + fr) * D + col0;
#pragma unroll
                for (int bj = 0; bj < 2; ++bj) {
                    if (BASE_F32) { bs[m][bj][0] = *(const f32x4*)(basef + off + bj * 128); bs[m][bj][1] = *(const f32x4*)(basef + off + bj * 128 + 4); }
                    else { const u32x4 w = *(const u32x4*)(xr + off + bj * 128); bs[m][bj][0] = (f32x4){bflo(w.x), bfhi(w.x), bflo(w.y), bfhi(w.y)}; bs[m][bj][1] = (f32x4){bflo(w.z), bfhi(w.z), bflo(w.w), bfhi(w.w)}; } } }
#pragma unroll
            for (int m = 0; m < 4; ++m) { const size_t off = (size_t)(u.pm * 256 + ai * 128 + wr * 64 + m * 16 + fr) * D + col0;
#pragma unroll
                for (int bj = 0; bj < 2; ++bj) { const f32x4 o0 = bs[m][bj][0] + gv[bj][0] * acc[ai][bj][m][0], o1 = bs[m][bj][1] + gv[bj][1] * acc[ai][bj][m][1];
                    u32x4 w; w.x = pk2(o0.x, o0.y); w.y = pk2(o0.z, o0.w); w.z = pk2(o1.x, o1.y); w.w = pk2(o1.z, o1.w);
                    *(u32x4*)(xr + off + bj * 128) = w; } }
            asm volatile("" ::: "memory"); }
    }
};
DI float dpp_ror1(float v) { return __builtin_bit_cast(float, __builtin_amdgcn_update_dpp(0, __builtin_bit_cast(int, v), 0x121, 0xf, 0xf, false)); }
DI float dpp_ror2(float v) { return __builtin_bit_cast(float, __builtin_amdgcn_update_dpp(0, __builtin_bit_cast(int, v), 0x122, 0xf, 0xf, false)); }
struct EpiGU {
    static constexpr bool PERM = false, AFTER_DRAIN = false;
    bf16_t* ACT; float* SA; float* SU; float* cvp; const float* cw; const float* cb;
    DI void operator()(const f32x4 (&acc)[2][2][4][2], const pg8::Unit& u, int wr, int wc, int fr, int fq) const {
        const int b = u.pm >> 3, f0 = u.pn * 128 + wc * 32 + 8 * fq;
        float w0[8], w1[8], w2[8], bb[8];
#pragma unroll
        for (int q = 0; q < 2; ++q) { const f32x4 x0 = *(const f32x4*)(cw + f0 + 4 * q), x1 = *(const f32x4*)(cw + DFF + f0 + 4 * q), x2 = *(const f32x4*)(cw + 2 * DFF + f0 + 4 * q), x3 = *(const f32x4*)(cb + f0 + 4 * q);
#pragma unroll
            for (int e = 0; e < 4; ++e) { w0[4 * q + e] = x0[e]; w1[4 * q + e] = x1[e]; w2[4 * q + e] = x2[e]; bb[4 * q + e] = x3[e]; } }
#pragma unroll
        for (int ai = 0; ai < 2; ++ai) {
            const int blk = u.pm * 4 + ai * 2 + wr;
#pragma unroll
            for (int m = 0; m < 4; ++m) { const int row = u.pm * 256 + ai * 128 + wr * 64 + m * 16 + fr, t = row & 2047;
                float o[8];
#pragma unroll
                for (int n = 0; n < 2; ++n)
#pragma unroll
                    for (int e = 0; e < 4; ++e) { const float a = acc[ai][0][m][n][e], ap = acc[ai][0][m > 0 ? m - 1 : 0][n][e];
                        const float r1a = dpp_ror1(a), r1b = dpp_ror1(ap), r2a = dpp_ror2(a), r2b = dpp_ror2(ap);
                        const float p1 = fr >= 1 ? r1a : r1b, p2 = fr >= 2 ? r2a : r2b;
                        const int c = 4 * n + e; const float cv = bb[c] + w0[c] * p2 + w1[c] * p1 + w2[c] * a;
                        o[c] = silu_f(cv) * acc[ai][1][m][n][e]; }
                const f32x4 g0 = acc[ai][0][m][0], g1 = acc[ai][0][m][1];
                if (m == 0 && fr < 2) {
                    float* sa = SA + ((size_t)(blk * 4 + 2 + fr)) * DFF + f0; *(f32x4*)sa = g0; *(f32x4*)(sa + 4) = g1;
                    float* su = SU + ((size_t)(blk * 2 + fr)) * DFF + f0; *(f32x4*)su = acc[ai][1][m][0]; *(f32x4*)(su + 4) = acc[ai][1][m][1];
                } else {
                    u32x4 w; w.x = pk2(o[0], o[1]); w.y = pk2(o[2], o[3]); w.z = pk2(o[4], o[5]); w.w = pk2(o[6], o[7]);
                    *(u32x4*)(ACT + (size_t)row * LDF + f0) = w;
                }
                if (m == 3 && fr >= 14) { float* sa = SA + ((size_t)(blk * 4 + fr - 14)) * DFF + f0; *(f32x4*)sa = g0; *(f32x4*)(sa + 4) = g1; }
                if (t >= 2046) { float* oo = cvp + ((size_t)(b * 2 + t - 2046) * DFF + f0); *(f32x4*)oo = g0; *(f32x4*)(oo + 4) = g1; }
            }
        }
    }
};

struct EpiNull {
    static constexpr bool PERM = false, AFTER_DRAIN = false;
    float* sink;
    DI void operator()(const f32x4 (&acc)[2][2][4][2], const pg8::Unit& u, int wr, int wc, int fr, int fq) const {
        f32x4 s = {0.f, 0.f, 0.f, 0.f};
#pragma unroll
        for (int ai = 0; ai < 2; ++ai)
#pragma unroll
            for (int bj = 0; bj < 2; ++bj)
#pragma unroll
                for (int m = 0; m < 4; ++m)
#pragma unroll
                    for (int n = 0; n < 2; ++n) s += acc[ai][bj][m][n];
        if (s.x + s.y + s.z + s.w == 1234567.0f) sink[8191] = s.x;
    }
};
DI void attn_unit(const P& p, int l, int unit, LAS unsigned char* lds, int tid, int wave, int lane) {
    const int b = unit >> 6, n = (unit >> 2) & 15, kvh = unit & 3;
    const bf16_t* Kb = (const bf16_t*)(p.ws + WS_K); const bf16_t* Vb = (const bf16_t*)(p.ws + WS_V); const bf16_t* Qb = (const bf16_t*)(p.ws + WS_Q);
    bf16_t* MIX = (bf16_t*)(p.ws + WS_MIX);
    LAS unsigned char* Ks = lds;
    LAS unsigned char* Vt = lds + 256 * 144;
    const int tok0 = b * 2048 + (n - 1) * 128;
#pragma unroll
    for (int i = 0; i < 4; ++i) { const int id = i * 512 + tid, key = id >> 3, part = id & 7;
        u32x4 v = {0u, 0u, 0u, 0u}; if (n > 0 || key >= 128) v = *(const u32x4*)(Kb + (size_t)(tok0 + key) * 256 + kvh * 64 + part * 8);
        *(LAS u32x4*)(Ks + key * 144 + part * 16) = v; }
#pragma unroll
    for (int i = 0; i < 4; ++i) { const int id = i * 512 + tid, key = id & 255, part = id >> 8;
        u32x4 v = {0u, 0u, 0u, 0u}; if (n > 0 || key >= 128) v = *(const u32x4*)(Vb + (size_t)(tok0 + key) * 256 + kvh * 64 + part * 8);
        LAS unsigned short* d = (LAS unsigned short*)(Vt + (part * 8) * 528 + key * 2);
        d[0 * 264] = (unsigned short)(v.x & 0xffffu); d[1 * 264] = (unsigned short)(v.x >> 16); d[2 * 264] = (unsigned short)(v.y & 0xffffu); d[3 * 264] = (unsigned short)(v.y >> 16);
        d[4 * 264] = (unsigned short)(v.z & 0xffffu); d[5 * 264] = (unsigned short)(v.z >> 16); d[6 * 264] = (unsigned short)(v.w & 0xffffu); d[7 * 264] = (unsigned short)(v.w >> 16); }
    __syncthreads();
    const int q16 = lane & 15, g4 = lane >> 4;
    for (int it = 0; it < 4; ++it) {
        const int qg = wave * 4 + it, g = qg >> 3, i0 = (qg & 7) * 16, head = kvh * 4 + g, nt0 = i0 >> 4;
        const size_t qtok = (size_t)b * 2048 + n * 128 + i0 + q16;
        const bf16x8 q0 = *(const bf16x8*)(Qb + qtok * 1024 + head * 64 + g4 * 8), q1 = *(const bf16x8*)(Qb + qtok * 1024 + head * 64 + 32 + g4 * 8);
        f32x4 s[9];
#pragma unroll
        for (int tt = 0; tt < 9; ++tt) { const LAS unsigned char* kp = Ks + ((nt0 + tt) * 16 + q16) * 144 + g4 * 16;
            const bf16x8 a0 = *(const LAS bf16x8*)kp, a1 = *(const LAS bf16x8*)(kp + 64);
            f32x4 z = {0.f, 0.f, 0.f, 0.f}; z = MFMA16(a0, q0, z); s[tt] = MFMA16(a1, q1, z); }
        const int iq = i0 + q16; float mx = -1e30f;
#pragma unroll
        for (int tt = 0; tt < 9; ++tt)
#pragma unroll
            for (int r = 0; r < 4; ++r) { const int j = (nt0 + tt) * 16 + g4 * 4 + r; const bool ok = (j >= iq) && (j <= iq + 128) && (n > 0 || j >= 128);
                const float v = ok ? s[tt][r] * 0.125f : -1e30f; s[tt][r] = v; mx = fmaxf(mx, v); }
        mx = fmaxf(mx, __shfl_xor(mx, 16)); mx = fmaxf(mx, __shfl_xor(mx, 32));
        const float sink = p.sinks[l * NH + head]; const float mm = fmaxf(mx, sink);
        float sum = 0.f;
#pragma unroll
        for (int tt = 0; tt < 9; ++tt)
#pragma unroll
            for (int r = 0; r < 4; ++r) { const float e = __expf(s[tt][r] - mm); s[tt][r] = e; sum += e; }
        sum += __shfl_xor(sum, 16); sum += __shfl_xor(sum, 32);
        const float inv = 1.0f / (sum + __expf(sink - mm));
        f32x4 o[4];
#pragma unroll
        for (int dt = 0; dt < 4; ++dt) o[dt] = (f32x4){0.f, 0.f, 0.f, 0.f};
#pragma unroll
        for (int i = 0; i < 5; ++i) {
            const f32x4 pl = s[2 * i], ph = (2 * i + 1 < 9) ? s[(2 * i + 1 < 9) ? 2 * i + 1 : 8] : (f32x4){0.f, 0.f, 0.f, 0.f};
            const bf16x8 pb = pack8v(pl, ph);
#pragma unroll
            for (int dt = 0; dt < 4; ++dt) { const LAS unsigned char* vp = Vt + (16 * dt + q16) * 528 + ((nt0 + 2 * i) * 16 + g4 * 4) * 2;
                u32x4 va; const u32x2 lo = *(const LAS u32x2*)vp; va.x = lo.x; va.y = lo.y;
                if (2 * i + 1 < 9) { const u32x2 hi = *(const LAS u32x2*)(vp + 32); va.z = hi.x; va.w = hi.y; } else { va.z = 0u; va.w = 0u; }
                o[dt] = MFMA16(__builtin_bit_cast(bf16x8, va), pb, o[dt]); }
        }
#pragma unroll
        for (int dt = 0; dt < 4; ++dt) { u32x2 w; w.x = pk2(o[dt].x * inv, o[dt].y * inv); w.y = pk2(o[dt].z * inv, o[dt].w * inv);
            *(u32x2*)(MIX + qtok * LDD + head * 64 + 16 * dt + 4 * g4) = w; }
    }
    __syncthreads();
}

DI void gmlp_unit(const P& p, int l, int unit, int wave, int lane) {
    const int b = unit >> 7, c = (unit >> 3) & 15, h = unit & 7;
    const int q16 = lane & 15, g4 = lane >> 4, i = 16 * wave + q16;
    const float* Wrow = p.gmws + (((size_t)l * 8 + h) * 128 + i) * 128;
    const float* ssq = (const float*)(p.ws + WS_SSQ) + l * M + b * 2048 + c * 128;
    const bf16_t* GT = (const bf16_t*)(p.ws + WS_GT) + (((size_t)(b * 16 + c) * 16) * 1024 + h * 128) * 8;
    const bf16_t* U = (const bf16_t*)(p.ws + WS_U); bf16_t* MIX = (bf16_t*)(p.ws + WS_MIX);
    f32x4 acc[8];
#pragma unroll
    for (int dt = 0; dt < 8; ++dt) acc[dt] = (f32x4){0.f, 0.f, 0.f, 0.f};
    const int ksmax = wave >> 1;
    for (int ks = 0; ks <= ksmax; ++ks) {
        const int j0 = 32 * ks + 8 * g4;
        const f32x4 w0 = *(const f32x4*)(Wrow + j0), w1 = *(const f32x4*)(Wrow + j0 + 4), s0 = *(const f32x4*)(ssq + j0), s1 = *(const f32x4*)(ssq + j0 + 4);
        float wv[8];
#pragma unroll
        for (int jj = 0; jj < 4; ++jj) { wv[jj] = (j0 + jj <= i) ? w0[jj] * rsqrtf(s0[jj] * (1.0f / GMW) + EPS) : 0.f; wv[4 + jj] = (j0 + 4 + jj <= i) ? w1[jj] * rsqrtf(s1[jj] * (1.0f / GMW) + EPS) : 0.f; }
        const bf16x8 bw = pack8(wv);
#pragma unroll
        for (int dt = 0; dt < 8; ++dt) { const bf16x8 a = *(const bf16x8*)(GT + ((size_t)(4 * ks + g4) * 1024 + 16 * dt + q16) * 8); acc[dt] = MFMA16(a, bw, acc[dt]); }
    }
    const size_t tok = (size_t)b * 2048 + c * 128 + i;
    const float bias = p.gmbs[(l * 8 + h) * 128 + i];
#pragma unroll
    for (int dt = 0; dt < 8; ++dt) { const int col = h * 128 + 16 * dt + 4 * g4;
        const f32x4 gain = *(const f32x4*)(p.gmgain + l * GMW + col); const u32x2 uu = *(const u32x2*)(U + tok * 1024 + col);
        const float o0 = bflo(uu.x) * (gain.x * acc[dt].x + bias), o1 = bfhi(uu.x) * (gain.y * acc[dt].y + bias), o2 = bflo(uu.y) * (gain.z * acc[dt].z + bias), o3 = bfhi(uu.y) * (gain.w * acc[dt].w + bias);
        u32x2 w; w.x = pk2(o0, o1); w.y = pk2(o2, o3); *(u32x2*)(MIX + tok * LDD + 1024 + col) = w; }
}

DI void sample_part(const P& p, int l, int s, int hp, LAS unsigned char* lds, int tid, int wave, int lane) {
    const float* qS = (const float*)(p.ws + WS_SMP + SM_Q) + s * 1024; const float* kS = (const float*)(p.ws + WS_SMP + SM_KK) + s * 256; const float* vS = (const float*)(p.ws + WS_SMP + SM_VV) + s * 256;
    const float* uS = (const float*)(p.ws + WS_SMP + SM_UU) + s * 1024; const float* gS = (const float*)(p.ws + WS_SMP + SM_GG) + s * 1024;
    bf16_t* mix = (bf16_t*)(p.ws + WS_SMP + SM_MIX) + s * 2048;
    const float* ck = p.ck + ((size_t)l * NS + s) * WIN * KVW; const float* cv = p.cv + ((size_t)l * NS + s) * WIN * KVW;
    LAS float* red = (LAS float*)lds;
    LAS float* ql = (LAS float*)(lds + 128);
    LAS float* pl = (LAS float*)(lds + 128 + 512);
    LAS float* po = (LAS float*)(lds + 128 + 512 + 1056);
    const int kvh = hp >> 1, hh = tid >> 8, j = tid & 255, head = 2 * hp + hh;
    const float g0 = gS[tid], g1 = gS[tid + 512];
    if (tid < 128) ql[tid] = qS[2 * hp * 64 + tid];
    f32x4 kk[16];
    { const float* kr = (j < 128) ? ck + (size_t)j * KVW + kvh * 64 : kS + kvh * 64;
#pragma unroll
      for (int e = 0; e < 16; ++e) kk[e] = (j < 129) ? ((const f32x4*)kr)[e] : (f32x4){0.f, 0.f, 0.f, 0.f}; }
    { float* ko = p.out + O_KWS + ((size_t)l * NS + s) * WIN * KVW; float* vo = p.out + O_VWS + ((size_t)l * NS + s) * WIN * KVW;
#pragma unroll
      for (int q = 0; q < 2; ++q) { const int i = hp * 1024 + tid + 512 * q, jj = i >> 6, c4 = i & 63;
          const f32x4 kv = (jj < 127) ? ((const f32x4*)ck)[(jj + 1) * 64 + c4] : ((const f32x4*)kS)[c4];
          const f32x4 vv = (jj < 127) ? ((const f32x4*)cv)[(jj + 1) * 64 + c4] : ((const f32x4*)vS)[c4];
          ((f32x4*)ko)[i] = kv; ((f32x4*)vo)[i] = vv; } }
    float ss = wave_sum(g0 * g0 + g1 * g1);
    if (lane == 0) red[wave] = ss;
    __syncthreads();
    if (tid < 128) { float tot = 0.f;
#pragma unroll
        for (int w = 0; w < 8; ++w) tot += red[w];
        const float rstd = rsqrtf(tot * (1.0f / GMW) + EPS); const int c = 128 * hp + tid;
        const float gvn = gS[c] * rstd * p.gmgain[l * GMW + c];
        p.out[O_GMS + ((size_t)l * NS + s) * GMW + c] = gvn;
        const float sv = p.gmws[((size_t)l * 8 + hp) * 128 * 128] * gvn + p.gmbs[(l * 8 + hp) * 128];
        mix[1024 + c] = (bf16_t)f2bf(uS[c] * sv); }
    float sc = -1e30f;
    if (j < 129) { float d = 0.f;
#pragma unroll
        for (int e = 0; e < 16; ++e) { const LAS float* qq = ql + hh * 64 + 4 * e; d += kk[e].x * qq[0] + kk[e].y * qq[1] + kk[e].z * qq[2] + kk[e].w * qq[3]; }
        sc = d * 0.125f; }
    float mx = sc;
#pragma unroll
    for (int o = 1; o < 64; o <<= 1) mx = fmaxf(mx, __shfl_xor(mx, o));
    if (lane == 0) red[8 + wave] = mx;
    __syncthreads();
    mx = fmaxf(fmaxf(red[8 + 4 * hh], red[9 + 4 * hh]), fmaxf(red[10 + 4 * hh], red[11 + 4 * hh]));
    const float sink = p.sinks[l * NH + head], mm = fmaxf(mx, sink);
    const float pe = (j < 129) ? __expf(sc - mm) : 0.f;
    const float sm = wave_sum(pe);
    if (lane == 0) red[16 + wave] = sm;
    __syncthreads();
    const float inv = 1.0f / ((red[16 + 4 * hh] + red[17 + 4 * hh]) + (red[18 + 4 * hh] + red[19 + 4 * hh]) + __expf(sink - mm));
    if (j < 129) pl[hh * 132 + j] = pe * inv;
    __syncthreads();
    { const int part = (tid >> 5) & 7, d2 = (tid & 31) * 2; float o0 = 0.f, o1 = 0.f; f32x2 vv[16];
#pragma unroll
      for (int q = 0; q < 16; ++q) vv[q] = *(const f32x2*)(cv + (size_t)(part * 16 + q) * KVW + kvh * 64 + d2);
#pragma unroll
      for (int q = 0; q < 16; ++q) { const float pj = pl[hh * 132 + part * 16 + q]; o0 += pj * vv[q].x; o1 += pj * vv[q].y; }
      if (part == 0) { const float pj = pl[hh * 132 + 128]; const f32x2 v2 = *(const f32x2*)(vS + kvh * 64 + d2); o0 += pj * v2.x; o1 += pj * v2.y; }
      po[(hh * 8 + part) * 64 + d2] = o0; po[(hh * 8 + part) * 64 + d2 + 1] = o1; }
    __syncthreads();
    if (tid < 128) { const int h2 = tid >> 6, d = tid & 63; float o = 0.f;
#pragma unroll
        for (int q = 0; q < 8; ++q) o += po[(h2 * 8 + q) * 64 + d];
        mix[(2 * hp + h2) * 64 + d] = (bf16_t)f2bf(o); }
    __syncthreads();
}

DI void gmv_fix(const P& p, int l, int tid) {
    float* gmv = p.out + O_GMP + (size_t)l * NB * 128 * GMW; const float* ssq = (const float*)(p.ws + WS_SSQ) + l * M;
    for (int i = blockIdx.x * 512 + tid; i < NB * 128 * GMW / 4; i += G * 512) { const int c4 = i & 255, r = i >> 8, b = r >> 7, tt = r & 127;
        const float rs = rsqrtf(ssq[b * 2048 + 1920 + tt] * (1.0f / GMW) + EPS); const f32x4 g = ((const f32x4*)(p.gmgain + l * GMW))[c4];
        f32x4 v = ((f32x4*)gmv)[i]; v = v * rs * g; ((f32x4*)gmv)[i] = v; }
}

DI void phase_fix(const P& p, int l, int tid) {
    const float* SA = (const float*)(p.ws + WS_GA); const float* SU = SA + (size_t)128 * 4 * DFF; bf16_t* ACT = (bf16_t*)(p.ws + WS_UP);
    const float* cw = p.convw + (size_t)l * 3 * DFF; const float* cb = p.convb + (size_t)l * DFF;
    constexpr int NC4 = DFF / 4;
    for (int task = blockIdx.x * 512 + tid; task < 128 * 2 * NC4; task += G * 512) {
        const int c4 = task % NC4, rr = task / NC4, blk = rr >> 1, r = rr & 1, f = c4 * 4; const bool first = (blk & 31) == 0;
        const f32x4 z = {0.f, 0.f, 0.f, 0.f};
        const float* cur = SA + (size_t)blk * 4 * DFF + f; const float* prv = SA + (size_t)(blk - 1) * 4 * DFF + f;
        const f32x4 a2 = *(const f32x4*)(cur + (2 + r) * DFF);
        const f32x4 a1 = r ? *(const f32x4*)(cur + 2 * DFF) : (first ? z : *(const f32x4*)(prv + DFF));
        const f32x4 a0 = r ? (first ? z : *(const f32x4*)(prv + DFF)) : (first ? z : *(const f32x4*)prv);
        const f32x4 uu = *(const f32x4*)(SU + ((size_t)(blk * 2 + r)) * DFF + f);
        const f32x4 x0 = *(const f32x4*)(cw + f), x1 = *(const f32x4*)(cw + DFF + f), x2 = *(const f32x4*)(cw + 2 * DFF + f), x3 = *(const f32x4*)(cb + f);
        float o[4];
#pragma unroll
        for (int e = 0; e < 4; ++e) o[e] = silu_f(x3[e] + x0[e] * a0[e] + x1[e] * a1[e] + x2[e] * a2[e]) * uu[e];
        u32x2 w; w.x = pk2(o[0], o[1]); w.y = pk2(o[2], o[3]);
        *(u32x2*)(ACT + (size_t)(blk * 64 + r) * LDF + f) = w;
    }
}
template <int NBLK, int K, class Epi>
#ifndef SK_REPEAT
#define SK_REPEAT 1
#endif
DI void skinny(LAS unsigned char* lds, const bf16_t* A, const bf16_t* B0, const bf16_t* B1, int wave, int lane, const Epi& epi) {
  for (int rep = 0; rep < SK_REPEAT; ++rep) {
    asm volatile("" ::: "memory");
    const int r = lane & 31, h = lane >> 5; constexpr int kw = K / 8;
    const bf16_t* ap = A + (size_t)r * K + wave * kw + h * 8;
    const bf16_t* b0 = B0 + (size_t)r * (K + 64) + wave * kw + h * 8;
    const bf16_t* b1 = (NBLK == 2 ? B1 : B0) + (size_t)r * (K + 64) + wave * kw + h * 8;
    f32x16 acc0, acc1;
#pragma unroll
    for (int q = 0; q < 16; ++q) { acc0[q] = 0.f; acc1[q] = 0.f; }
#pragma unroll (K == 2048 ? 16 : 11)
    for (int k = 0; k < kw; k += 16) { const bf16x8 a = *(const bf16x8*)(ap + k);
        acc0 = MFMA32(*(const bf16x8*)(b0 + k), a, acc0);
        if (NBLK == 2) acc1 = MFMA32(*(const bf16x8*)(b1 + k), a, acc1); }
    LAS float* red = (LAS float*)lds;
#pragma unroll
    for (int q = 0; q < 16; ++q) { red[((wave * 2 + 0) * 16 + q) * 64 + lane] = acc0[q]; if (NBLK == 2) red[((wave * 2 + 1) * 16 + q) * 64 + lane] = acc1[q]; }
    __syncthreads();
    if (wave == 0) {
#pragma unroll
        for (int q = 0; q < 16; ++q) { float s0 = 0.f, s1 = 0.f;
#pragma unroll
            for (int w = 0; w < 8; ++w) { s0 += red[((w * 2 + 0) * 16 + q) * 64 + lane]; if (NBLK == 2) s1 += red[((w * 2 + 1) * 16 + q) * 64 + lane]; }
            acc0[q] = s0; acc1[q] = s1; }
        if (rep == SK_REPEAT - 1) epi(acc0, acc1, lane);
    }
    __syncthreads();
  }
}
struct SkIn {
    int item; float *qS, *kS, *vS, *uS, *gS; const float* ropeS;
    DI void operator()(const f32x16& acc, const f32x16&, int lane) const {
        const int s = lane & 31, h = lane >> 5, p0 = item * 32, pn = p0 >> 8, bj = (p0 >> 7) & 1, wc = (p0 >> 5) & 3;
        if (pn <= 4) {
#pragma unroll
            for (int q = 0; q < 8; ++q) { const int fq = 2 * ((q >> 2) & 1) + h, e = q & 3, dh = 16 * (wc & 1) + 4 * fq + e;
                const float cs = ropeS[dh], sn = ropeS[32 + dh], x1 = acc[q], x2 = acc[q + 8], o1 = x1 * cs - x2 * sn, o2 = x2 * cs + x1 * sn;
                const int hc = 128 * bj + 64 * (wc >> 1) + dh;
                if (pn < 4) { qS[s * 1024 + pn * 256 + hc] = o1; qS[s * 1024 + pn * 256 + hc + 32] = o2; } else { kS[s * 256 + hc] = o1; kS[s * 256 + hc + 32] = o2; } }
        } else if (pn < 10) {
#pragma unroll
            for (int q = 0; q < 16; ++q) { const int n = q >> 3, fq = 2 * ((q >> 2) & 1) + h, e = q & 3, L = p0 + 8 * fq + 4 * n + e;
                if (pn == 5) vS[s * 256 + L - 1280] = acc[q]; else uS[s * 1024 + L - 1536] = gelu_tanh(acc[q]); }
        } else {
#pragma unroll
            for (int q = 0; q < 16; ++q) { const int L = p0 + (q & 3) + 8 * (q >> 2) + 4 * h; gS[s * 1024 + L - 2560] = gelu_tanh(acc[q]); }
        }
    }
};
struct SkRes {
    int item; const float* base; float* out; const float* gate;
    DI void operator()(const f32x16& acc, const f32x16&, int lane) const {
        const int s = lane & 31, h = lane >> 5;
#pragma unroll
        for (int q = 0; q < 16; ++q) { const int n = q >> 3, fq = 2 * ((q >> 2) & 1) + h, e = q & 3, col = item * 32 + 8 * fq + 4 * n + e;
            out[s * D + col] = base[s * D + col] + gate[(size_t)(NB + s) * 6 * D + col] * acc[q]; }
    }
};
struct SkGU {
    int item, l; const float *sconv, *cw, *cb; bf16_t* act; float* cvs;
    DI void operator()(const f32x16& ga, const f32x16& up, int lane) const {
        const int s = lane & 31, h = lane >> 5, pn = item >> 2, wc = item & 3;
#pragma unroll
        for (int q = 0; q < 16; ++q) { const int n = q >> 3, fq = 2 * ((q >> 2) & 1) + h, e = q & 3, f = 128 * pn + 32 * wc + 8 * fq + 4 * n + e;
            const float p0 = sconv[((size_t)(l * NS + s) * 2 + 0) * DFF + f], p1 = sconv[((size_t)(l * NS + s) * 2 + 1) * DFF + f], a = ga[q];
            const float cv = cb[l * DFF + f] + cw[((size_t)l * 3 + 0) * DFF + f] * p0 + cw[((size_t)l * 3 + 1) * DFF + f] * p1 + cw[((size_t)l * 3 + 2) * DFF + f] * a;
            act[s * DFF + f] = (bf16_t)f2bf(silu_f(cv) * up[q]);
            cvs[((size_t)(l * NS + s) * 2 + 0) * DFF + f] = p1; cvs[((size_t)(l * NS + s) * 2 + 1) * DFF + f] = a; }
    }
};

#ifndef MULTI
#define MULTI 0
#endif
constexpr int NPHASE = 18;
__global__ void __launch_bounds__(512, 2) fwd(Args a) {
    extern __shared__ __attribute__((aligned(16))) unsigned char lds_raw[];
    LAS unsigned char* lds = (LAS unsigned char*)lds_raw;
    cg::grid_group grid = cg::this_grid();
    const int wave0 = __builtin_amdgcn_readfirstlane(threadIdx.x >> 6);
    P p;
    p.xp = a.in[0]; p.xs = a.in[1]; p.ck = a.in[2]; p.cv = a.in[3]; p.sconv = a.in[4]; p.cp = a.in[5]; p.cs = a.in[6]; p.wada = a.in[7]; p.bada = a.in[8];
    p.g1 = a.in[9]; p.g2 = a.in[10]; p.win = a.in[11]; p.gmgain = a.in[12]; p.gmws = a.in[13]; p.gmbs = a.in[14]; p.sinks = a.in[15]; p.wout = a.in[16];
    p.wgate = a.in[17]; p.wup = a.in[18]; p.convw = a.in[19]; p.convb = a.in[20]; p.wdown = a.in[21]; p.gfinal = a.in[22]; p.out = a.out; p.ws = a.ws;
    const int lo = a.ph_lo, hi = a.ph_hi;
    volatile LAS unsigned* xst = (volatile LAS unsigned*)(lds + 147456);
    if (threadIdx.x < 2) xst[threadIdx.x] = 0u;
    __syncthreads();
    const XcdBarrier xbar = xcd_barrier_post((unsigned*)(a.ws + WS_BAR), xst);
#define IN(k) (lo <= (k) && (k) < hi)
#define FRESH() int wv_f = wave0; asm volatile("" : "+s"(wv_f)); int tid_f = wv_f * 64 + (int)__builtin_amdgcn_mbcnt_hi(~0u, __builtin_amdgcn_mbcnt_lo(~0u, 0u)); asm volatile("" : "+v"(tid_f)); const int tid = tid_f, lane = tid & 63, wave = __builtin_amdgcn_readfirstlane(tid >> 6); (void)lane; (void)wave
#ifndef PROBE_MASK
#define PROBE_MASK 0
#endif
#ifndef PROBE_CLK
#define PROBE_CLK 0
#endif
#ifndef PROBE_MUL
#define PROBE_MUL 2
#endif
    unsigned long long pr_acc = 0, pr_t0 = 0, pr_c0 = 0, pr_cacc = 0; (void)pr_c0; (void)pr_cacc;
#define PR_BEGIN(k) do { if (PROBE_MASK & (1u << (k))) { pr_t0 = __builtin_amdgcn_s_memrealtime(); pr_c0 = __builtin_readcyclecounter(); } } while (0)
#define SEAM(k) do { if (IN(k) && IN((k) + 1)) { if (hi > 1000) grid.sync(); else xcd_barrier(xbar); } if (PROBE_MASK & (1u << (k))) { pr_acc += __builtin_amdgcn_s_memrealtime() - pr_t0; pr_cacc += __builtin_readcyclecounter() - pr_c0; } } while (0)
    unsigned char* ws = a.ws;
    bf16_t* XN = (bf16_t*)(ws + WS_XN); bf16_t* XR = (bf16_t*)(ws + WS_XR); float* XS = (float*)(ws + WS_SMP + SM_XS);
    bf16_t* HS = (bf16_t*)(ws + WS_SMP + SM_HS); bf16_t* MIXS = (bf16_t*)(ws + WS_SMP + SM_MIX); bf16_t* ACTS = (bf16_t*)(ws + WS_SMP + SM_ACT);
    const float* MOD = (const float*)(ws + WS_MOD);

    PR_BEGIN(0);
    if (IN(0)) { FRESH(); phaseA(p, lds, tid, wave, lane); }
    SEAM(0);
    for (int l = 0; l < DEPTH; ++l) {
        const int pb = 1 + 8 * l;
        const bf16_t* Win = (const bf16_t*)(ws + WS_WIN + l * SZ_WIN); const bf16_t* Wout = (const bf16_t*)(ws + WS_WOUT + l * SZ_WOUT);
        const bf16_t* Wgu = (const bf16_t*)(ws + WS_WGU + l * SZ_WGU); const bf16_t* Wdn = (const bf16_t*)(ws + WS_WDN + l * SZ_WDN);
        const float* modl = MOD + (size_t)l * NMODROWS * 6 * D;
        PR_BEGIN(pb + 0);
        if (IN(pb + 0)) { FRESH(); phase_norm(p, l, 0, wave, lane); }
        SEAM(pb + 0);
        PR_BEGIN(pb + 1);
        if (IN(pb + 1)) {
            pg8::Gemm g{XN, Win, M, INC, D}; pg8::StaticOrder S; S.init(M, INC, gridDim.x, blockIdx.x);
            EpiIn E{(bf16_t*)(ws + WS_Q), (bf16_t*)(ws + WS_K), (bf16_t*)(ws + WS_V), (bf16_t*)(ws + WS_U), (bf16_t*)(ws + WS_GT), (float*)(ws + WS_SSQ) + l * M, (const float*)(ws + WS_ROPE),
                    p.out + O_KWP + (size_t)l * NB * WIN * KVW, p.out + O_VWP + (size_t)l * NB * WIN * KVW, p.out + O_GMP + (size_t)l * NB * 128 * GMW, lds + 131072};
            pg8::gemm_phase<EpiIn, pg8::StaticOrder>(lds, g, S, E, nullptr, wave0); FRESH();
            for (int item = (int)blockIdx.x - 192; item >= 0 && item < INC / 32; item += 64) {
                SkIn e{item, (float*)(ws + WS_SMP + SM_Q), (float*)(ws + WS_SMP + SM_KK), (float*)(ws + WS_SMP + SM_VV), (float*)(ws + WS_SMP + SM_UU), (float*)(ws + WS_SMP + SM_GG), (const float*)(ws + WS_ROPE) + 2 * 2048 * 32};
                skinny<1, D>(lds, HS, Win + (size_t)item * 32 * LDD, nullptr, wave, lane, e); }
        }
        SEAM(pb + 1);
        PR_BEGIN(pb + 2);
        if (IN(pb + 2)) { FRESH();
#ifndef REP_ATT
#define REP_ATT 1
#endif
#ifndef REP_GM
#define REP_GM 1
#endif
            for (int rep = 0; rep < REP_ATT; ++rep) { asm volatile("" ::: "memory"); for (int u = blockIdx.x; u < NB * 16 * NKV; u += gridDim.x) attn_unit(p, l, u, lds, tid, wave, lane); }
            for (int rep = 0; rep < REP_GM; ++rep) { asm volatile("" ::: "memory"); for (int u = blockIdx.x; u < NB * 16 * 8; u += gridDim.x) gmlp_unit(p, l, u, wave, lane); }
            for (int it = (int)gridDim.x - 1 - (int)blockIdx.x; it < NS * 8; it += gridDim.x) sample_part(p, l, it >> 3, it & 7, lds, tid, wave, lane);
            gmv_fix(p, l, tid);
        }
        SEAM(pb + 2);
        PR_BEGIN(pb + 3);
        if (IN(pb + 3)) {
            pg8::Gemm g{(const bf16_t*)(ws + WS_MIX), Wout, M, D, D}; pg8::StaticOrder S; S.init(M, D, gridDim.x, blockIdx.x);
            if (l == 0) { EpiRes<true> E{p.xp, XR, modl + 2 * D}; pg8::gemm_phase<EpiRes<true>, pg8::StaticOrder>(lds, g, S, E, nullptr, wave0); }
            else { EpiRes<false> E{nullptr, XR, modl + 2 * D}; pg8::gemm_phase<EpiRes<false>, pg8::StaticOrder>(lds, g, S, E, nullptr, wave0); }
            FRESH();
            for (int item = (int)gridDim.x - 1 - (int)blockIdx.x; item < D / 32; item += gridDim.x) {
                SkRes e{item, l == 0 ? p.xs : XS, XS, modl + 2 * D};
                skinny<1, D>(lds, MIXS, Wout + (size_t)item * 32 * LDD, nullptr, wave, lane, e); }
        }
        SEAM(pb + 3);
        PR_BEGIN(pb + 4);
        if (IN(pb + 4)) { FRESH(); phase_norm(p, l, 1, wave, lane); }
        SEAM(pb + 4);
        PR_BEGIN(pb + 5);
        if (IN(pb + 5)) {
            pg8::Gemm g{XN, Wgu, M, 2 * DFF, D}; pg8::StaticOrder S; S.init(M, 2 * DFF, gridDim.x, blockIdx.x);
            EpiGU E{(bf16_t*)(ws + WS_UP), (float*)(ws + WS_GA), (float*)(ws + WS_GA) + (size_t)128 * 4 * DFF, p.out + O_CVP + (size_t)l * NB * 2 * DFF, p.convw + (size_t)l * 3 * DFF, p.convb + (size_t)l * DFF};
            pg8::gemm_phase<EpiGU, pg8::StaticOrder>(lds, g, S, E, nullptr, wave0);
#if defined(PROBE_GU_EXTRA)
            if (l == 1) { for (int rep = 0; rep < PROBE_GU_EXTRA; ++rep) { grid.sync(); EpiNull EN{(float*)(ws + WS_SSQ)}; pg8::gemm_phase<EpiNull, pg8::StaticOrder>(lds, g, S, EN, nullptr, wave0); } }
#endif
            FRESH();
            for (int item = (int)blockIdx.x - 128; item >= 0 && item < DFF / 32; item += 128) {
                SkGU e{item, l, p.sconv, p.convw, p.convb, ACTS, p.out + O_CVS};
                const bf16_t* b0 = Wgu + (size_t)(256 * (item >> 2) + 32 * (item & 3)) * LDD;
                skinny<2, D>(lds, HS, b0, b0 + (size_t)128 * LDD, wave, lane, e); }
        }
        SEAM(pb + 5);
        PR_BEGIN(pb + 6);
        if (IN(pb + 6)) { FRESH(); phase_fix(p, l, tid); }
        SEAM(pb + 6);
        PR_BEGIN(pb + 7);
        if (IN(pb + 7)) {
            pg8::Gemm g{(const bf16_t*)(ws + WS_UP), Wdn, M, D, DFF}; pg8::StaticOrder S; S.init(M, D, gridDim.x, blockIdx.x);
            EpiRes<false> E{nullptr, XR, modl + 5 * D};
            pg8::gemm_phase<EpiRes<false>, pg8::StaticOrder>(lds, g, S, E, nullptr, wave0); FRESH();
            for (int item = (int)gridDim.x - 1 - (int)blockIdx.x; item < D / 32; item += gridDim.x) {
                SkRes e{item, XS, XS, modl + 5 * D};
                skinny<1, DFF>(lds, ACTS, Wdn + (size_t)item * 32 * LDF, nullptr, wave, lane, e); }
        }
        SEAM(pb + 7);
    }
    if (IN(17)) { FRESH(); phase_norm(p, 0, 2, wave, lane); }
    if (PROBE_MASK) { grid.sync(); if (blockIdx.x == 0) { const unsigned long long t0 = __builtin_amdgcn_s_memrealtime(); const unsigned long long spin = PROBE_CLK ? (pr_cacc * 1000ull / (pr_acc ? pr_acc : 1ull)) : (unsigned long long)PROBE_MUL * pr_acc;
        while (__builtin_amdgcn_s_memrealtime() - t0 < spin) __builtin_amdgcn_s_sleep(8); } }
}

extern "C" void kernel_launch(void* const* d_in, const int* in_sizes, int n_in, void* d_out, int out_size, void* d_ws, size_t ws_size, hipStream_t stream) {
    static int grid = 0;
    if (grid == 0) {
        if (n_in != 23 || (size_t)out_size != O_END || ws_size < WS_END) { fprintf(stderr, "kernel_launch: unexpected shapes: n_in %d out %d (want %zu) ws %zu (want %zu)\n", n_in, out_size, (size_t)O_END, ws_size, (size_t)WS_END); grid = -1; return; }
        int dev = 0, cus = 0, per = 0;
        (void)hipGetDevice(&dev); (void)hipDeviceGetAttribute(&cus, hipDeviceAttributeMultiprocessorCount, dev);
        if (hipFuncSetAttribute((const void*)fwd, hipFuncAttributeMaxDynamicSharedMemorySize, LDS_BYTES) != hipSuccess) { fprintf(stderr, "kernel_launch: hipFuncSetAttribute failed\n"); grid = -1; return; }
        (void)hipOccupancyMaxActiveBlocksPerMultiprocessor(&per, (const void*)fwd, 512, LDS_BYTES);
        if (per < 1) { fprintf(stderr, "kernel_launch: occupancy query says %d blocks per CU\n", per); per = 1; }
        grid = cus * 1;
        fprintf(stderr, "kernel_launch: grid %d (cus %d, per-cu %d)\n", grid, cus, per);
    }
    if (grid < 0) return;
    Args a{};
    for (int i = 0; i < 23; ++i) a.in[i] = (const float*)d_in[i];
    a.out = (float*)d_out; a.ws = (unsigned char*)d_ws;
    if (hipMemsetAsync((char*)d_ws + WS_BAR, 0, 65536, stream) != hipSuccess) { fprintf(stderr, "kernel_launch: memset of barrier words failed\n"); return; }
#if MULTI
    for (int k = 0; k < NPHASE; ++k) { a.ph_lo = k; a.ph_hi = k + 1; hipLaunchKernelGGL(fwd, dim3(grid), dim3(512), LDS_BYTES, stream, a); }
#else
    a.ph_lo = 0; a.ph_hi = NPHASE;
    void* args[] = {&a};
    hipError_t e = hipLaunchCooperativeKernel((void*)fwd, dim3(grid), dim3(512), args, LDS_BYTES, stream);
    if (e != hipSuccess) fprintf(stderr, "kernel_launch: cooperative launch failed: %s (grid %d)\n", hipGetErrorString(e), grid);
#endif
}
```

```cpp
#include <hip/hip_runtime.h>
#include <hip/hip_cooperative_groups.h>
#include <cstdio>
namespace cg = cooperative_groups;
namespace pg8 {
#define PG8_LAS __attribute__((address_space(3)))
typedef unsigned short bf16_t;
typedef short bf16x8 __attribute__((ext_vector_type(8)));
typedef float f32x4 __attribute__((ext_vector_type(4)));
typedef unsigned u32x4 __attribute__((ext_vector_type(4)));
constexpr int BM = 256, BK = 64, HALF = 128, HTB = HALF * BK * 2  , STAGE_BYTES = 8 * HTB, NXCD = 8, WGM = 8;

__host__ __device__ __forceinline__ int lds_byte(int r, int c) { const int st = (r >> 4) * 2 + (c >> 5), rr = r & 15, cc = c & 31, ob = rr * 64 + cc * 2; return st * 1024 + (ob ^ (((ob >> 9) & 1) << 5)); }
__host__ __device__ __forceinline__ void stage_rc(int b, int& R, int& C) { const int st = b / 1024, sb = b % 1024, swz = sb ^ (((sb >> 9) & 1) << 5); R = (st >> 1) * 16 + swz / 64; C = (st & 1) * 32 + (swz % 64) / 2; }
__host__ __device__ __forceinline__ int perm32(int rho) { const int n = rho >> 4, i = rho & 15; return 8 * (i >> 2) + 4 * n + (i & 3); }

struct Unit { int pm, pn; };
struct Gemm { const bf16_t* A; const bf16_t* Bt; int M, N, K; };

struct StaticOrder {
    int nM, nN, nwg, G, c;
    __host__ __device__ void init(int M, int N, int G_, int c_) { nM = M / BM; nN = N / BM; nwg = nM * nN; G = G_; c = c_; }
    __host__ __device__ bool next(int i, Unit& u) const {
        const long L = (long)i * G + c; if (L >= nwg) return false;
        int wgid = (int)L; { const int q = nwg / NXCD, r = nwg % NXCD, xcd = wgid % NXCD, off = wgid / NXCD; wgid = (xcd < r ? xcd * (q + 1) : r * (q + 1) + (xcd - r) * q) + off; }
        const int nig = WGM * nN, gid = wgid / nig, fm = gid * WGM, gsz = (nM - fm) < WGM ? (nM - fm) : WGM;
        u.pm = fm + ((wgid % nig) % gsz); u.pn = (wgid % nig) / gsz; return true;
    }
    __device__ __forceinline__ void a_ready(const Unit&) const {}
    __device__ __forceinline__ void done(const Unit&) const {}
};
__device__ __forceinline__ unsigned cvt_pk_bf16(float lo, float hi) { unsigned r; asm volatile("v_cvt_pk_bf16_f32 %0, %1, %2" : "=v"(r) : "v"(lo), "v"(hi)); return r; }
template <class Epi, class Sched, bool STAMP = false>
__device__ __forceinline__ void gemm_phase(PG8_LAS unsigned char* lds, const Gemm g, const Sched& S, const Epi& E, unsigned long long* stamps, int wave_in) {
    int wv_l = wave_in; asm volatile("" : "+s"(wv_l)); int tid_l = wv_l * 64 + (int)__builtin_amdgcn_mbcnt_hi(~0u, __builtin_amdgcn_mbcnt_lo(~0u, 0u)); asm volatile("" : "+v"(tid_l)); const int tid = tid_l, wid = __builtin_amdgcn_readfirstlane(tid >> 6), lane = tid & 63, wr = wid >> 2, wc = wid & 3, fr = lane & 15, fq = lane >> 4;
    const int K = g.K, nt = K / BK, LD = K + 64;
    int ts_lo = 0, ts_hi = 0, nts = 0; const unsigned long long rt_entry = STAMP ? (unsigned long long)wall_clock64() : 0ull;
#define PG8_STAMP() do { if (STAMP && wid == 0 && nts < 64) { const unsigned long long _c = (unsigned long long)clock64(); \
        ts_lo = (lane == nts) ? (int)(unsigned)_c : ts_lo; ts_hi = (lane == nts) ? (int)(unsigned)(_c >> 32) : ts_hi; ++nts; } } while (0)
    PG8_STAMP();
    unsigned voffA[2], voffB[2];
#pragma unroll
    for (int i = 0; i < 2; ++i) { int R, C; stage_rc(tid * 16 + i * 8192, R, C); const int Rb = Epi::PERM ? ((R & ~31) + perm32(R & 31)) : R;
        voffA[i] = (unsigned)(R * LD + C) * 2u; voffB[i] = (unsigned)(Rb * LD + C) * 2u; }
    const size_t kstep = (size_t)(BK * 2);
    const size_t hstep = (size_t)HALF * LD * 2;
    const size_t tstep = 2 * hstep;
    const unsigned ldsw = (unsigned)wid * 1024u;
    const int aoff = lds_byte(wr * 64 + fr, fq * 8), boff = lds_byte(wc * 32 + fr, fq * 8);
#define PG8_SA(b, h) (((b) * 2 + (h)) * HTB)
#define PG8_SB(b, h) ((4 + (b) * 2 + (h)) * HTB)
#define PG8_STAGE(bufoff, gbase, voff) do { _Pragma("unroll") for (int _i = 0; _i < 2; ++_i) \
        __builtin_amdgcn_global_load_lds((const unsigned*)((const char*)(gbase) + (voff)[_i]), (PG8_LAS unsigned*)(lds + (bufoff) + ldsw + _i * 8192), 16, 0, 0); } while (0)
#define PG8_LDA(dst, b, h) do { _Pragma("unroll") for (int m = 0; m < 4; ++m) _Pragma("unroll") for (int k = 0; k < 2; ++k) dst[m][k] = *(const PG8_LAS bf16x8*)(lds + PG8_SA(b, h) + aoff + m * 2048 + k * 1024); } while (0)
#define PG8_LDB(dst, b, h) do { _Pragma("unroll") for (int n = 0; n < 2; ++n) _Pragma("unroll") for (int k = 0; k < 2; ++k) dst[n][k] = *(const PG8_LAS bf16x8*)(lds + PG8_SB(b, h) + boff + n * 2048 + k * 1024); } while (0)
#define PG8_MMA(ai, bj, At, Bt) do { __builtin_amdgcn_s_setprio(1); _Pragma("unroll") for (int m = 0; m < 4; ++m) _Pragma("unroll") for (int n = 0; n < 2; ++n) _Pragma("unroll") for (int k = 0; k < 2; ++k) \
        acc[ai][bj][m][n] = __builtin_amdgcn_mfma_f32_16x16x32_bf16(Bt[n][k], At[m][k], acc[ai][bj][m][n], 0, 0, 0); __builtin_amdgcn_s_setprio(0); } while (0)
#define PG8_WAIT_V(n) asm volatile("s_waitcnt vmcnt(" #n ")" ::: "memory")
#define PG8_WAIT_L(n) asm volatile("s_waitcnt lgkmcnt(" #n ")" ::: "memory")
#define PG8_BAR __builtin_amdgcn_s_barrier()
#define PG8_SCHED __builtin_amdgcn_sched_barrier(0)
    Unit cur, nxt; int ui = 0;
    if (!S.next(0, cur)) return;
    f32x4 acc[2][2][4][2];
#pragma unroll
    for (int a = 0; a < 2; ++a)
#pragma unroll
        for (int b = 0; b < 2; ++b)
#pragma unroll
            for (int m = 0; m < 4; ++m)
#pragma unroll
                for (int n = 0; n < 2; ++n) acc[a][b][m][n] = (f32x4){0.f, 0.f, 0.f, 0.f};
    bf16x8 At[4][2], B0[2][2], B1[2][2];
    const char* cA = (const char*)g.A + (size_t)cur.pm * tstep; const char* cB = (const char*)g.Bt + (size_t)cur.pn * tstep;
    S.a_ready(cur);
    PG8_STAGE(PG8_SB(0, 0), cB, voffB); PG8_STAGE(PG8_SA(0, 0), cA, voffA); PG8_STAGE(PG8_SB(0, 1), cB + hstep, voffB); PG8_STAGE(PG8_SA(0, 1), cA + hstep, voffA);
    if (wr == 1) PG8_BAR;
    PG8_WAIT_V(4); PG8_BAR;
    PG8_STAGE(PG8_SB(1, 0), cB + kstep, voffB); PG8_STAGE(PG8_SA(1, 0), cA + kstep, voffA); PG8_STAGE(PG8_SB(1, 1), cB + hstep + kstep, voffB);
    PG8_WAIT_V(6); PG8_BAR;
    PG8_STAMP();
    for (;;) {
        const bool has_next = S.next(ui + 1, nxt);
        const char* nA = has_next ? (const char*)g.A + (size_t)nxt.pm * tstep : cA; const char* nB = has_next ? (const char*)g.Bt + (size_t)nxt.pn * tstep : cB;
        for (int t = 0; t < nt; t += 2) {
            const bool last = (t == nt - 2);
            const char* a1 = cA + (size_t)(t + 1) * kstep;
            const char* a2 = last ? nA : cA + (size_t)(t + 2) * kstep; const char* b2 = last ? nB : cB + (size_t)(t + 2) * kstep;
            const char* a3 = a2 + kstep; const char* b3 = b2 + kstep;
            if (last && has_next) S.a_ready(nxt);
            PG8_LDB(B0, 0, 0); PG8_SCHED; PG8_LDA(At, 0, 0); PG8_STAGE(PG8_SA(1, 1), a1 + hstep, voffA);
            PG8_WAIT_L(8); PG8_BAR; PG8_WAIT_L(0); PG8_MMA(0, 0, At, B0); PG8_BAR; PG8_SCHED;
            PG8_LDB(B1, 0, 1); PG8_STAGE(PG8_SB(0, 0), b2, voffB);
            PG8_BAR; PG8_WAIT_L(0); PG8_MMA(0, 1, At, B1); PG8_BAR;
            PG8_LDA(At, 0, 1); PG8_STAGE(PG8_SA(0, 0), a2, voffA);
            PG8_BAR; PG8_WAIT_L(0); PG8_MMA(1, 0, At, B0); PG8_BAR; PG8_SCHED;
            PG8_STAGE(PG8_SB(0, 1), b2 + hstep, voffB);
            PG8_WAIT_V(6); PG8_BAR; PG8_MMA(1, 1, At, B1); PG8_BAR;
            PG8_LDB(B0, 1, 0); PG8_SCHED; PG8_LDA(At, 1, 0); PG8_STAGE(PG8_SA(0, 1), a2 + hstep, voffA);
            PG8_WAIT_L(8); PG8_BAR; PG8_WAIT_L(0); PG8_MMA(0, 0, At, B0); PG8_BAR; PG8_SCHED;
            PG8_LDB(B1, 1, 1); PG8_STAGE(PG8_SB(1, 0), b3, voffB);
            PG8_BAR; PG8_WAIT_L(0); PG8_MMA(0, 1, At, B1); PG8_BAR;
            PG8_LDA(At, 1, 1); PG8_STAGE(PG8_SA(1, 0), a3, voffA);
            PG8_BAR; PG8_WAIT_L(0); PG8_MMA(1, 0, At, B0); PG8_BAR; PG8_SCHED;
            PG8_STAGE(PG8_SB(1, 1), b3 + hstep, voffB);
            PG8_WAIT_V(6); PG8_BAR; PG8_MMA(1, 1, At, B1); PG8_BAR;
        }
        PG8_STAMP();
        if constexpr (!Epi::AFTER_DRAIN) { E(acc, cur, wr, wc, fr, fq); S.done(cur); }
        PG8_STAMP();
        if (!has_next) break;
#pragma unroll
        for (int a = 0; a < 2; ++a)
#pragma unroll
            for (int b = 0; b < 2; ++b)
#pragma unroll
                for (int m = 0; m < 4; ++m)
#pragma unroll
                    for (int n = 0; n < 2; ++n) acc[a][b][m][n] = (f32x4){0.f, 0.f, 0.f, 0.f};
        cur = nxt; cA = nA; cB = nB; ++ui;
    }
    PG8_WAIT_V(0);
    if (wr == 0) PG8_BAR;
    PG8_BAR;
    if constexpr (Epi::AFTER_DRAIN) { E.fused(acc, cur, wr, wc, fr, fq, lds, wid, lane); S.done(cur); }
    PG8_STAMP();
    if (STAMP && wid == 0) { stamps[lane] = lane < nts ? (((unsigned long long)(unsigned)ts_hi << 32) | (unsigned)ts_lo) : 0ull;
        if (lane == 62) stamps[62] = rt_entry; if (lane == 63) stamps[63] = (unsigned long long)wall_clock64(); }
#undef PG8_STAMP
#undef PG8_SA
#undef PG8_SB
#undef PG8_STAGE
#undef PG8_LDA
#undef PG8_LDB
#undef PG8_MMA
#undef PG8_WAIT_V
#undef PG8_WAIT_L
#undef PG8_BAR
#undef PG8_SCHED
}
}
using pg8::bf16_t; using pg8::bf16x8; using pg8::f32x4; using pg8::u32x4;
typedef float f32x16 __attribute__((ext_vector_type(16)));
typedef float f32x2 __attribute__((ext_vector_type(2)));
typedef unsigned u32x2 __attribute__((ext_vector_type(2)));
#define LAS __attribute__((address_space(3)))
#define DI __device__ __forceinline__

constexpr int D = 2048, SEQ = 2048, NB = 4, M = NB * SEQ, NS = 32, DEPTH = 2;
constexpr int INC = 3584, DFF = 5632, WIN = 128, NH = 16, NKV = 4, HD = 64, GMW = 1024, KVW = 256, AW = 1024;
constexpr int PAST = 16384;
constexpr float EPS = 1e-6f;
constexpr int NMODROWS = NB + NS;
#define G ((int)gridDim.x)

constexpr size_t O_YP = 0;
constexpr size_t O_YS = O_YP + (size_t)M * D;
constexpr size_t O_KWP = O_YS + (size_t)NS * D;
constexpr size_t O_VWP = O_KWP + (size_t)DEPTH * NB * WIN * KVW;
constexpr size_t O_GMP = O_VWP + (size_t)DEPTH * NB * WIN * KVW;
constexpr size_t O_CVP = O_GMP + (size_t)DEPTH * NB * 128 * GMW;
constexpr size_t O_KWS = O_CVP + (size_t)DEPTH * NB * 2 * DFF;
constexpr size_t O_VWS = O_KWS + (size_t)DEPTH * NS * WIN * KVW;
constexpr size_t O_GMS = O_VWS + (size_t)DEPTH * NS * WIN * KVW;
constexpr size_t O_CVS = O_GMS + (size_t)DEPTH * NS * GMW;
constexpr size_t O_END = O_CVS + (size_t)DEPTH * NS * 2 * DFF;

constexpr size_t MiB = 1u << 20;
constexpr int LDD = D + 64, LDF = DFF + 64;
constexpr size_t SZ_WIN = 15 * MiB, SZ_WOUT = 9 * MiB, SZ_WGU = 46 * MiB, SZ_WDN = 23 * MiB;
constexpr size_t WS_WIN = 0;
constexpr size_t WS_WOUT = WS_WIN + 2 * SZ_WIN;
constexpr size_t WS_WGU = WS_WOUT + 2 * SZ_WOUT;
constexpr size_t WS_WDN = WS_WGU + 2 * SZ_WGU;
constexpr size_t WS_XN = WS_WDN + 2 * SZ_WDN;
constexpr size_t WS_Q = WS_XN + 34 * MiB;
constexpr size_t WS_K = WS_Q + 16 * MiB;
constexpr size_t WS_V = WS_K + 4 * MiB;
constexpr size_t WS_U = WS_V + 4 * MiB;
constexpr size_t WS_GT = WS_U + 16 * MiB;
constexpr size_t WS_MIX = WS_GT + 16 * MiB;
constexpr size_t WS_XR = WS_MIX + 34 * MiB;
constexpr size_t WS_GA = WS_XR + 64 * MiB;
constexpr size_t WS_UP = WS_GA + 88 * MiB;
constexpr size_t WS_MOD = WS_UP + 90 * MiB;
constexpr size_t WS_ROPE = WS_MOD + 4 * MiB;
constexpr size_t WS_SSQ = WS_ROPE + 1 * MiB;
constexpr size_t WS_SMP = WS_SSQ + 1 * MiB;
constexpr size_t WS_BAR = WS_SMP + 4 * MiB;
constexpr size_t WS_END = WS_BAR + 1 * MiB;
constexpr size_t SM_XS = 0;
constexpr size_t SM_HS = SM_XS + 32 * 2048 * 4;
constexpr size_t SM_Q = SM_HS + 32 * 2048 * 2;
constexpr size_t SM_KK = SM_Q + 32 * 1024 * 4;
constexpr size_t SM_VV = SM_KK + 32 * 256 * 4;
constexpr size_t SM_UU = SM_VV + 32 * 256 * 4;
constexpr size_t SM_GG = SM_UU + 32 * 1024 * 4;
constexpr size_t SM_MIX = SM_GG + 32 * 1024 * 4;
constexpr size_t SM_ACT = SM_MIX + 32 * 2048 * 2;
constexpr size_t SM_END = SM_ACT + 32 * 5632 * 2;
static_assert(SM_END <= 4 * MiB, "sample buffers");

constexpr int LDS_BYTES = 148480;

struct Args {
    const float* in[23];
    float* out;
    unsigned char* ws;
    int ph_lo, ph_hi;
};

DI unsigned f2bf(float f) { unsigned u = __builtin_bit_cast(unsigned, f); return (u + 0x7fffu + ((u >> 16) & 1u)) >> 16; }
DI unsigned pk2(float lo, float hi) { return pg8::cvt_pk_bf16(lo, hi); }
DI float bf2f(unsigned short b) { return __builtin_bit_cast(float, ((unsigned)b) << 16); }
DI float bflo(unsigned w) { return __builtin_bit_cast(float, w << 16); }
DI float bfhi(unsigned w) { return __builtin_bit_cast(float, w & 0xffff0000u); }
DI float wave_sum(float v) {
#pragma unroll
    for (int o = 1; o < 64; o <<= 1) v += __shfl_xor(v, o);
    return v;
}
DI float gelu_tanh(float x) {
    const float u = 0.7978845608028654f * (x + 0.044715f * x * x * x);
    return x * __builtin_amdgcn_rcpf(1.0f + __expf(-2.0f * u));
}
DI float silu_f(float x) { return x * __builtin_amdgcn_rcpf(1.0f + __expf(-x)); }

DI int pair8_phys(int r32) { const int fq = r32 >> 3, n = (r32 >> 2) & 1, e = r32 & 3; return 16 * n + 4 * fq + e; }
DI int win_phys(int L) {
    if (L < 1280) { const int h2 = L >> 7, r = L & 127, hd = r >> 6, d = r & 63, n = d >> 5, d5 = d & 31, wcl = d5 >> 4, fq = (d5 >> 2) & 3, e = d5 & 3;
        return 128 * h2 + 32 * (2 * hd + wcl) + 16 * n + 4 * fq + e; }
    if (L < 2560) return (L & ~31) + pair8_phys(L & 31);
    return L;
}

struct ConvDesc { const float* W; bf16_t* WT; int K, N, type, item; };
DI int conv_phys(int type, int L) {
    if (type == 0) return win_phys(L);
    if (type == 1) return (L & ~31) + pair8_phys(L & 31);
    return 256 * (L >> 7) + (type == 3 ? 128 : 0) + (L & 96) + pair8_phys(L & 31);
}
DI void conv_load(const ConvDesc& d, int lane, f32x4 (&v)[8]) {
    const int nblk = d.N / 32, kb = d.item / nblk, nb = d.item % nblk, k0 = 64 * kb, n0 = 32 * nb;
#pragma unroll
    for (int i = 0; i < 8; ++i) { const int kk = 8 * i + (lane >> 3); v[i] = *(const f32x4*)(d.W + (size_t)(k0 + kk) * d.N + n0 + 4 * (lane & 7)); }
}
DI void conv_store(const ConvDesc& d, int lane, const f32x4 (&v)[8], LAS float* scr) {
    const int nblk = d.N / 32, kb = d.item / nblk, nb = d.item % nblk, k0 = 64 * kb, n0 = 32 * nb;
#pragma unroll
    for (int i = 0; i < 8; ++i) { const int kk = 8 * i + (lane >> 3); LAS float* s = scr + kk * 33 + 4 * (lane & 7); s[0] = v[i].x; s[1] = v[i].y; s[2] = v[i].z; s[3] = v[i].w; }
    asm volatile("s_waitcnt lgkmcnt(0)" ::: "memory");
    const int c = lane & 7;
#pragma unroll
    for (int j = 0; j < 4; ++j) { const int n = (lane >> 3) + 8 * j; const LAS float* s = scr + (8 * c) * 33 + n;
        u32x4 o; o.x = pk2(s[0 * 33], s[1 * 33]); o.y = pk2(s[2 * 33], s[3 * 33]); o.z = pk2(s[4 * 33], s[5 * 33]); o.w = pk2(s[6 * 33], s[7 * 33]);
        *(u32x4*)(d.WT + (size_t)conv_phys(d.type, n0 + n) * (d.K + 64) + k0 + 8 * c) = o; }
    asm volatile("s_waitcnt lgkmcnt(0)" ::: "memory");
}

struct P {
    const float *xp, *xs, *ck, *cv, *sconv, *cp, *cs, *wada, *bada, *g1, *g2, *win, *gmgain, *gmws, *gmbs, *sinks, *wout, *wgate, *wup, *convw, *convb, *wdown, *gfinal;
    float* out; unsigned char* ws;
};
#define RLX_AGENT __ATOMIC_RELAXED, __HIP_MEMORY_SCOPE_AGENT
#define XB_TMO      128
#define XB_XCNT(j)  (256  + 64 * (j))
#define XB_XSUB(j)  (1280 + 64 * (j))
#define XB_XGEN(j)  (2304 + 64 * (j))
#define XB_TOP      3328
#define XB_TOPGEN   3392
#define XCD_BAR_WORDS 3456
#define XB_SPIN_CAP (1u << 18)

__device__ __forceinline__ unsigned xb_ld(unsigned* p)              { return __hip_atomic_load(p, __ATOMIC_RELAXED, __HIP_MEMORY_SCOPE_AGENT); }
__device__ __forceinline__ unsigned xb_add(unsigned* p, unsigned v) { return __hip_atomic_fetch_add(p, v, __ATOMIC_RELAXED, __HIP_MEMORY_SCOPE_AGENT); }
__device__ __forceinline__ unsigned xb_xcc_id() { return (unsigned)__builtin_amdgcn_s_getreg((3 << 11) | 20) & 0xFu; }
#define XB_SPIN(cond, bar) do { unsigned _sp = 0; while (cond) { __builtin_amdgcn_s_sleep(1); \
    if ((++_sp & 255u) == 0u) { if (xb_ld(&(bar)[XB_TMO])) break; if (_sp > XB_SPIN_CAP) { atomicAdd(&(bar)[XB_TMO], 1u); break; } } } } while (0)

struct XcdBarrier {
    unsigned* bar; unsigned x;
    volatile LAS unsigned* st;
};

__device__ __forceinline__ XcdBarrier xcd_barrier_post(unsigned* bar, volatile LAS unsigned* st) {
    XcdBarrier b; b.bar = bar; b.x = xb_xcc_id(); b.st = st;
    if (threadIdx.x == 0) (void)xb_add(&bar[XB_XCNT(b.x)], 1u);
    return b;
}
__device__ __forceinline__ void xcd_barrier_complete(unsigned* bar, unsigned x, unsigned& nloc, unsigned& nx) {
    const unsigned GG = gridDim.x * gridDim.y * gridDim.z;
    unsigned sum, cnt, mine, sp = 0u;
    for (;;) {
        sum = 0u; cnt = 0u; mine = 0u;
#pragma unroll
        for (unsigned j = 0; j < 16; ++j) { const unsigned c = xb_ld(&bar[XB_XCNT(j)]); sum += c; cnt += (c > 0u) ? 1u : 0u; mine = (j == x) ? c : mine; }
        if (sum == GG) break;
        __builtin_amdgcn_s_sleep(1);
        if ((++sp & 255u) == 0u) { if (xb_ld(&bar[XB_TMO])) break; if (sp > XB_SPIN_CAP) { atomicAdd(&bar[XB_TMO], 1u); break; } }
    }
    nloc = mine > 0u ? mine : 1u; nx = cnt > 0u ? cnt : 1u;
}

__device__ __forceinline__ void xcd_barrier(const XcdBarrier& b) {
    asm volatile("s_waitcnt vmcnt(0)" ::: "memory");
    __syncthreads();
    if (threadIdx.x == 0) {
        unsigned* bar = b.bar;
        __builtin_amdgcn_s_waitcnt(0);
        unsigned nloc = b.st[0], nx = b.st[1];
        if (nloc == 0u) { xcd_barrier_complete(bar, b.x, nloc, nx); b.st[0] = nloc; b.st[1] = nx; }
        const unsigned old = xb_add(&bar[XB_XSUB(b.x)], 1u);
        const unsigned gen = old / nloc;
        if (old + 1u == (gen + 1u) * nloc) {
            __builtin_amdgcn_fence(__ATOMIC_RELEASE, "agent");
            asm volatile("s_waitcnt vmcnt(0)" ::: "memory");
            const unsigned og = xb_add(&bar[XB_TOP], 1u);
            const unsigned tg = og / nx;
            if (og + 1u == (tg + 1u) * nx) xb_add(&bar[XB_TOPGEN], 1u);
            else XB_SPIN(xb_ld(&bar[XB_TOPGEN]) == tg, bar);
            __builtin_amdgcn_fence(__ATOMIC_ACQUIRE, "agent");
            xb_add(&bar[XB_XGEN(b.x)], 1u);
            asm volatile("s_waitcnt vmcnt(0)" ::: "memory");
        } else {
            XB_SPIN(xb_ld(&bar[XB_XGEN(b.x)]) == gen, bar);
            __builtin_amdgcn_fence(__ATOMIC_ACQUIRE, "agent");
            asm volatile("s_waitcnt vmcnt(0)" ::: "memory");
        }
    }
    __syncthreads();
}
DI bf16x8 pack8(const float (&w)[8]) { u32x4 o; o.x = pk2(w[0], w[1]); o.y = pk2(w[2], w[3]); o.z = pk2(w[4], w[5]); o.w = pk2(w[6], w[7]); return __builtin_bit_cast(bf16x8, o); }
DI bf16x8 pack8v(f32x4 a, f32x4 b) { u32x4 o; o.x = pk2(a.x, a.y); o.y = pk2(a.z, a.w); o.z = pk2(b.x, b.y); o.w = pk2(b.z, b.w); return __builtin_bit_cast(bf16x8, o); }
#define MFMA16(a, b, c) __builtin_amdgcn_mfma_f32_16x16x32_bf16((a), (b), (c), 0, 0, 0)
#define MFMA32(a, b, c) __builtin_amdgcn_mfma_f32_32x32x16_bf16((a), (b), (c), 0, 0, 0)

DI void phaseA(const P& p, LAS unsigned char* lds, int tid, int wave, int lane) {
    const int gw = blockIdx.x * 8 + wave, NGW = G * 8;
    { float* ssq = (float*)(p.ws + WS_SSQ); for (int i = blockIdx.x * 512 + tid; i < 2 * M; i += G * 512) ssq[i] = 0.f; }
    { float* rc = (float*)(p.ws + WS_ROPE);
      for (int i = blockIdx.x * 512 + tid; i < 2048 * 32 + 32; i += G * 512) {
          const int pos = i < 2048 * 32 ? (i >> 5) : PAST, j = i & 31;
          const float inv = exp2f(-(float)j * (13.287712379549449f / 32.0f));
          const float ang = (float)pos * inv; float sn, cs; sincosf(ang, &sn, &cs);
          if (i < 2048 * 32) { rc[i] = cs; rc[2048 * 32 + i] = sn; } else { rc[2 * 2048 * 32 + j] = cs; rc[2 * 2048 * 32 + 32 + j] = sn; }
      } }
#ifndef REP_ADA
#define REP_ADA 1
#endif
    for (int rep = 0; rep < REP_ADA; ++rep)
    for (int item = blockIdx.x; item < 2 * 384; item += G) {
        const int l = item / 384, cs = item % 384, h = lane >> 5, r = lane & 31;
        const float* W = p.wada + (size_t)l * D * 6 * D + cs * 32 + r;
        const float* c0 = (r < 4) ? p.cp + r * D : p.cs + (r - 4) * D;
        const float* c1 = p.cs + (28 + (r & 3)) * D;
        f32x16 acc0, acc1;
#pragma unroll
        for (int q = 0; q < 16; ++q) { acc0[q] = 0.f; acc1[q] = 0.f; }
#pragma unroll 4
        for (int ks = 0; ks < 16; ++ks) {
            const int k = wave * 256 + ks * 16 + h * 8;
            float w[8];
#pragma unroll
            for (int j = 0; j < 8; ++j) w[j] = W[(size_t)(k + j) * (6 * D)];
            const bf16x8 bfr = pack8(w);
            f32x4 a0 = *(const f32x4*)(c0 + k), a1 = *(const f32x4*)(c0 + k + 4);
            f32x4 e0 = {0.f, 0.f, 0.f, 0.f}, e1 = e0;
            if (r < 4) { e0 = *(const f32x4*)(c1 + k); e1 = *(const f32x4*)(c1 + k + 4); }
#pragma unroll
            for (int q = 0; q < 4; ++q) { a0[q] = silu_f(a0[q]); a1[q] = silu_f(a1[q]); e0[q] = silu_f(e0[q]); e1[q] = silu_f(e1[q]); }
            acc0 = MFMA32(pack8v(a0, a1), bfr, acc0);
            acc1 = MFMA32(pack8v(e0, e1), bfr, acc1);
        }
        LAS float* red = (LAS float*)lds;
#pragma unroll
        for (int q = 0; q < 16; ++q) { red[((wave * 2 + 0) * 16 + q) * 64 + lane] = acc0[q]; red[((wave * 2 + 1) * 16 + q) * 64 + lane] = acc1[q]; }
        __syncthreads();
        for (int idx = tid; idx < NMODROWS * 32; idx += 512) {
            const int row = idx >> 5, col = idx & 31, mt = row >> 5, rr = row & 31, q = (rr >> 3) * 4 + (rr & 3), ln = ((rr >> 2) & 1) * 32 + col;
            float s = 0.f;
#pragma unroll
            for (int w8 = 0; w8 < 8; ++w8) s += red[((w8 * 2 + mt) * 16 + q) * 64 + ln];
            ((float*)(p.ws + WS_MOD))[((size_t)l * NMODROWS + row) * (6 * D) + cs * 32 + col] = s + p.bada[l * 6 * D + cs * 32 + col];
        }
        __syncthreads();
    }
    LAS float* scr = (LAS float*)(lds + wave * 8448);
    constexpr int I_IN = 32 * 112, I_OUT = 32 * 64, I_G = 32 * 176, I_DN = 88 * 64, I_L = I_IN + I_OUT + 2 * I_G + I_DN;
    auto decode = [&](int it) { ConvDesc d; const int l = it / I_L; int r = it % I_L;
        if (r < I_IN) { d.W = p.win + (size_t)l * D * INC; d.WT = (bf16_t*)(p.ws + WS_WIN + l * SZ_WIN); d.K = D; d.N = INC; d.type = 0; d.item = r; return d; } r -= I_IN;
        if (r < I_OUT) { d.W = p.wout + (size_t)l * D * D; d.WT = (bf16_t*)(p.ws + WS_WOUT + l * SZ_WOUT); d.K = D; d.N = D; d.type = 1; d.item = r; return d; } r -= I_OUT;
        if (r < I_G) { d.W = p.wgate + (size_t)l * D * DFF; d.WT = (bf16_t*)(p.ws + WS_WGU + l * SZ_WGU); d.K = D; d.N = DFF; d.type = 2; d.item = r; return d; } r -= I_G;
        if (r < I_G) { d.W = p.wup + (size_t)l * D * DFF; d.WT = (bf16_t*)(p.ws + WS_WGU + l * SZ_WGU); d.K = D; d.N = DFF; d.type = 3; d.item = r; return d; } r -= I_G;
        d.W = p.wdown + (size_t)l * DFF * D; d.WT = (bf16_t*)(p.ws + WS_WDN + l * SZ_WDN); d.K = DFF; d.N = D; d.type = 1; d.item = r; return d; };
    { int it = gw; ConvDesc d = decode(it < 2 * I_L ? it : 0); f32x4 v[8];
      if (it < 2 * I_L) conv_load(d, lane, v);
      while (it < 2 * I_L) {
          const int nit = it + NGW; ConvDesc nd = decode(nit < 2 * I_L ? nit : 0); f32x4 nv[8];
          if (nit < 2 * I_L) conv_load(nd, lane, nv);
          conv_store(d, lane, v, scr);
          it = nit; d = nd;
#pragma unroll
          for (int i = 0; i < 8; ++i) v[i] = nv[i];
      } }
}

DI void phase_norm(const P& p, int l, int which, int wave, int lane) {
    const int gw = blockIdx.x * 8 + wave, NGW = G * 8;
    const float* mod = (const float*)(p.ws + WS_MOD) + (size_t)l * NMODROWS * 6 * D;
    const float* gvec = which == 0 ? p.g1 + l * D : which == 1 ? p.g2 + l * D : p.gfinal;
    const bool first = (l == 0 && which == 0);
    for (int row = gw; row < M + NS; row += NGW) {
        const float* x; bf16_t* o; float* of; int mrow;
        if (row < M) { x = (first ? p.xp : (const float*)(p.ws + WS_XR)) + (size_t)row * D; o = (bf16_t*)(p.ws + WS_XN) + (size_t)row * LDD; of = p.out + O_YP + (size_t)row * D; mrow = row >> 11; }
        else { const int s = row - M; x = (first ? p.xs : (const float*)(p.ws + WS_SMP + SM_XS)) + (size_t)s * D; o = (bf16_t*)(p.ws + WS_SMP + SM_HS) + (size_t)s * D; of = p.out + O_YS + (size_t)s * D; mrow = NB + s; }
        f32x4 v[8]; float ss = 0.f;
        if (row >= M && first) {
#pragma unroll
            for (int j = 0; j < 8; ++j) ((f32x4*)(p.ws + WS_SMP + SM_XS) + (size_t)(row - M) * (D / 4))[lane + 64 * j] = ((const f32x4*)x)[lane + 64 * j];
        }
        if (row < M && !first) {
#pragma unroll
            for (int j = 0; j < 8; ++j) { const u32x2 w = ((const u32x2*)((const bf16_t*)(p.ws + WS_XR) + (size_t)row * D))[lane + 64 * j]; v[j] = (f32x4){bflo(w.x), bfhi(w.x), bflo(w.y), bfhi(w.y)}; }
        } else {
#pragma unroll
            for (int j = 0; j < 8; ++j) v[j] = ((const f32x4*)x)[lane + 64 * j];
        }
#pragma unroll
        for (int j = 0; j < 8; ++j) ss += (v[j].x * v[j].x + v[j].y * v[j].y) + (v[j].z * v[j].z + v[j].w * v[j].w);
        const float rstd = rsqrtf(wave_sum(ss) * (1.0f / D) + EPS);
        if (which == 2) {
#pragma unroll
            for (int j = 0; j < 8; ++j) { const f32x4 g = ((const f32x4*)gvec)[lane + 64 * j]; ((f32x4*)of)[lane + 64 * j] = v[j] * rstd * g; }
        } else {
            const float* sh = mod + (size_t)mrow * 6 * D + (which == 0 ? 0 : 3) * D; const float* sc = sh + D;
#pragma unroll
            for (int j = 0; j < 8; ++j) { const f32x4 g = ((const f32x4*)gvec)[lane + 64 * j], c = ((const f32x4*)sc)[lane + 64 * j], h = ((const f32x4*)sh)[lane + 64 * j];
                const f32x4 y = v[j] * rstd * g * (c + 1.0f) + h; u32x2 w; w.x = pk2(y.x, y.y); w.y = pk2(y.z, y.w); ((u32x2*)o)[lane + 64 * j] = w; }
        }
    }
}

struct EpiIn {
    static constexpr bool PERM = false, AFTER_DRAIN = false;
    bf16_t *Q, *K, *V, *U, *GT; float* ssq; const float* rope; float *kwin, *vwin, *gmv; LAS unsigned char* tbuf;
    DI void operator()(const f32x4 (&acc)[2][2][4][2], const pg8::Unit& u, int wr, int wc, int fr, int fq) const {
        const int pn = u.pn, b = u.pm >> 3;
#pragma unroll
        for (int ai = 0; ai < 2; ++ai)
#pragma unroll
            for (int m = 0; m < 4; ++m) {
                const int row = u.pm * 256 + ai * 128 + wr * 64 + m * 16 + fr, t = row & 2047;
                if (pn <= 4) {
                    const int dh = 16 * (wc & 1) + 4 * fq;
                    const f32x4 cs = *(const f32x4*)(rope + t * 32 + dh), sn = *(const f32x4*)(rope + 65536 + t * 32 + dh);
#pragma unroll
                    for (int bj = 0; bj < 2; ++bj) {
                        const f32x4 x1 = acc[ai][bj][m][0], x2 = acc[ai][bj][m][1];
                        const f32x4 o1 = x1 * cs - x2 * sn, o2 = x2 * cs + x1 * sn;
                        const int hc = (2 * bj + (wc >> 1)) * 64 + dh;
                        u32x2 w1, w2; w1.x = pk2(o1.x, o1.y); w1.y = pk2(o1.z, o1.w); w2.x = pk2(o2.x, o2.y); w2.y = pk2(o2.z, o2.w);
                        if (pn < 4) { bf16_t* dst = Q + (size_t)row * 1024 + pn * 256 + hc; *(u32x2*)dst = w1; *(u32x2*)(dst + 32) = w2; }
                        else { bf16_t* dst = K + (size_t)row * 256 + hc; *(u32x2*)dst = w1; *(u32x2*)(dst + 32) = w2;
                            if (t >= 1920) { float* w = kwin + ((size_t)(b * 128 + t - 1920) * 256 + hc); *(f32x4*)w = o1; *(f32x4*)(w + 32) = o2; } }
                    }
                } else if (pn == 5) {
#pragma unroll
                    for (int bj = 0; bj < 2; ++bj) {
                        const int col = 128 * bj + 32 * wc + 8 * fq; const f32x4 v0 = acc[ai][bj][m][0], v1 = acc[ai][bj][m][1];
                        u32x4 w; w.x = pk2(v0.x, v0.y); w.y = pk2(v0.z, v0.w); w.z = pk2(v1.x, v1.y); w.w = pk2(v1.z, v1.w);
                        *(u32x4*)(V + (size_t)row * 256 + col) = w;
                        if (t >= 1920) { float* o = vwin + ((size_t)(b * 128 + t - 1920) * 256 + col); *(f32x4*)o = v0; *(f32x4*)(o + 4) = v1; }
                    }
                } else if (pn < 10) {
#pragma unroll
                    for (int bj = 0; bj < 2; ++bj) {
                        const int col = 256 * (pn - 6) + 128 * bj + 32 * wc + 8 * fq; f32x4 v0 = acc[ai][bj][m][0], v1 = acc[ai][bj][m][1];
#pragma unroll
                        for (int e = 0; e < 4; ++e) { v0[e] = gelu_tanh(v0[e]); v1[e] = gelu_tanh(v1[e]); }
                        u32x4 w; w.x = pk2(v0.x, v0.y); w.y = pk2(v0.z, v0.w); w.z = pk2(v1.x, v1.y); w.w = pk2(v1.z, v1.w);
                        *(u32x4*)(U + (size_t)row * 1024 + col) = w;
                    }
                } else {
                    float s = 0.f; LAS unsigned char* tb = tbuf + (wr * 4 + wc) * 2048;
#pragma unroll
                    for (int bj = 0; bj < 2; ++bj)
#pragma unroll
                        for (int n = 0; n < 2; ++n) {
                            const int col = 256 * (pn - 10) + 128 * bj + 32 * wc + 16 * n + 4 * fq; f32x4 g = acc[ai][bj][m][n];
#pragma unroll
                            for (int e = 0; e < 4; ++e) { g[e] = gelu_tanh(g[e]); s += g[e] * g[e]; *(LAS unsigned short*)(tb + (32 * bj + 16 * n + 4 * fq + e) * 32 + fr * 2) = (unsigned short)f2bf(g[e]); }
                            if (t >= 1920) *(f32x4*)(gmv + ((size_t)(b * 128 + t - 1920) * 1024 + col)) = g;
                        }
                    asm volatile("s_waitcnt lgkmcnt(0)" ::: "memory");
                    { const int lane = fq * 16 + fr, t0 = (u.pm * 256 + ai * 128 + wr * 64 + m * 16) & 2047;
#pragma unroll
                      for (int q = 0; q < 2; ++q) { const int id = lane + 64 * q, lc = id & 63, half = id >> 6;
                          const u32x4 v = *(const LAS u32x4*)(tb + lc * 32 + half * 16);
                          const int col = 256 * (pn - 10) + 128 * (lc >> 5) + 32 * wc + (lc & 31);
                          *(u32x4*)(GT + ((((size_t)b * 256 + (t0 >> 3) + half) * 1024 + col) << 3)) = v; }
                    }
                    asm volatile("s_waitcnt lgkmcnt(0)" ::: "memory");
                    s += __shfl_xor(s, 16); s += __shfl_xor(s, 32);
                    if (fq == 0) __hip_atomic_fetch_add(ssq + row, s, __ATOMIC_RELAXED, __HIP_MEMORY_SCOPE_AGENT);
                }
            }
    }
};
template <bool BASE_F32>
struct EpiRes {
    static constexpr bool PERM = false, AFTER_DRAIN = false;
    const float* basef; bf16_t* xr; const float* gate;
    DI void operator()(const f32x4 (&acc)[2][2][4][2], const pg8::Unit& u, int wr, int wc, int fr, int fq) const {
        const int b = u.pm >> 3; const int col0 = u.pn * 256 + wc * 32 + 8 * fq;
        f32x4 gv[2][2];
#pragma unroll
        for (int bj = 0; bj < 2; ++bj)
#pragma unroll
            for (int n = 0; n < 2; ++n) gv[bj][n] = *(const f32x4*)(gate + (size_t)b * 6 * D + col0 + bj * 128 + n * 4);
#pragma unroll
        for (int ai = 0; ai < 2; ++ai) {
            f32x4 bs[4][2][2];
#pragma unroll
            for (int m = 0; m < 4; ++m) { const size_t off = (size_t)(u.pm * 256 + ai * 128 + wr * 64 + m * 16 + fr) * D + col0;
#pragma unroll
                for (int bj = 0; bj < 2; ++bj) {
                    if (BASE_F32) { bs[m][bj][0] = *(const f32x4*)(basef + off + bj * 128); bs[m][bj][1] = *(const f32x4*)(basef + off + bj * 128 + 4); }
                    else { const u32x4 w = *(const u32x4*)(xr + off + bj * 128); bs[m][bj][0] = (f32x4){bflo(w.x), bfhi(w.x), bflo(w.y), bfhi(w.y)}; bs[m][bj][1] = (f32x4){bflo(w.z), bfhi(w.z), bflo(w.w), bfhi(w.w)}; } } }
#pragma unroll
            for (int m = 0; m < 4; ++m) { const size_t off = (size_t)(u.pm * 256 + ai * 128 + wr * 64 + m * 16 + fr) * D + col0;
#pragma unroll
                for (int bj = 0; bj < 2; ++bj) { const f32x4 o0 = bs[m][bj][0] + gv[bj][0] * acc[ai][bj][m][0], o1 = bs[m][bj][1] + gv[bj][1] * acc[ai][bj][m][1];
                    u32x4 w; w.x = pk2(o0.x, o0.y); w.y = pk2(o0.z, o0.w); w.z = pk2(o1.x, o1.y); w.w = pk2(o1.z, o1.w);
                    *(u32x4*)(xr + off + bj * 128) = w; } }
            asm volatile("" ::: "memory"); }
    }
};
DI float dpp_ror1(float v) { return __builtin_bit_cast(float, __builtin_amdgcn_update_dpp(0, __builtin_bit_cast(int, v), 0x121, 0xf, 0xf, false)); }
DI float dpp_ror2(float v) { return __builtin_bit_cast(float, __builtin_amdgcn_update_dpp(0, __builtin_bit_cast(int, v), 0x122, 0xf, 0xf, false)); }
struct EpiGU {
    static constexpr bool PERM = false, AFTER_DRAIN = false;
    bf16_t* ACT; float* SA; float* SU; float* cvp; const float* cw; const float* cb;
    DI void operator()(const f32x4 (&acc)[2][2][4][2], const pg8::Unit& u, int wr, int wc, int fr, int fq) const {
        const int b = u.pm >> 3, f0 = u.pn * 128 + wc * 32 + 8 * fq;
        float w0[8], w1[8], w2[8], bb[8];
#pragma unroll
        for (int q = 0; q < 2; ++q) { const f32x4 x0 = *(const f32x4*)(cw + f0 + 4 * q), x1 = *(const f32x4*)(cw + DFF + f0 + 4 * q), x2 = *(const f32x4*)(cw + 2 * DFF + f0 + 4 * q), x3 = *(const f32x4*)(cb + f0 + 4 * q);
#pragma unroll
            for (int e = 0; e < 4; ++e) { w0[4 * q + e] = x0[e]; w1[4 * q + e] = x1[e]; w2[4 * q + e] = x2[e]; bb[4 * q + e] = x3[e]; } }
#pragma unroll
        for (int ai = 0; ai < 2; ++ai) {
            const int blk = u.pm * 4 + ai * 2 + wr;
#pragma unroll
            for (int m = 0; m < 4; ++m) { const int row = u.pm * 256 + ai * 128 + wr * 64 + m * 16 + fr, t = row & 2047;
                float o[8];
#pragma unroll
                for (int n = 0; n < 2; ++n)
#pragma unroll
                    for (int e = 0; e < 4; ++e) { const float a = acc[ai][0][m][n][e], ap = acc[ai][0][m > 0 ? m - 1 : 0][n][e];
                        const float r1a = dpp_ror1(a), r1b = dpp_ror1(ap), r2a = dpp_ror2(a), r2b = dpp_ror2(ap);
                        const float p1 = fr >= 1 ? r1a : r1b, p2 = fr >= 2 ? r2a : r2b;
                        const int c = 4 * n + e; const float cv = bb[c] + w0[c] * p2 + w1[c] * p1 + w2[c] * a;
                        o[c] = silu_f(cv) * acc[ai][1][m][n][e]; }
                const f32x4 g0 = acc[ai][0][m][0], g1 = acc[ai][0][m][1];
                if (m == 0 && fr < 2) {
                    float* sa = SA + ((size_t)(blk * 4 + 2 + fr)) * DFF + f0; *(f32x4*)sa = g0; *(f32x4*)(sa + 4) = g1;
                    float* su = SU + ((size_t)(blk * 2 + fr)) * DFF + f0; *(f32x4*)su = acc[ai][1][m][0]; *(f32x4*)(su + 4) = acc[ai][1][m][1];
                } else {
                    u32x4 w; w.x = pk2(o[0], o[1]); w.y = pk2(o[2], o[3]); w.z = pk2(o[4], o[5]); w.w = pk2(o[6], o[7]);
                    *(u32x4*)(ACT + (size_t)row * LDF + f0) = w;
                }
                if (m == 3 && fr >= 14) { float* sa = SA + ((size_t)(blk * 4 + fr - 14)) * DFF + f0; *(f32x4*)sa = g0; *(f32x4*)(sa + 4) = g1; }
                if (t >= 2046) { float* oo = cvp + ((size_t)(b * 2 + t - 2046) * DFF + f0); *(f32x4*)oo = g0; *(f32x4*)(oo + 4) = g1; }
            }
        }
    }
};

struct EpiNull {
    static constexpr bool PERM = false, AFTER_DRAIN = false;
    float* sink;
    DI void operator()(const f32x4 (&acc)[2][2][4][2], const pg8::Unit& u, int wr, int wc, int fr, int fq) const {
        f32x4 s = {0.f, 0.f, 0.f, 0.f};
#pragma unroll
        for (int ai = 0; ai < 2; ++ai)
#pragma unroll
            for (int bj = 0; bj < 2; ++bj)
#pragma unroll
                for (int m = 0; m < 4; ++m)
#pragma unroll
                    for (int n = 0; n < 2; ++n) s += acc[ai][bj][m][n];
        if (s.x + s.y + s.z + s.w == 1234567.0f) sink[8191] = s.x;
    }
};
DI void attn_unit(const P& p, int l, int unit, LAS unsigned char* lds, int tid, int wave, int lane) {
    const int b = unit >> 6, n = (unit >> 2) & 15, kvh = unit & 3;
    const bf16_t* Kb = (const bf16_t*)(p.ws + WS_K); const bf16_t* Vb = (const bf16_t*)(p.ws + WS_V); const bf16_t* Qb = (const bf16_t*)(p.ws + WS_Q);
    bf16_t* MIX = (bf16_t*)(p.ws + WS_MIX);
    LAS unsigned char* Ks = lds;
    LAS unsigned char* Vt = lds + 256 * 144;
    const int tok0 = b * 2048 + (n - 1) * 128;
#pragma unroll
    for (int i = 0; i < 4; ++i) { const int id = i * 512 + tid, key = id >> 3, part = id & 7;
        u32x4 v = {0u, 0u, 0u, 0u}; if (n > 0 || key >= 128) v = *(const u32x4*)(Kb + (size_t)(tok0 + key) * 256 + kvh * 64 + part * 8);
        *(LAS u32x4*)(Ks + key * 144 + part * 16) = v; }
#pragma unroll
    for (int i = 0; i < 4; ++i) { const int id = i * 512 + tid, key = id & 255, part = id >> 8;
        u32x4 v = {0u, 0u, 0u, 0u}; if (n > 0 || key >= 128) v = *(const u32x4*)(Vb + (size_t)(tok0 + key) * 256 + kvh * 64 + part * 8);
        LAS unsigned short* d = (LAS unsigned short*)(Vt + (part * 8) * 528 + key * 2);
        d[0 * 264] = (unsigned short)(v.x & 0xffffu); d[1 * 264] = (unsigned short)(v.x >> 16); d[2 * 264] = (unsigned short)(v.y & 0xffffu); d[3 * 264] = (unsigned short)(v.y >> 16);
        d[4 * 264] = (unsigned short)(v.z & 0xffffu); d[5 * 264] = (unsigned short)(v.z >> 16); d[6 * 264] = (unsigned short)(v.w & 0xffffu); d[7 * 264] = (unsigned short)(v.w >> 16); }
    __syncthreads();
    const int q16 = lane & 15, g4 = lane >> 4;
    for (int it = 0; it < 4; ++it) {
        const int qg = wave * 4 + it, g = qg >> 3, i0 = (qg & 7) * 16, head = kvh * 4 + g, nt0 = i0 >> 4;
        const size_t qtok = (size_t)b * 2048 + n * 128 + i0 + q16;
        const bf16x8 q0 = *(const bf16x8*)(Qb + qtok * 1024 + head * 64 + g4 * 8), q1 = *(const bf16x8*)(Qb + qtok * 1024 + head * 64 + 32 + g4 * 8);
        f32x4 s[9];
#pragma unroll
        for (int tt = 0; tt < 9; ++tt) { const LAS unsigned char* kp = Ks + ((nt0 + tt) * 16 + q16) * 144 + g4 * 16;
            const bf16x8 a0 = *(const LAS bf16x8*)kp, a1 = *(const LAS bf16x8*)(kp + 64);
            f32x4 z = {0.f, 0.f, 0.f, 0.f}; z = MFMA16(a0, q0, z); s[tt] = MFMA16(a1, q1, z); }
        const int iq = i0 + q16; float mx = -1e30f;
#pragma unroll
        for (int tt = 0; tt < 9; ++tt)
#pragma unroll
            for (int r = 0; r < 4; ++r) { const int j = (nt0 + tt) * 16 + g4 * 4 + r; const bool ok = (j >= iq) && (j <= iq + 128) && (n > 0 || j >= 128);
                const float v = ok ? s[tt][r] * 0.125f : -1e30f; s[tt][r] = v; mx = fmaxf(mx, v); }
        mx = fmaxf(mx, __shfl_xor(mx, 16)); mx = fmaxf(mx, __shfl_xor(mx, 32));
        const float sink = p.sinks[l * NH + head]; const float mm = fmaxf(mx, sink);
        float sum = 0.f;
#pragma unroll
        for (int tt = 0; tt < 9; ++tt)
#pragma unroll
            for (int r = 0; r < 4; ++r) { const float e = __expf(s[tt][r] - mm); s[tt][r] = e; sum += e; }
        sum += __shfl_xor(sum, 16); sum += __shfl_xor(sum, 32);
        const float inv = 1.0f / (sum + __expf(sink - mm));
        f32x4 o[4];
#pragma unroll
        for (int dt = 0; dt < 4; ++dt) o[dt] = (f32x4){0.f, 0.f, 0.f, 0.f};
#pragma unroll
        for (int i = 0; i < 5; ++i) {
            const f32x4 pl = s[2 * i], ph = (2 * i + 1 < 9) ? s[(2 * i + 1 < 9) ? 2 * i + 1 : 8] : (f32x4){0.f, 0.f, 0.f, 0.f};
            const bf16x8 pb = pack8v(pl, ph);
#pragma unroll
            for (int dt = 0; dt < 4; ++dt) { const LAS unsigned char* vp = Vt + (16 * dt + q16) * 528 + ((nt0 + 2 * i) * 16 + g4 * 4) * 2;
                u32x4 va; const u32x2 lo = *(const LAS u32x2*)vp; va.x = lo.x; va.y = lo.y;
                if (2 * i + 1 < 9) { const u32x2 hi = *(const LAS u32x2*)(vp + 32); va.z = hi.x; va.w = hi.y; } else { va.z = 0u; va.w = 0u; }
                o[dt] = MFMA16(__builtin_bit_cast(bf16x8, va), pb, o[dt]); }
        }
#pragma unroll
        for (int dt = 0; dt < 4; ++dt) { u32x2 w; w.x = pk2(o[dt].x * inv, o[dt].y * inv); w.y = pk2(o[dt].z * inv, o[dt].w * inv);
            *(u32x2*)(MIX + qtok * LDD + head * 64 + 16 * dt + 4 * g4) = w; }
    }
    __syncthreads();
}

DI void gmlp_unit(const P& p, int l, int unit, int rt, int lane) {
    const int b = unit >> 7, c = (unit >> 3) & 15, h = unit & 7;
    const int q16 = lane & 15, g4 = lane >> 4, i = 16 * rt + q16;
    const float* Wrow = p.gmws + (((size_t)l * 8 + h) * 128 + i) * 128;
    const float* ssq = (const float*)(p.ws + WS_SSQ) + l * M + b * 2048 + c * 128;
    const bf16_t* GT = (const bf16_t*)(p.ws + WS_GT) + (((size_t)(b * 16 + c) * 16) * 1024 + h * 128) * 8;
    const bf16_t* U = (const bf16_t*)(p.ws + WS_U); bf16_t* MIX = (bf16_t*)(p.ws + WS_MIX);
    f32x4 acc[8];
#pragma unroll
    for (int dt = 0; dt < 8; ++dt) acc[dt] = (f32x4){0.f, 0.f, 0.f, 0.f};
    const int ksmax = rt >> 1;
    for (int ks = 0; ks <= ksmax; ++ks) {
        const int j0 = 32 * ks + 8 * g4;
        const f32x4 w0 = *(const f32x4*)(Wrow + j0), w1 = *(const f32x4*)(Wrow + j0 + 4), s0 = *(const f32x4*)(ssq + j0), s1 = *(const f32x4*)(ssq + j0 + 4);
        float wv[8];
#pragma unroll
        for (int jj = 0; jj < 4; ++jj) { wv[jj] = (j0 + jj <= i) ? w0[jj] * rsqrtf(s0[jj] * (1.0f / GMW) + EPS) : 0.f; wv[4 + jj] = (j0 + 4 + jj <= i) ? w1[jj] * rsqrtf(s1[jj] * (1.0f / GMW) + EPS) : 0.f; }
        const bf16x8 bw = pack8(wv);
#pragma unroll
        for (int dt = 0; dt < 8; ++dt) { const bf16x8 a = *(const bf16x8*)(GT + ((size_t)(4 * ks + g4) * 1024 + 16 * dt + q16) * 8); acc[dt] = MFMA16(a, bw, acc[dt]); }
    }
    const size_t tok = (size_t)b * 2048 + c * 128 + i;
    const float bias = p.gmbs[(l * 8 + h) * 128 + i];
#pragma unroll
    for (int dt = 0; dt < 8; ++dt) { const int col = h * 128 + 16 * dt + 4 * g4;
        const f32x4 gain = *(const f32x4*)(p.gmgain + l * GMW + col); const u32x2 uu = *(const u32x2*)(U + tok * 1024 + col);
        const float o0 = bflo(uu.x) * (gain.x * acc[dt].x + bias), o1 = bfhi(uu.x) * (gain.y * acc[dt].y + bias), o2 = bflo(uu.y) * (gain.z * acc[dt].z + bias), o3 = bfhi(uu.y) * (gain.w * acc[dt].w + bias);
        u32x2 w; w.x = pk2(o0, o1); w.y = pk2(o2, o3); *(u32x2*)(MIX + tok * LDD + 1024 + col) = w; }
}

DI void sample_part(const P& p, int l, int s, int hp, LAS unsigned char* lds, int tid, int wave, int lane) {
    const float* qS = (const float*)(p.ws + WS_SMP + SM_Q) + s * 1024; const float* kS = (const float*)(p.ws + WS_SMP + SM_KK) + s * 256; const float* vS = (const float*)(p.ws + WS_SMP + SM_VV) + s * 256;
    const float* uS = (const float*)(p.ws + WS_SMP + SM_UU) + s * 1024; const float* gS = (const float*)(p.ws + WS_SMP + SM_GG) + s * 1024;
    bf16_t* mix = (bf16_t*)(p.ws + WS_SMP + SM_MIX) + s * 2048;
    const float* ck = p.ck + ((size_t)l * NS + s) * WIN * KVW; const float* cv = p.cv + ((size_t)l * NS + s) * WIN * KVW;
    LAS float* red = (LAS float*)lds;
    LAS float* ql = (LAS float*)(lds + 128);
    LAS float* pl = (LAS float*)(lds + 128 + 512);
    LAS float* po = (LAS float*)(lds + 128 + 512 + 1056);
    const int kvh = hp >> 1, hh = tid >> 8, j = tid & 255, head = 2 * hp + hh;
    const float g0 = gS[tid], g1 = gS[tid + 512];
    if (tid < 128) ql[tid] = qS[2 * hp * 64 + tid];
    f32x4 kk[16];
    { const float* kr = (j < 128) ? ck + (size_t)j * KVW + kvh * 64 : kS + kvh * 64;
#pragma unroll
      for (int e = 0; e < 16; ++e) kk[e] = (j < 129) ? ((const f32x4*)kr)[e] : (f32x4){0.f, 0.f, 0.f, 0.f}; }
    { float* ko = p.out + O_KWS + ((size_t)l * NS + s) * WIN * KVW; float* vo = p.out + O_VWS + ((size_t)l * NS + s) * WIN * KVW;
#pragma unroll
      for (int q = 0; q < 2; ++q) { const int i = hp * 1024 + tid + 512 * q, jj = i >> 6, c4 = i & 63;
          const f32x4 kv = (jj < 127) ? ((const f32x4*)ck)[(jj + 1) * 64 + c4] : ((const f32x4*)kS)[c4];
          const f32x4 vv = (jj < 127) ? ((const f32x4*)cv)[(jj + 1) * 64 + c4] : ((const f32x4*)vS)[c4];
          ((f32x4*)ko)[i] = kv; ((f32x4*)vo)[i] = vv; } }
    float ss = wave_sum(g0 * g0 + g1 * g1);
    if (lane == 0) red[wave] = ss;
    __syncthreads();
    if (tid < 128) { float tot = 0.f;
#pragma unroll
        for (int w = 0; w < 8; ++w) tot += red[w];
        const float rstd = rsqrtf(tot * (1.0f / GMW) + EPS); const int c = 128 * hp + tid;
        const float gvn = gS[c] * rstd * p.gmgain[l * GMW + c];
        p.out[O_GMS + ((size_t)l * NS + s) * GMW + c] = gvn;
        const float sv = p.gmws[((size_t)l * 8 + hp) * 128 * 128] * gvn + p.gmbs[(l * 8 + hp) * 128];
        mix[1024 + c] = (bf16_t)f2bf(uS[c] * sv); }
    float sc = -1e30f;
    if (j < 129) { float d = 0.f;
#pragma unroll
        for (int e = 0; e < 16; ++e) { const LAS float* qq = ql + hh * 64 + 4 * e; d += kk[e].x * qq[0] + kk[e].y * qq[1] + kk[e].z * qq[2] + kk[e].w * qq[3]; }
        sc = d * 0.125f; }
    float mx = sc;
#pragma unroll
    for (int o = 1; o < 64; o <<= 1) mx = fmaxf(mx, __shfl_xor(mx, o));
    if (lane == 0) red[8 + wave] = mx;
    __syncthreads();
    mx = fmaxf(fmaxf(red[8 + 4 * hh], red[9 + 4 * hh]), fmaxf(red[10 + 4 * hh], red[11 + 4 * hh]));
    const float sink = p.sinks[l * NH + head], mm = fmaxf(mx, sink);
    const float pe = (j < 129) ? __expf(sc - mm) : 0.f;
    const float sm = wave_sum(pe);
    if (lane == 0) red[16 + wave] = sm;
    __syncthreads();
    const float inv = 1.0f / ((red[16 + 4 * hh] + red[17 + 4 * hh]) + (red[18 + 4 * hh] + red[19 + 4 * hh]) + __expf(sink - mm));
    if (j < 129) pl[hh * 132 + j] = pe * inv;
    __syncthreads();
    { const int part = (tid >> 5) & 7, d2 = (tid & 31) * 2; float o0 = 0.f, o1 = 0.f; f32x2 vv[16];
#pragma unroll
      for (int q = 0; q < 16; ++q) vv[q] = *(const f32x2*)(cv + (size_t)(part * 16 + q) * KVW + kvh * 64 + d2);
#pragma unroll
      for (int q = 0; q < 16; ++q) { const float pj = pl[hh * 132 + part * 16 + q]; o0 += pj * vv[q].x; o1 += pj * vv[q].y; }
      if (part == 0) { const float pj = pl[hh * 132 + 128]; const f32x2 v2 = *(const f32x2*)(vS + kvh * 64 + d2); o0 += pj * v2.x; o1 += pj * v2.y; }
      po[(hh * 8 + part) * 64 + d2] = o0; po[(hh * 8 + part) * 64 + d2 + 1] = o1; }
    __syncthreads();
    if (tid < 128) { const int h2 = tid >> 6, d = tid & 63; float o = 0.f;
#pragma unroll
        for (int q = 0; q < 8; ++q) o += po[(h2 * 8 + q) * 64 + d];
        mix[(2 * hp + h2) * 64 + d] = (bf16_t)f2bf(o); }
    __syncthreads();
}

DI void gmv_fix(const P& p, int l, int tid) {
    float* gmv = p.out + O_GMP + (size_t)l * NB * 128 * GMW; const float* ssq = (const float*)(p.ws + WS_SSQ) + l * M;
    for (int i = blockIdx.x * 512 + tid; i < NB * 128 * GMW / 4; i += G * 512) { const int c4 = i & 255, r = i >> 8, b = r >> 7, tt = r & 127;
        const float rs = rsqrtf(ssq[b * 2048 + 1920 + tt] * (1.0f / GMW) + EPS); const f32x4 g = ((const f32x4*)(p.gmgain + l * GMW))[c4];
        f32x4 v = ((f32x4*)gmv)[i]; v = v * rs * g; ((f32x4*)gmv)[i] = v; }
}

DI void phase_fix(const P& p, int l, int tid) {
    const float* SA = (const float*)(p.ws + WS_GA); const float* SU = SA + (size_t)128 * 4 * DFF; bf16_t* ACT = (bf16_t*)(p.ws + WS_UP);
    const float* cw = p.convw + (size_t)l * 3 * DFF; const float* cb = p.convb + (size_t)l * DFF;
    constexpr int NC4 = DFF / 4;
    for (int task = blockIdx.x * 512 + tid; task < 128 * 2 * NC4; task += G * 512) {
        const int c4 = task % NC4, rr = task / NC4, blk = rr >> 1, r = rr & 1, f = c4 * 4; const bool first = (blk & 31) == 0;
        const f32x4 z = {0.f, 0.f, 0.f, 0.f};
        const float* cur = SA + (size_t)blk * 4 * DFF + f; const float* prv = SA + (size_t)(blk - 1) * 4 * DFF + f;
        const f32x4 a2 = *(const f32x4*)(cur + (2 + r) * DFF);
        const f32x4 a1 = r ? *(const f32x4*)(cur + 2 * DFF) : (first ? z : *(const f32x4*)(prv + DFF));
        const f32x4 a0 = r ? (first ? z : *(const f32x4*)(prv + DFF)) : (first ? z : *(const f32x4*)prv);
        const f32x4 uu = *(const f32x4*)(SU + ((size_t)(blk * 2 + r)) * DFF + f);
        const f32x4 x0 = *(const f32x4*)(cw + f), x1 = *(const f32x4*)(cw + DFF + f), x2 = *(const f32x4*)(cw + 2 * DFF + f), x3 = *(const f32x4*)(cb + f);
        float o[4];
#pragma unroll
        for (int e = 0; e < 4; ++e) o[e] = silu_f(x3[e] + x0[e] * a0[e] + x1[e] * a1[e] + x2[e] * a2[e]) * uu[e];
        u32x2 w; w.x = pk2(o[0], o[1]); w.y = pk2(o[2], o[3]);
        *(u32x2*)(ACT + (size_t)(blk * 64 + r) * LDF + f) = w;
    }
}
template <int NBLK, int K, int KSPLIT, class Epi>
#ifndef SK_REPEAT
#define SK_REPEAT 1
#endif
DI void skinny(LAS unsigned char* lds, const bf16_t* A, const bf16_t* B0, const bf16_t* B1, int kq, int wave, int lane, const Epi& epi) {
  for (int rep = 0; rep < SK_REPEAT; ++rep) {
    asm volatile("" ::: "memory");
    const int r = lane & 31, h = lane >> 5; constexpr int kw = K / (8 * KSPLIT); const int koff = kq * (K / KSPLIT) + wave * kw + h * 8;
    const bf16_t* ap = A + (size_t)r * K + koff;
    const bf16_t* b0 = B0 + (size_t)r * (K + 64) + koff;
    const bf16_t* b1 = (NBLK == 2 ? B1 : B0) + (size_t)r * (K + 64) + koff;
    f32x16 acc0, acc1;
#pragma unroll
    for (int q = 0; q < 16; ++q) { acc0[q] = 0.f; acc1[q] = 0.f; }
#pragma unroll (kw / 16 <= 16 ? kw / 16 : 11)
    for (int k = 0; k < kw; k += 16) { const bf16x8 a = *(const bf16x8*)(ap + k);
        acc0 = MFMA32(*(const bf16x8*)(b0 + k), a, acc0);
        if (NBLK == 2) acc1 = MFMA32(*(const bf16x8*)(b1 + k), a, acc1); }
    LAS float* red = (LAS float*)lds;
#pragma unroll
    for (int q = 0; q < 16; ++q) { red[((wave * 2 + 0) * 16 + q) * 64 + lane] = acc0[q]; if (NBLK == 2) red[((wave * 2 + 1) * 16 + q) * 64 + lane] = acc1[q]; }
    __syncthreads();
    if (wave == 0) {
#pragma unroll
        for (int q = 0; q < 16; ++q) { float s0 = 0.f, s1 = 0.f;
#pragma unroll
            for (int w = 0; w < 8; ++w) { s0 += red[((w * 2 + 0) * 16 + q) * 64 + lane]; if (NBLK == 2) s1 += red[((w * 2 + 1) * 16 + q) * 64 + lane]; }
            acc0[q] = s0; acc1[q] = s1; }
        if (rep == SK_REPEAT - 1) epi(acc0, acc1, lane);
    }
    __syncthreads();
  }
}
struct SkIn {
    int item; float *qS, *kS, *vS, *uS, *gS; const float* ropeS;
    DI void operator()(const f32x16& acc, const f32x16&, int lane) const {
        const int s = lane & 31, h = lane >> 5, p0 = item * 32, pn = p0 >> 8, bj = (p0 >> 7) & 1, wc = (p0 >> 5) & 3;
        if (pn <= 4) {
#pragma unroll
            for (int q = 0; q < 8; ++q) { const int fq = 2 * ((q >> 2) & 1) + h, e = q & 3, dh = 16 * (wc & 1) + 4 * fq + e;
                const float cs = ropeS[dh], sn = ropeS[32 + dh], x1 = acc[q], x2 = acc[q + 8], o1 = x1 * cs - x2 * sn, o2 = x2 * cs + x1 * sn;
                const int hc = 128 * bj + 64 * (wc >> 1) + dh;
                if (pn < 4) { qS[s * 1024 + pn * 256 + hc] = o1; qS[s * 1024 + pn * 256 + hc + 32] = o2; } else { kS[s * 256 + hc] = o1; kS[s * 256 + hc + 32] = o2; } }
        } else if (pn < 10) {
#pragma unroll
            for (int q = 0; q < 16; ++q) { const int n = q >> 3, fq = 2 * ((q >> 2) & 1) + h, e = q & 3, L = p0 + 8 * fq + 4 * n + e;
                if (pn == 5) vS[s * 256 + L - 1280] = acc[q]; else uS[s * 1024 + L - 1536] = gelu_tanh(acc[q]); }
        } else {
#pragma unroll
            for (int q = 0; q < 16; ++q) { const int L = p0 + (q & 3) + 8 * (q >> 2) + 4 * h; gS[s * 1024 + L - 2560] = gelu_tanh(acc[q]); }
        }
    }
};
struct SkRes {
    int item; float* out; const float* gate;
    DI void operator()(const f32x16& acc, const f32x16&, int lane) const {
        const int s = lane & 31, h = lane >> 5;
#pragma unroll
        for (int q = 0; q < 16; ++q) { const int n = q >> 3, fq = 2 * ((q >> 2) & 1) + h, e = q & 3, col = item * 32 + 8 * fq + 4 * n + e;
            __hip_atomic_fetch_add(out + s * D + col, gate[(size_t)(NB + s) * 6 * D + col] * acc[q], __ATOMIC_RELAXED, __HIP_MEMORY_SCOPE_AGENT); }
    }
};
struct SkGU {
    int item, l; const float *sconv, *cw, *cb; bf16_t* act; float* cvs;
    DI void operator()(const f32x16& ga, const f32x16& up, int lane) const {
        const int s = lane & 31, h = lane >> 5, pn = item >> 2, wc = item & 3;
#pragma unroll
        for (int q = 0; q < 16; ++q) { const int n = q >> 3, fq = 2 * ((q >> 2) & 1) + h, e = q & 3, f = 128 * pn + 32 * wc + 8 * fq + 4 * n + e;
            const float p0 = sconv[((size_t)(l * NS + s) * 2 + 0) * DFF + f], p1 = sconv[((size_t)(l * NS + s) * 2 + 1) * DFF + f], a = ga[q];
            const float cv = cb[l * DFF + f] + cw[((size_t)l * 3 + 0) * DFF + f] * p0 + cw[((size_t)l * 3 + 1) * DFF + f] * p1 + cw[((size_t)l * 3 + 2) * DFF + f] * a;
            act[s * DFF + f] = (bf16_t)f2bf(silu_f(cv) * up[q]);
            cvs[((size_t)(l * NS + s) * 2 + 0) * DFF + f] = p1; cvs[((size_t)(l * NS + s) * 2 + 1) * DFF + f] = a; }
    }
};

#ifndef MULTI
#define MULTI 0
#endif
constexpr int NPHASE = 18;
__global__ void __launch_bounds__(512, 2) fwd(Args a) {
    extern __shared__ __attribute__((aligned(16))) unsigned char lds_raw[];
    LAS unsigned char* lds = (LAS unsigned char*)lds_raw;
    cg::grid_group grid = cg::this_grid();
    const int wave0 = __builtin_amdgcn_readfirstlane(threadIdx.x >> 6);
    P p;
    p.xp = a.in[0]; p.xs = a.in[1]; p.ck = a.in[2]; p.cv = a.in[3]; p.sconv = a.in[4]; p.cp = a.in[5]; p.cs = a.in[6]; p.wada = a.in[7]; p.bada = a.in[8];
    p.g1 = a.in[9]; p.g2 = a.in[10]; p.win = a.in[11]; p.gmgain = a.in[12]; p.gmws = a.in[13]; p.gmbs = a.in[14]; p.sinks = a.in[15]; p.wout = a.in[16];
    p.wgate = a.in[17]; p.wup = a.in[18]; p.convw = a.in[19]; p.convb = a.in[20]; p.wdown = a.in[21]; p.gfinal = a.in[22]; p.out = a.out; p.ws = a.ws;
    const int lo = a.ph_lo, hi = a.ph_hi;
    volatile LAS unsigned* xst = (volatile LAS unsigned*)(lds + 147456);
    if (threadIdx.x < 2) xst[threadIdx.x] = 0u;
    __syncthreads();
    const XcdBarrier xbar = xcd_barrier_post((unsigned*)(a.ws + WS_BAR), xst);
#define IN(k) (lo <= (k) && (k) < hi)
#define FRESH() int wv_f = wave0; asm volatile("" : "+s"(wv_f)); int tid_f = wv_f * 64 + (int)__builtin_amdgcn_mbcnt_hi(~0u, __builtin_amdgcn_mbcnt_lo(~0u, 0u)); asm volatile("" : "+v"(tid_f)); const int tid = tid_f, lane = tid & 63, wave = __builtin_amdgcn_readfirstlane(tid >> 6); (void)lane; (void)wave
#ifndef PROBE_MASK
#define PROBE_MASK 0
#endif
#ifndef PROBE_CLK
#define PROBE_CLK 0
#endif
#ifndef PROBE_MUL
#define PROBE_MUL 2
#endif
    unsigned long long pr_acc = 0, pr_t0 = 0, pr_c0 = 0, pr_cacc = 0; (void)pr_c0; (void)pr_cacc;
#define PR_BEGIN(k) do { if (PROBE_MASK & (1u << (k))) { pr_t0 = __builtin_amdgcn_s_memrealtime(); pr_c0 = __builtin_readcyclecounter(); } } while (0)
#define SEAM(k) do { if (IN(k) && IN((k) + 1)) { if (hi > 1000) grid.sync(); else xcd_barrier(xbar); } if (PROBE_MASK & (1u << (k))) { pr_acc += __builtin_amdgcn_s_memrealtime() - pr_t0; pr_cacc += __builtin_readcyclecounter() - pr_c0; } } while (0)
    unsigned char* ws = a.ws;
    bf16_t* XN = (bf16_t*)(ws + WS_XN); bf16_t* XR = (bf16_t*)(ws + WS_XR); float* XS = (float*)(ws + WS_SMP + SM_XS);
    bf16_t* HS = (bf16_t*)(ws + WS_SMP + SM_HS); bf16_t* MIXS = (bf16_t*)(ws + WS_SMP + SM_MIX); bf16_t* ACTS = (bf16_t*)(ws + WS_SMP + SM_ACT);
    const float* MOD = (const float*)(ws + WS_MOD);

    PR_BEGIN(0);
    if (IN(0)) { FRESH(); phaseA(p, lds, tid, wave, lane); }
    SEAM(0);
    for (int l = 0; l < DEPTH; ++l) {
        const int pb = 1 + 8 * l;
        const bf16_t* Win = (const bf16_t*)(ws + WS_WIN + l * SZ_WIN); const bf16_t* Wout = (const bf16_t*)(ws + WS_WOUT + l * SZ_WOUT);
        const bf16_t* Wgu = (const bf16_t*)(ws + WS_WGU + l * SZ_WGU); const bf16_t* Wdn = (const bf16_t*)(ws + WS_WDN + l * SZ_WDN);
        const float* modl = MOD + (size_t)l * NMODROWS * 6 * D;
        PR_BEGIN(pb + 0);
        if (IN(pb + 0)) { FRESH(); phase_norm(p, l, 0, wave, lane); }
        SEAM(pb + 0);
        PR_BEGIN(pb + 1);
        if (IN(pb + 1)) {
            pg8::Gemm g{XN, Win, M, INC, D}; pg8::StaticOrder S; S.init(M, INC, gridDim.x, blockIdx.x);
            EpiIn E{(bf16_t*)(ws + WS_Q), (bf16_t*)(ws + WS_K), (bf16_t*)(ws + WS_V), (bf16_t*)(ws + WS_U), (bf16_t*)(ws + WS_GT), (float*)(ws + WS_SSQ) + l * M, (const float*)(ws + WS_ROPE),
                    p.out + O_KWP + (size_t)l * NB * WIN * KVW, p.out + O_VWP + (size_t)l * NB * WIN * KVW, p.out + O_GMP + (size_t)l * NB * 128 * GMW, lds + 131072};
            pg8::gemm_phase<EpiIn, pg8::StaticOrder>(lds, g, S, E, nullptr, wave0); FRESH();
            for (int item = (int)blockIdx.x - 192; item >= 0 && item < INC / 32; item += 64) {
                SkIn e{item, (float*)(ws + WS_SMP + SM_Q), (float*)(ws + WS_SMP + SM_KK), (float*)(ws + WS_SMP + SM_VV), (float*)(ws + WS_SMP + SM_UU), (float*)(ws + WS_SMP + SM_GG), (const float*)(ws + WS_ROPE) + 2 * 2048 * 32};
                skinny<1, D, 1>(lds, HS, Win + (size_t)item * 32 * LDD, nullptr, 0, wave, lane, e); }
        }
        SEAM(pb + 1);
        PR_BEGIN(pb + 2);
        if (IN(pb + 2)) { FRESH();
#ifndef REP_ATT
#define REP_ATT 1
#endif
#ifndef REP_GM
#define REP_GM 1
#endif
            for (int rep = 0; rep < REP_ATT; ++rep) { asm volatile("" ::: "memory"); for (int u = blockIdx.x; u < NB * 16 * NKV; u += gridDim.x) attn_unit(p, l, u, lds, tid, wave, lane); }
            for (int rep = 0; rep < REP_GM; ++rep) { asm volatile("" ::: "memory"); { int flip = 0; for (int u = blockIdx.x; u < NB * 16 * 8; u += gridDim.x, flip ^= 1) gmlp_unit(p, l, u, flip ? 7 - wave : wave, lane); } }
            for (int it = (int)gridDim.x - 1 - (int)blockIdx.x; it < NS * 8; it += gridDim.x) sample_part(p, l, it >> 3, it & 7, lds, tid, wave, lane);
            gmv_fix(p, l, tid);
        }
        SEAM(pb + 2);
        PR_BEGIN(pb + 3);
        if (IN(pb + 3)) {
            pg8::Gemm g{(const bf16_t*)(ws + WS_MIX), Wout, M, D, D}; pg8::StaticOrder S; S.init(M, D, gridDim.x, blockIdx.x);
            if (l == 0) { EpiRes<true> E{p.xp, XR, modl + 2 * D}; pg8::gemm_phase<EpiRes<true>, pg8::StaticOrder>(lds, g, S, E, nullptr, wave0); }
            else { EpiRes<false> E{nullptr, XR, modl + 2 * D}; pg8::gemm_phase<EpiRes<false>, pg8::StaticOrder>(lds, g, S, E, nullptr, wave0); }
            FRESH();
            for (int it = blockIdx.x; it < (D / 32) * 4; it += gridDim.x) { const int item = it >> 2;
                SkRes e{item, XS, modl + 2 * D};
                skinny<1, D, 4>(lds, MIXS, Wout + (size_t)item * 32 * LDD, nullptr, it & 3, wave, lane, e); }
        }
        SEAM(pb + 3);
        PR_BEGIN(pb + 4);
        if (IN(pb + 4)) { FRESH(); phase_norm(p, l, 1, wave, lane); }
        SEAM(pb + 4);
        PR_BEGIN(pb + 5);
        if (IN(pb + 5)) {
            pg8::Gemm g{XN, Wgu, M, 2 * DFF, D}; pg8::StaticOrder S; S.init(M, 2 * DFF, gridDim.x, blockIdx.x);
            EpiGU E{(bf16_t*)(ws + WS_UP), (float*)(ws + WS_GA), (float*)(ws + WS_GA) + (size_t)128 * 4 * DFF, p.out + O_CVP + (size_t)l * NB * 2 * DFF, p.convw + (size_t)l * 3 * DFF, p.convb + (size_t)l * DFF};
            pg8::gemm_phase<EpiGU, pg8::StaticOrder>(lds, g, S, E, nullptr, wave0);
#if defined(PROBE_GU_EXTRA)
            if (l == 1) { for (int rep = 0; rep < PROBE_GU_EXTRA; ++rep) { grid.sync(); EpiNull EN{(float*)(ws + WS_SSQ)}; pg8::gemm_phase<EpiNull, pg8::StaticOrder>(lds, g, S, EN, nullptr, wave0); } }
#endif
            FRESH();
            for (int item = (int)blockIdx.x - 128; item >= 0 && item < DFF / 32; item += 128) {
                SkGU e{item, l, p.sconv, p.convw, p.convb, ACTS, p.out + O_CVS};
                const bf16_t* b0 = Wgu + (size_t)(256 * (item >> 2) + 32 * (item & 3)) * LDD;
                skinny<2, D, 1>(lds, HS, b0, b0 + (size_t)128 * LDD, 0, wave, lane, e); }
        }
        SEAM(pb + 5);
        PR_BEGIN(pb + 6);
        if (IN(pb + 6)) { FRESH(); phase_fix(p, l, tid); }
        SEAM(pb + 6);
        PR_BEGIN(pb + 7);
        if (IN(pb + 7)) {
            pg8::Gemm g{(const bf16_t*)(ws + WS_UP), Wdn, M, D, DFF}; pg8::StaticOrder S; S.init(M, D, gridDim.x, blockIdx.x);
            EpiRes<false> E{nullptr, XR, modl + 5 * D};
            pg8::gemm_phase<EpiRes<false>, pg8::StaticOrder>(lds, g, S, E, nullptr, wave0); FRESH();
            for (int it = blockIdx.x; it < (D / 32) * 4; it += gridDim.x) { const int item = it >> 2;
                SkRes e{item, XS, modl + 5 * D};
                skinny<1, DFF, 4>(lds, ACTS, Wdn + (size_t)item * 32 * LDF, nullptr, it & 3, wave, lane, e); }
        }
        SEAM(pb + 7);
    }
    if (IN(17)) { FRESH(); phase_norm(p, 0, 2, wave, lane); }
    if (PROBE_MASK) { grid.sync(); if (blockIdx.x == 0) { const unsigned long long t0 = __builtin_amdgcn_s_memrealtime(); const unsigned long long spin = PROBE_CLK ? (pr_cacc * 1000ull / (pr_acc ? pr_acc : 1ull)) : (unsigned long long)PROBE_MUL * pr_acc;
        while (__builtin_amdgcn_s_memrealtime() - t0 < spin) __builtin_amdgcn_s_sleep(8); } }
}

extern "C" void kernel_launch(void* const* d_in, const int* in_sizes, int n_in, void* d_out, int out_size, void* d_ws, size_t ws_size, hipStream_t stream) {
    static int grid = 0;
    if (grid == 0) {
        if (n_in != 23 || (size_t)out_size != O_END || ws_size < WS_END) { fprintf(stderr, "kernel_launch: unexpected shapes: n_in %d out %d (want %zu) ws %zu (want %zu)\n", n_in, out_size, (size_t)O_END, ws_size, (size_t)WS_END); grid = -1; return; }
        int dev = 0, cus = 0, per = 0;
        (void)hipGetDevice(&dev); (void)hipDeviceGetAttribute(&cus, hipDeviceAttributeMultiprocessorCount, dev);
        if (hipFuncSetAttribute((const void*)fwd, hipFuncAttributeMaxDynamicSharedMemorySize, LDS_BYTES) != hipSuccess) { fprintf(stderr, "kernel_launch: hipFuncSetAttribute failed\n"); grid = -1; return; }
        (void)hipOccupancyMaxActiveBlocksPerMultiprocessor(&per, (const void*)fwd, 512, LDS_BYTES);
        if (per < 1) { fprintf(stderr, "kernel_launch: occupancy query says %d blocks per CU\n", per); per = 1; }
        grid = cus * 1;
        fprintf(stderr, "kernel_launch: grid %d (cus %d, per-cu %d)\n", grid, cus, per);
    }
    if (grid < 0) return;
    Args a{};
    for (int i = 0; i < 23; ++i) a.in[i] = (const float*)d_in[i];
    a.out = (float*)d_out; a.ws = (unsigned char*)d_ws;
    if (hipMemsetAsync((char*)d_ws + WS_BAR, 0, 65536, stream) != hipSuccess) { fprintf(stderr, "kernel_launch: memset of barrier words failed\n"); return; }
#if MULTI
    for (int k = 0; k < NPHASE; ++k) { a.ph_lo = k; a.ph_hi = k + 1; hipLaunchKernelGGL(fwd, dim3(grid), dim3(512), LDS_BYTES, stream, a); }
#else
    a.ph_lo = 0; a.ph_hi = NPHASE;
    void* args[] = {&a};
    hipError_t e = hipLaunchCooperativeKernel((void*)fwd, dim3(grid), dim3(512), args, LDS_BYTES, stream);
    if (e != hipSuccess) fprintf(stderr, "kernel_launch: cooperative launch failed: %s (grid %d)\n", hipGetErrorString(e), grid);
#endif
}
```
